# Optimizing an MI355X kernel written in HIP

```python
import jax, jax.numpy as jnp
from jax import lax
import numpy as np

D_MODEL = 1024
BATCH = 8
SEQ = 2048
DEPTH = 2

HEAD_DIM = 64
N_HEADS_FOX = 6
N_HEADS_MOBA = 6
DILATED_PAIRS = ((128, 1), (512, 4), (2048, 16))
N_SLOTS_DIL = 4
N_HEADS_DIL = N_SLOTS_DIL * len(DILATED_PAIRS)
N_HEADS = N_HEADS_FOX + N_HEADS_MOBA + N_HEADS_DIL
MIX_WIDTH = N_HEADS * HEAD_DIM
N_BRANCH = 3
IN_COLS = 3 * MIX_WIDTH + N_HEADS_FOX + N_BRANCH * D_MODEL
FOX_BLOCK = 128
MOBA_BLOCK = 256
MOBA_TOPK = 3
MOBA_Q_CHUNK = 32
WIN_BLOCK = 128
N_ALIBI = N_HEADS_MOBA + N_HEADS_DIL
DIL_SLOPE_OFFSETS = (0, N_SLOTS_DIL, 2 * N_SLOTS_DIL + N_HEADS_MOBA)
MOBA_SLOPE_OFFSET = 2 * N_SLOTS_DIL
D_FF = 2816
N_EXPERTS = 8
TOP_K = 2
D_FF_EXPERT = 2816
N_DENSE = (DEPTH + 1) // 2
N_MOE = DEPTH // 2
RMS_EPS = 1e-6
NEG_INF = -1e30

kernel_name = 'hybrid_fox_moba_dilated_moe_adaln'


def _rmsnorm(x, g):
    xf = x.astype(jnp.float32)
    y = xf * lax.rsqrt(jnp.mean(xf * xf, axis=-1, keepdims=True) + RMS_EPS)
    return (y * g.astype(jnp.float32)).astype(x.dtype)


def _alibi_slopes(n):
    return jnp.asarray(2.0 ** (-8.0 * np.arange(1, n + 1) / n), dtype=jnp.float32)


def _merge_heads(o):
    B, H, S, dh = o.shape
    return o.transpose(0, 2, 1, 3).reshape(B, S, H * dh)


def _fox_attention(q, k, v, f_logit):
    B, H, S, dh = q.shape
    cum = jnp.cumsum(jax.nn.log_sigmoid(f_logit.astype(jnp.float32)), axis=1).transpose(0, 2, 1)
    nqb = S // FOX_BLOCK
    qb = q.reshape(B, H, nqb, FOX_BLOCK, dh).transpose(2, 0, 1, 3, 4)
    cb = cum.reshape(B, H, nqb, FOX_BLOCK).transpose(2, 0, 1, 3)
    key_pos = jnp.arange(S)
    scale = dh ** -0.5

    def block(args):
        i, q_i, c_i = args
        s = jnp.einsum('bhqd,bhkd->bhqk', q_i, k, preferred_element_type=jnp.float32) * scale
        s = s + c_i[..., :, None] - cum[:, :, None, :]
        qpos = i * FOX_BLOCK + jnp.arange(FOX_BLOCK)
        s = jnp.where(key_pos[None, :] <= qpos[:, None], s, NEG_INF)
        p = jax.nn.softmax(s, axis=-1)
        return jnp.einsum('bhqk,bhkd->bhqd', p.astype(v.dtype), v)

    out = lax.map(block, (jnp.arange(nqb), qb, cb))
    return out.transpose(1, 2, 0, 3, 4).reshape(B, H, S, dh)


def _moba_attention(q, k, v, slopes):
    B, H, S, dh = q.shape
    Sp = -(-S // MOBA_BLOCK) * MOBA_BLOCK
    pad = ((0, 0), (0, 0), (0, Sp - S), (0, 0))
    q, k, v = (jnp.pad(t, pad) for t in (q, k, v))
    nb = Sp // MOBA_BLOCK
    n_sel = min(MOBA_TOPK, nb)
    kb = k.reshape(B, H, nb, MOBA_BLOCK, dh)
    vb = v.reshape(B, H, nb, MOBA_BLOCK, dh)
    k_mean = jnp.mean(kb.astype(jnp.float32), axis=3)
    gate = jnp.einsum('bhsd,bhnd->bhsn', q.astype(jnp.float32), k_mean)
    q_blk = jnp.arange(Sp) // MOBA_BLOCK
    gate = jnp.where(jnp.arange(nb)[None, :] < q_blk[:, None], gate, NEG_INF)
    _, sel = lax.top_k(gate, n_sel)
    sel_ok = sel < q_blk[:, None]
    scale = dh ** -0.5
    b_idx = jnp.arange(B)[:, None, None, None]
    h_idx = jnp.arange(H)[None, :, None, None]
    blk_pos = jnp.arange(MOBA_BLOCK)

    def chunk(i):
        start = i * MOBA_Q_CHUNK
        q_c = lax.dynamic_slice_in_dim(q, start, MOBA_Q_CHUNK, axis=2)
        sel_c = lax.dynamic_slice_in_dim(sel, start, MOBA_Q_CHUNK, axis=2)
        ok_c = lax.dynamic_slice_in_dim(sel_ok, start, MOBA_Q_CHUNK, axis=2)
        qpos = start + jnp.arange(MOBA_Q_CHUNK)
        own = start // MOBA_BLOCK
        k_own = lax.dynamic_slice_in_dim(k, own * MOBA_BLOCK, MOBA_BLOCK, axis=2)
        v_own = lax.dynamic_slice_in_dim(v, own * MOBA_BLOCK, MOBA_BLOCK, axis=2)
        dist_own = (qpos[:, None] - (own * MOBA_BLOCK + blk_pos)[None, :])
        s_own = jnp.einsum('bhcd,bhld->bhcl', q_c, k_own, preferred_element_type=jnp.float32) * scale
        s_own = s_own - slopes[:, None, None] * dist_own.astype(jnp.float32)
        s_own = jnp.where(dist_own >= 0, s_own, NEG_INF)
        k_sel = kb[b_idx, h_idx, sel_c]
        v_sel = vb[b_idx, h_idx, sel_c]
        s_sel = jnp.einsum('bhcd,bhcnld->bhcnl', q_c, k_sel, preferred_element_type=jnp.float32) * scale
        dist_sel = qpos[:, None, None] - (sel_c[..., None] * MOBA_BLOCK + blk_pos)
        s_sel = s_sel - slopes[:, None, None, None] * dist_sel.astype(jnp.float32)
        s_sel = jnp.where(ok_c[..., None], s_sel, NEG_INF)
        s = jnp.concatenate([s_own, s_sel.reshape(B, H, MOBA_Q_CHUNK, n_sel * MOBA_BLOCK)], axis=-1)
        p = jax.nn.softmax(s, axis=-1).astype(v.dtype)
        p_own = p[..., :MOBA_BLOCK]
        p_sel = p[..., MOBA_BLOCK:].reshape(B, H, MOBA_Q_CHUNK, n_sel, MOBA_BLOCK)
        return (jnp.einsum('bhcl,bhld->bhcd', p_own, v_own)
                + jnp.einsum('bhcnl,bhcnld->bhcd', p_sel, v_sel))

    out = lax.map(chunk, jnp.arange(Sp // MOBA_Q_CHUNK))
    return out.transpose(1, 2, 0, 3, 4).reshape(B, H, Sp, dh)[:, :, :S]


def _dilated_group(q, k, v, slopes, window, dil):
    B, H, S, dh = q.shape
    n_back = window // dil
    L = S // dil
    Lp = -(-L // WIN_BLOCK) * WIN_BLOCK
    nblk = Lp // WIN_BLOCK

    def to_blocks(t):
        t = t.reshape(B, H, L, dil, dh).transpose(0, 1, 3, 2, 4)
        t = jnp.pad(t, ((0, 0), (0, 0), (0, 0), (0, Lp - L), (0, 0)))
        return t.reshape(B, H, dil, nblk, WIN_BLOCK, dh)

    def band(t):
        prev = jnp.concatenate([jnp.zeros_like(t[:, :, :, :1]), t[:, :, :, :-1]], axis=3)
        return jnp.concatenate([prev, t], axis=4)

    qb = to_blocks(q)
    kband = band(to_blocks(k))
    vband = band(to_blocks(v))
    s = jnp.einsum('bhrnqd,bhrnkd->bhrnqk', qb, kband, preferred_element_type=jnp.float32) * (dh ** -0.5)
    steps = (jnp.arange(WIN_BLOCK)[:, None] + WIN_BLOCK) - jnp.arange(2 * WIN_BLOCK)[None, :]
    key_sub = (jnp.arange(nblk)[:, None, None] - 1) * WIN_BLOCK + jnp.arange(2 * WIN_BLOCK)[None, None, :]
    valid = (steps >= 0) & (steps <= n_back) & (key_sub >= 0)
    s = s - slopes[:, None, None, None, None] * (steps * dil).astype(jnp.float32)
    s = jnp.where(valid, s, NEG_INF)
    lse = jax.nn.logsumexp(s, axis=-1)
    p = jnp.exp(s - lse[..., None])
    o = jnp.einsum('bhrnqk,bhrnkd->bhrnqd', p.astype(v.dtype), vband)

    def from_blocks(t):
        t = t.reshape((B, H, dil, Lp) + t.shape[5:])[:, :, :, :L]
        t = jnp.moveaxis(t, 2, 3)
        return t.reshape((B, H, S) + t.shape[4:])

    return from_blocks(o), from_blocks(lse)


def _token_mixer(h, w_in, b_fgate, q_gain, k_gain, w_br_fox, w_br_moba, w_br_dil, w_out):
    B, S, _ = h.shape
    proj = h @ w_in
    qkv = proj[..., :3 * MIX_WIDTH].reshape(B, S, 3, N_HEADS, HEAD_DIM)
    f_logit = proj[..., 3 * MIX_WIDTH:3 * MIX_WIDTH + N_HEADS_FOX] + b_fgate
    gates = jax.nn.sigmoid(proj[..., 3 * MIX_WIDTH + N_HEADS_FOX:].astype(jnp.float32))
    gates = gates.reshape(B, S, N_BRANCH, D_MODEL).astype(h.dtype)
    q = _rmsnorm(qkv[:, :, 0], q_gain).transpose(0, 2, 1, 3)
    k = _rmsnorm(qkv[:, :, 1], k_gain).transpose(0, 2, 1, 3)
    v = qkv[:, :, 2].transpose(0, 2, 1, 3)
    slopes = _alibi_slopes(N_ALIBI)

    a1 = N_HEADS_FOX
    b1 = a1 + N_HEADS_MOBA
    o_fox = _fox_attention(q[:, :a1], k[:, :a1], v[:, :a1], f_logit)
    o_moba = _moba_attention(q[:, a1:b1], k[:, a1:b1], v[:, a1:b1],
                             slopes[MOBA_SLOPE_OFFSET:MOBA_SLOPE_OFFSET + N_HEADS_MOBA])
    outs, lses = [], []
    for g, (window, dil) in enumerate(DILATED_PAIRS):
        lo = b1 + g * N_SLOTS_DIL
        so = DIL_SLOPE_OFFSETS[g]
        o_g, l_g = _dilated_group(q[:, lo:lo + N_SLOTS_DIL], k[:, lo:lo + N_SLOTS_DIL],
                                  v[:, lo:lo + N_SLOTS_DIL], slopes[so:so + N_SLOTS_DIL], window, dil)
        outs.append(o_g)
        lses.append(l_g)
    w_dil = jax.nn.softmax(jnp.stack(lses, axis=0), axis=0)
    o_dil = jnp.einsum('gbhs,gbhsd->bhsd', w_dil.astype(v.dtype), jnp.stack(outs, axis=0))

    y = (gates[:, :, 0] * (_merge_heads(o_fox) @ w_br_fox)
         + gates[:, :, 1] * (_merge_heads(o_moba) @ w_br_moba)
         + gates[:, :, 2] * (_merge_heads(o_dil) @ w_br_dil))
    return y @ w_out


def _swiglu(h, w_gate, w_up, w_down):
    return (jax.nn.silu(h @ w_gate) * (h @ w_up)) @ w_down


def _moe_swiglu(h, w_router, b_router, w_gate, w_up, w_down):
    logits = (h @ w_router).astype(jnp.float32) + b_router.astype(jnp.float32)
    top_val, top_idx = lax.top_k(logits, TOP_K)
    top_w = jax.nn.softmax(top_val, axis=-1)
    combine = jnp.sum(jax.nn.one_hot(top_idx, N_EXPERTS, dtype=jnp.float32) * top_w[..., None], axis=-2)
    combine = combine.astype(h.dtype)
    out = jnp.zeros_like(h)
    for e in range(N_EXPERTS):
        out = out + combine[..., e:e + 1] * _swiglu(h, w_gate[e], w_up[e], w_down[e])
    return out


def setup_inputs(seed: int = 0) -> dict:
    key = jax.random.key(seed)
    ks = jax.random.split(key, 22)
    D = D_MODEL

    def nrm(k, shape, scale):
        return jax.random.normal(k, shape, jnp.float32) * scale

    wf = N_HEADS_FOX * HEAD_DIM
    wm = N_HEADS_MOBA * HEAD_DIM
    wd = N_SLOTS_DIL * HEAD_DIM
    return {
        'x': nrm(ks[0], (BATCH, SEQ, D), 1.0),
        'c': nrm(ks[1], (BATCH, D), 1.0),
        'w_ada': nrm(ks[2], (DEPTH, D, 6 * D), 0.5 * D ** -0.5),
        'b_ada': nrm(ks[3], (DEPTH, 6 * D), 0.05),
        'norm_mix': 1.0 + nrm(ks[4], (DEPTH, D), 0.05),
        'norm_ffn': 1.0 + nrm(ks[5], (DEPTH, D), 0.05),
        'w_in': nrm(ks[6], (DEPTH, D, IN_COLS), D ** -0.5),
        'b_fgate': jax.random.uniform(ks[7], (DEPTH, N_HEADS_FOX), jnp.float32, 1.0, 6.0),
        'q_gain': 1.0 + nrm(ks[8], (DEPTH, N_HEADS, HEAD_DIM), 0.05),
        'k_gain': 1.0 + nrm(ks[9], (DEPTH, N_HEADS, HEAD_DIM), 0.05),
        'w_br_fox': nrm(ks[10], (DEPTH, wf, D), wf ** -0.5),
        'w_br_moba': nrm(ks[11], (DEPTH, wm, D), wm ** -0.5),
        'w_br_dil': nrm(ks[12], (DEPTH, wd, D), wd ** -0.5),
        'w_out': nrm(ks[13], (DEPTH, D, D), D ** -0.5),
        'w_ffn_gate': nrm(ks[14], (N_DENSE, D, D_FF), D ** -0.5),
        'w_ffn_up': nrm(ks[15], (N_DENSE, D, D_FF), D ** -0.5),
        'w_ffn_down': nrm(ks[16], (N_DENSE, D_FF, D), D_FF ** -0.5),
        'w_router': nrm(ks[17], (N_MOE, D, N_EXPERTS), D ** -0.5),
        'b_router': nrm(ks[18], (N_MOE, N_EXPERTS), 0.01),
        'w_exp_gate': nrm(ks[19], (N_MOE, N_EXPERTS, D, D_FF_EXPERT), D ** -0.5),
        'w_exp_up': nrm(ks[20], (N_MOE, N_EXPERTS, D, D_FF_EXPERT), D ** -0.5),
        'w_exp_down': nrm(ks[21], (N_MOE, N_EXPERTS, D_FF_EXPERT, D), D_FF_EXPERT ** -0.5),
    }


def reference(x, c, w_ada, b_ada, norm_mix, norm_ffn, w_in, b_fgate, q_gain, k_gain,
              w_br_fox, w_br_moba, w_br_dil, w_out, w_ffn_gate, w_ffn_up, w_ffn_down,
              w_router, b_router, w_exp_gate, w_exp_up, w_exp_down):
    cond = jax.nn.silu(c)
    for l in range(DEPTH):
        mod = (cond @ w_ada[l] + b_ada[l])[:, None, :]
        shift1, scale1, gate1, shift2, scale2, gate2 = jnp.split(mod, 6, axis=-1)
        h = _rmsnorm(x, norm_mix[l]) * (1 + scale1) + shift1
        x = x + gate1 * _token_mixer(h, w_in[l], b_fgate[l], q_gain[l], k_gain[l],
                                     w_br_fox[l], w_br_moba[l], w_br_dil[l], w_out[l])
        h = _rmsnorm(x, norm_ffn[l]) * (1 + scale2) + shift2
        i = l // 2
        if l % 2 == 0:
            y = _swiglu(h, w_ffn_gate[i], w_ffn_up[i], w_ffn_down[i])
        else:
            y = _moe_swiglu(h, w_router[i], b_router[i], w_exp_gate[i], w_exp_up[i], w_exp_down[i])
        x = x + gate2 * y
    return x
```

```cpp
#include <hip/hip_runtime.h>
#include <cstdio>
#include <cstdint>

constexpr int NB = 8, SEQ = 2048, DM = 1024, M = NB * SEQ, NH = 24, HD = 64, QW = 1536;
constexpr int IN_COLS = 7686, NIN = 7680, DFF = 2816, NE = 8;
constexpr int FOXW = 384, MOBW = 384, DILW = 256;
constexpr float RMS_EPS = 1e-6f, LOG2E = 1.4426950408889634f, C2 = 0.125f * 1.4426950408889634f;
constexpr int PMAX = 2 * M + NE * 256;
constexpr int NWAVES = 8, NTHR = 512;

constexpr size_t MiB = 1u << 20, KiB = 1024;
constexpr size_t WS_CTL = 0, CTL_ZERO_BYTES = 1 * MiB;
constexpr size_t WS_MODS = 1 * MiB;
constexpr size_t WS_FLOG = WS_MODS + 384 * KiB;
constexpr size_t WS_FCUM = WS_FLOG + 384 * KiB;
constexpr size_t WS_KMEAN = WS_FCUM + 384 * KiB;
constexpr size_t WS_SEL = WS_KMEAN + 96 * KiB;
constexpr size_t WS_WT = WS_SEL + 128 * KiB;
constexpr size_t WS_POS = WS_WT + 128 * KiB;
constexpr size_t WS_TOK = WS_POS + 128 * KiB;
constexpr size_t WS_WROW = WS_TOK + 136 * KiB;
constexpr size_t WS_TILEE = WS_WROW + 136 * KiB;
constexpr size_t WS_GAINS = WS_TILEE + 1024;
static_assert(WS_GAINS + 2 * 2 * 1536 * 4 <= 5 * MiB, "small buffers");
constexpr size_t WS_WIN = 5 * MiB;
constexpr size_t WS_WBF = 35 * MiB;
constexpr size_t WS_WBM = WS_WBF + 1536 * KiB;
constexpr size_t WS_WBD = WS_WBM + 1536 * KiB;
constexpr size_t WS_WOUT = 39 * MiB;
constexpr size_t WS_WF1 = 43 * MiB;
constexpr size_t WS_WF2 = 54 * MiB;
constexpr size_t WS_WE1 = WS_WF2 + 5632 * KiB;
constexpr size_t WS_WE2 = WS_WE1 + 88 * MiB;
constexpr size_t WS_H = WS_WE2 + 44 * MiB;
constexpr size_t WS_OF = WS_H, WS_OM = WS_H + 12 * MiB, WS_OD = WS_H + 24 * MiB;
constexpr size_t WS_Q = WS_H + 32 * MiB, WS_K = WS_Q + 48 * MiB, WS_V = WS_K + 48 * MiB;
constexpr size_t WS_G = WS_V + 48 * MiB;
constexpr size_t WS_END = WS_G + 96 * MiB;
constexpr size_t WS_Y32 = WS_Q;
constexpr size_t WS_YB = WS_V;
constexpr size_t WS_ACT = WS_Q;
constexpr size_t WS_HP = WS_H;
constexpr size_t WS_ACTE = WS_H + 68 * MiB;
static_assert(WS_ACTE + (size_t)PMAX * DFF * 2 <= WS_END, "moe act fits");
static_assert(WS_ACT + (size_t)M * DFF * 2 <= WS_V, "dense act fits under y");

constexpr int CW_BAR = 4096;
constexpr int RING_BYTES = 131072, MISC_OFF = RING_BYTES + 320, LDS_BYTES = 147456;

#define GAS __attribute__((address_space(1)))
#define LAS __attribute__((address_space(3)))
typedef unsigned short bf16;
typedef unsigned v4u __attribute__((ext_vector_type(4)));
typedef float f32x4 __attribute__((ext_vector_type(4)));
#define LDS_WAIT() asm volatile("s_waitcnt lgkmcnt(0)" ::: "memory")
#define VM_WAIT() asm volatile("s_waitcnt vmcnt(0)" ::: "memory")
__device__ __forceinline__ unsigned f2bf(float f) { unsigned u = __builtin_bit_cast(unsigned, f); return (u + 0x7fffu + ((u >> 16) & 1u)) >> 16; }
__device__ __forceinline__ unsigned pk2(float lo, float hi) { return f2bf(lo) | (f2bf(hi) << 16); }
__device__ __forceinline__ float bflo(unsigned w) { return __builtin_bit_cast(float, w << 16); }
__device__ __forceinline__ float bfhi(unsigned w) { return __builtin_bit_cast(float, w & 0xffff0000u); }
__device__ __forceinline__ float wave_sum(float v) {
#pragma unroll
    for (int o = 1; o < 64; o <<= 1) v += __shfl_xor(v, o);
    return v;
}
__device__ __forceinline__ float alibi_slope(int i) { return exp2f(-8.0f * (float)(i + 1) / 18.0f); }
namespace pg8 {
#define PG8_LAS __attribute__((address_space(3)))
typedef unsigned short bf16_t;
typedef short bf16x8 __attribute__((ext_vector_type(8)));
typedef float f32x4 __attribute__((ext_vector_type(4)));
typedef unsigned u32x4 __attribute__((ext_vector_type(4)));
constexpr int BM = 256, BK = 64, HALF = 128, HTB = HALF * BK * 2  , STAGE_BYTES = 8 * HTB, NXCD = 8, WGM = 8;

__host__ __device__ __forceinline__ int lds_byte(int r, int c) { const int st = (r >> 4) * 2 + (c >> 5), rr = r & 15, cc = c & 31, ob = rr * 64 + cc * 2; return st * 1024 + (ob ^ (((ob >> 9) & 1) << 5)); }
__host__ __device__ __forceinline__ void stage_rc(int b, int& R, int& C) { const int st = b / 1024, sb = b % 1024, swz = sb ^ (((sb >> 9) & 1) << 5); R = (st >> 1) * 16 + swz / 64; C = (st & 1) * 32 + (swz % 64) / 2; }
__host__ __device__ __forceinline__ int perm32(int rho) { const int n = rho >> 4, i = rho & 15; return 8 * (i >> 2) + 4 * n + (i & 3); }

struct Unit { int pm, pn; };
struct Gemm { const bf16_t* A; const bf16_t* Bt; int M, N, K; };

struct StaticOrder {
    int nM, nN, nwg, G, c;
    __host__ __device__ void init(int M, int N, int G_, int c_) { nM = M / BM; nN = N / BM; nwg = nM * nN; G = G_; c = c_; }
    __host__ __device__ bool next(int i, Unit& u) const {
        const long L = (long)i * G + c; if (L >= nwg) return false;
        int wgid = (int)L; { const int q = nwg / NXCD, r = nwg % NXCD, xcd = wgid % NXCD, off = wgid / NXCD; wgid = (xcd < r ? xcd * (q + 1) : r * (q + 1) + (xcd - r) * q) + off; }
        const int nig = WGM * nN, gid = wgid / nig, fm = gid * WGM, gsz = (nM - fm) < WGM ? (nM - fm) : WGM;
        u.pm = fm + ((wgid % nig) % gsz); u.pn = (wgid % nig) / gsz; return true;
    }
    __device__ __forceinline__ void a_ready(const Unit&) const {}
    __device__ __forceinline__ void done(const Unit&) const {}
};
template <class Epi, class Sched, bool ALIGN_EPI = false, bool SP2 = false>
__device__ __forceinline__ void gemm_phase(PG8_LAS unsigned char* lds, const Gemm g, const Sched& S, const Epi& E) {
    int tid_o = threadIdx.x; asm volatile("" : "+v"(tid_o));
    const int tid = tid_o, wid = __builtin_amdgcn_readfirstlane(tid >> 6), lane = tid & 63, wr = wid >> 2, wc = wid & 3, fr = lane & 15, fq = lane >> 4;
    const int K = g.K, nt = K / BK;
    unsigned voffA[2], voffB[2];
#pragma unroll
    for (int i = 0; i < 2; ++i) { int R, C; stage_rc(tid * 16 + i * 8192, R, C); const int Rb = Epi::PERM ? ((R & ~31) + perm32(R & 31)) : R;
        voffA[i] = (unsigned)(R * K + C) * 2u; voffB[i] = (unsigned)(Rb * K + C) * 2u; }
    const size_t kstep = (size_t)(BK * 2);
    const size_t hstep = (size_t)HALF * K * 2;
    const size_t tstep = 2 * hstep;
    const unsigned ldsw = (unsigned)wid * 1024u;
    const int aoff = lds_byte(wr * 64 + fr, fq * 8), boff = lds_byte(wc * 32 + fr, fq * 8);
#define PG8_SA(b, h) (((b) * 2 + (h)) * HTB)
#define PG8_SB(b, h) ((4 + (b) * 2 + (h)) * HTB)
#define PG8_STAGE(bufoff, gbase, voff) do { _Pragma("unroll") for (int _i = 0; _i < 2; ++_i) \
        __builtin_amdgcn_global_load_lds((const unsigned*)((const char*)(gbase) + (voff)[_i]), (PG8_LAS unsigned*)(lds + (bufoff) + ldsw + _i * 8192), 16, 0, 0); } while (0)
#define PG8_LDA(dst, b, h) do { _Pragma("unroll") for (int m = 0; m < 4; ++m) _Pragma("unroll") for (int k = 0; k < 2; ++k) dst[m][k] = *(const PG8_LAS bf16x8*)(lds + PG8_SA(b, h) + aoff + m * 2048 + k * 1024); } while (0)
#define PG8_LDB(dst, b, h) do { _Pragma("unroll") for (int n = 0; n < 2; ++n) _Pragma("unroll") for (int k = 0; k < 2; ++k) dst[n][k] = *(const PG8_LAS bf16x8*)(lds + PG8_SB(b, h) + boff + n * 2048 + k * 1024); } while (0)
#define PG8_MMA(ai, bj, At, Bt) do { __builtin_amdgcn_s_setprio(1); _Pragma("unroll") for (int m = 0; m < 4; ++m) _Pragma("unroll") for (int n = 0; n < 2; ++n) _Pragma("unroll") for (int k = 0; k < 2; ++k) \
        acc[ai][bj][m][n] = __builtin_amdgcn_mfma_f32_16x16x32_bf16(Bt[n][k], At[m][k], acc[ai][bj][m][n], 0, 0, 0); __builtin_amdgcn_s_setprio(0); } while (0)
#define PG8_WAIT_V(n) asm volatile("s_waitcnt vmcnt(" #n ")" ::: "memory")
#define PG8_WAIT_L(n) asm volatile("s_waitcnt lgkmcnt(" #n ")" ::: "memory")
#define PG8_BAR __builtin_amdgcn_s_barrier()
#define PG8_SCHED __builtin_amdgcn_sched_barrier(0)
    Unit cur, nxt; int ui = 0;
    if (!S.next(0, cur)) return;
    f32x4 acc[2][2][4][2];
#pragma unroll
    for (int a = 0; a < 2; ++a)
#pragma unroll
        for (int b = 0; b < 2; ++b)
#pragma unroll
            for (int m = 0; m < 4; ++m)
#pragma unroll
                for (int n = 0; n < 2; ++n) acc[a][b][m][n] = (f32x4){0.f, 0.f, 0.f, 0.f};
    bf16x8 At[4][2], B0[2][2], B1[2][2];
    const char* cA = (const char*)g.A + (size_t)cur.pm * tstep; const char* cB = (const char*)g.Bt + (size_t)cur.pn * tstep;
    S.a_ready(cur);
    if constexpr (SP2) {
        PG8_STAGE(PG8_SB(0, 0), cB, voffB); PG8_STAGE(PG8_SB(0, 1), cB + hstep, voffB); PG8_STAGE(PG8_SA(0, 0), cA, voffA); PG8_STAGE(PG8_SA(0, 1), cA + hstep, voffA);
        if (wr == 1) PG8_BAR;
        PG8_WAIT_V(2); PG8_BAR;
        PG8_STAGE(PG8_SB(1, 0), cB + kstep, voffB); PG8_STAGE(PG8_SA(1, 0), cA + kstep, voffA); PG8_STAGE(PG8_SB(1, 1), cB + hstep + kstep, voffB);
        PG8_WAIT_V(6); PG8_BAR;
    } else {
        PG8_STAGE(PG8_SB(0, 0), cB, voffB); PG8_STAGE(PG8_SA(0, 0), cA, voffA); PG8_STAGE(PG8_SB(0, 1), cB + hstep, voffB); PG8_STAGE(PG8_SA(0, 1), cA + hstep, voffA);
        if (wr == 1) PG8_BAR;
        PG8_WAIT_V(4); PG8_BAR;
        PG8_STAGE(PG8_SB(1, 0), cB + kstep, voffB); PG8_STAGE(PG8_SA(1, 0), cA + kstep, voffA); PG8_STAGE(PG8_SB(1, 1), cB + hstep + kstep, voffB);
        PG8_WAIT_V(6); PG8_BAR;
    }
    for (;;) {
        const bool has_next = S.next(ui + 1, nxt);
        const char* nA = has_next ? (const char*)g.A + (size_t)nxt.pm * tstep : cA; const char* nB = has_next ? (const char*)g.Bt + (size_t)nxt.pn * tstep : cB;
        for (int t = 0; t < nt; t += 2) {
            const bool last = (t == nt - 2);
            const char* a1 = cA + (size_t)(t + 1) * kstep;
            const char* a2 = last ? nA : cA + (size_t)(t + 2) * kstep; const char* b2 = last ? nB : cB + (size_t)(t + 2) * kstep;
            const char* a3 = a2 + kstep; const char* b3 = b2 + kstep;
            if (last && has_next) S.a_ready(nxt);
            if constexpr (SP2) {
            PG8_LDB(B0, 0, 0); PG8_LDB(B1, 0, 1); PG8_SCHED; PG8_LDA(At, 0, 0); PG8_STAGE(PG8_SA(1, 1), a1 + hstep, voffA);
            PG8_WAIT_V(8); PG8_WAIT_L(0); PG8_BAR; PG8_MMA(0, 0, At, B0); PG8_MMA(0, 1, At, B1); PG8_BAR; PG8_SCHED;
            PG8_LDA(At, 0, 1); PG8_STAGE(PG8_SB(0, 0), b2, voffB); PG8_STAGE(PG8_SB(0, 1), b2 + hstep, voffB); PG8_STAGE(PG8_SA(0, 0), a2, voffA);
            PG8_WAIT_V(8); PG8_WAIT_L(0); PG8_BAR; PG8_MMA(1, 0, At, B0); PG8_MMA(1, 1, At, B1); PG8_BAR; PG8_SCHED;
            PG8_LDB(B0, 1, 0); PG8_LDB(B1, 1, 1); PG8_SCHED; PG8_LDA(At, 1, 0); PG8_STAGE(PG8_SA(0, 1), a2 + hstep, voffA);
            PG8_WAIT_V(8); PG8_WAIT_L(0); PG8_BAR; PG8_MMA(0, 0, At, B0); PG8_MMA(0, 1, At, B1); PG8_BAR; PG8_SCHED;
            PG8_LDA(At, 1, 1); PG8_STAGE(PG8_SB(1, 0), b3, voffB); PG8_STAGE(PG8_SB(1, 1), b3 + hstep, voffB); PG8_STAGE(PG8_SA(1, 0), a3, voffA);
            PG8_WAIT_V(8); PG8_WAIT_L(0); PG8_BAR; PG8_MMA(1, 0, At, B0); PG8_MMA(1, 1, At, B1); PG8_BAR; PG8_SCHED;
            } else {
            PG8_LDB(B0, 0, 0); PG8_SCHED; PG8_LDA(At, 0, 0); PG8_STAGE(PG8_SA(1, 1), a1 + hstep, voffA);
            PG8_WAIT_L(8); PG8_BAR; PG8_WAIT_L(0); PG8_MMA(0, 0, At, B0); PG8_BAR; PG8_SCHED;
            PG8_LDB(B1, 0, 1); PG8_STAGE(PG8_SB(0, 0), b2, voffB);
            PG8_BAR; PG8_WAIT_L(0); PG8_MMA(0, 1, At, B1); PG8_BAR;
            PG8_LDA(At, 0, 1); PG8_STAGE(PG8_SA(0, 0), a2, voffA);
            PG8_BAR; PG8_WAIT_L(0); PG8_MMA(1, 0, At, B0); PG8_BAR; PG8_SCHED;
            PG8_STAGE(PG8_SB(0, 1), b2 + hstep, voffB);
            PG8_WAIT_V(6); PG8_BAR; PG8_MMA(1, 1, At, B1); PG8_BAR;
            PG8_LDB(B0, 1, 0); PG8_SCHED; PG8_LDA(At, 1, 0); PG8_STAGE(PG8_SA(0, 1), a2 + hstep, voffA);
            PG8_WAIT_L(8); PG8_BAR; PG8_WAIT_L(0); PG8_MMA(0, 0, At, B0); PG8_BAR; PG8_SCHED;
            PG8_LDB(B1, 1, 1); PG8_STAGE(PG8_SB(1, 0), b3, voffB);
            PG8_BAR; PG8_WAIT_L(0); PG8_MMA(0, 1, At, B1); PG8_BAR;
            PG8_LDA(At, 1, 1); PG8_STAGE(PG8_SA(1, 0), a3, voffA);
            PG8_BAR; PG8_WAIT_L(0); PG8_MMA(1, 0, At, B0); PG8_BAR; PG8_SCHED;
            PG8_STAGE(PG8_SB(1, 1), b3 + hstep, voffB);
            PG8_WAIT_V(6); PG8_BAR; PG8_MMA(1, 1, At, B1); PG8_BAR;
            }
        }
        if constexpr (ALIGN_EPI) { if (wr == 0) PG8_BAR; }
        if constexpr (!Epi::AFTER_DRAIN) { E(acc, cur, wr, wc, fr, fq); S.done(cur); }
        if (!has_next) break;
#pragma unroll
        for (int a = 0; a < 2; ++a)
#pragma unroll
            for (int b = 0; b < 2; ++b)
#pragma unroll
                for (int m = 0; m < 4; ++m)
#pragma unroll
                    for (int n = 0; n < 2; ++n) acc[a][b][m][n] = (f32x4){0.f, 0.f, 0.f, 0.f};
        cur = nxt; cA = nA; cB = nB; ++ui;
        if constexpr (ALIGN_EPI) { if (wr == 1) PG8_BAR; }
    }
    PG8_WAIT_V(0);
    if constexpr (!ALIGN_EPI) { if (wr == 0) PG8_BAR; }
    PG8_BAR;
    if constexpr (Epi::AFTER_DRAIN) { E.fused(acc, cur, wr, wc, fr, fq, lds, wid, lane); S.done(cur); }
#undef PG8_SA
#undef PG8_SB
#undef PG8_STAGE
#undef PG8_LDA
#undef PG8_LDB
#undef PG8_MMA
#undef PG8_WAIT_V
#undef PG8_WAIT_L
#undef PG8_BAR
#undef PG8_SCHED
}
}

namespace pg8 {
struct EpiInProj {
    static constexpr bool PERM = true, AFTER_DRAIN = false;
    bf16_t *Q, *G; const float *gains;
    __device__ __forceinline__ void operator()(const f32x4 (&acc)[2][2][4][2], const Unit& u, int wr, int wc, int fr, int fq) const {
        const int row0 = u.pm * BM + wr * 64 + fr;
        if (u.pn < 18) {
            const int sec = u.pn / 6, head = (u.pn % 6) * 4 + wc;
            bf16_t* dst = Q + (size_t)sec * ((size_t)M * QW) + head * 64 + fq * 8;
            f32x4 gn[2][2];
#pragma unroll
            for (int bj = 0; bj < 2; ++bj)
#pragma unroll
                for (int n = 0; n < 2; ++n) {
                    if (sec < 2) gn[bj][n] = *(const f32x4*)(gains + sec * QW + head * 64 + bj * 32 + fq * 8 + 4 * n);
                    else gn[bj][n] = (f32x4){1.f, 1.f, 1.f, 1.f};
                }
#pragma unroll
            for (int ai = 0; ai < 2; ++ai)
#pragma unroll
                for (int m = 0; m < 4; ++m) {
                    float rs = 1.f;
                    if (sec < 2) {
                        float ss = 0.f;
#pragma unroll
                        for (int bj = 0; bj < 2; ++bj)
#pragma unroll
                            for (int n = 0; n < 2; ++n) { const f32x4 x = acc[ai][bj][m][n]; ss += (x[0] * x[0] + x[1] * x[1]) + (x[2] * x[2] + x[3] * x[3]); }
                        ss += __shfl_xor(ss, 16); ss += __shfl_xor(ss, 32);
                        rs = 1.0f / sqrtf(ss * (1.0f / 64.0f) + RMS_EPS);
                    }
                    bf16_t* rowp = dst + (size_t)(row0 + ai * HALF + m * 16) * QW;
#pragma unroll
                    for (int bj = 0; bj < 2; ++bj) {
                        const f32x4 v0 = acc[ai][bj][m][0] * rs * gn[bj][0], v1 = acc[ai][bj][m][1] * rs * gn[bj][1];
                        u32x4 w; w.x = pk2(v0[0], v0[1]); w.y = pk2(v0[2], v0[3]); w.z = pk2(v1[0], v1[1]); w.w = pk2(v1[2], v1[3]);
                        *(u32x4*)(rowp + bj * 32) = w;
                    }
                    asm volatile("" ::: "memory");
                }
        } else {
            const int col0 = (u.pn - 18) * BM + wc * 32 + fq * 8;
#pragma unroll
            for (int ai = 0; ai < 2; ++ai)
#pragma unroll
                for (int m = 0; m < 4; ++m) {
                    bf16_t* rowp = G + (size_t)(row0 + ai * HALF + m * 16) * 3072 + col0;
#pragma unroll
                    for (int bj = 0; bj < 2; ++bj) {
                        float s[8];
#pragma unroll
                        for (int n = 0; n < 2; ++n)
#pragma unroll
                            for (int i = 0; i < 4; ++i) s[4 * n + i] = 1.0f / (1.0f + __expf(-acc[ai][bj][m][n][i]));
                        u32x4 w; w.x = pk2(s[0], s[1]); w.y = pk2(s[2], s[3]); w.z = pk2(s[4], s[5]); w.w = pk2(s[6], s[7]);
                        *(u32x4*)(rowp + bj * HALF) = w;
                    }
                    asm volatile("" ::: "memory");
                }
        }
    }
};
template <int MODE> struct EpiBranch {
    static constexpr bool PERM = true, AFTER_DRAIN = false;
    float* Y32; bf16_t* YB; const bf16_t* G; int goff;
    __device__ __forceinline__ void operator()(const f32x4 (&acc)[2][2][4][2], const Unit& u, int wr, int wc, int fr, int fq) const {
        const int row0 = u.pm * BM + wr * 64 + fr, col0 = u.pn * BM + wc * 32 + fq * 8;
#pragma unroll
        for (int ai = 0; ai < 2; ++ai)
#pragma unroll
            for (int m = 0; m < 4; ++m) {
                const size_t row = (size_t)(row0 + ai * HALF + m * 16);
#pragma unroll
                for (int bj = 0; bj < 2; ++bj) {
                    const int col = col0 + bj * HALF;
                    const u32x4 gw = *(const u32x4*)(G + row * 3072 + goff + col);
                    f32x4 g0 = {bflo(gw.x), bfhi(gw.x), bflo(gw.y), bfhi(gw.y)}, g1 = {bflo(gw.z), bfhi(gw.z), bflo(gw.w), bfhi(gw.w)};
                    f32x4 v0 = acc[ai][bj][m][0] * g0, v1 = acc[ai][bj][m][1] * g1;
                    float* yp = Y32 + row * DM + col;
                    if (MODE >= 1) { v0 = v0 + *(const f32x4*)yp; v1 = v1 + *(const f32x4*)(yp + 4); }
                    if (MODE <= 1) { *(f32x4*)yp = v0; *(f32x4*)(yp + 4) = v1; }
                    else { u32x4 w; w.x = pk2(v0[0], v0[1]); w.y = pk2(v0[2], v0[3]); w.z = pk2(v1[0], v1[1]); w.w = pk2(v1[2], v1[3]); *(u32x4*)(YB + row * DM + col) = w; }
                }
                asm volatile("" ::: "memory");
            }
    }
};
struct EpiResid {
    static constexpr bool PERM = true, AFTER_DRAIN = false;
    const float* xin; float* out; const float* gate;
    __device__ __forceinline__ void operator()(const f32x4 (&acc)[2][2][4][2], const Unit& u, int wr, int wc, int fr, int fq) const {
        const int row0 = u.pm * BM + wr * 64 + fr, col0 = u.pn * BM + wc * 32 + fq * 8;
        const float* gp = gate + (size_t)((u.pm * BM) / SEQ) * 6144;
#pragma unroll
        for (int bj = 0; bj < 2; ++bj) {
            const int col = col0 + bj * HALF;
            const f32x4 g0 = *(const f32x4*)(gp + col), g1 = *(const f32x4*)(gp + col + 4);
#pragma unroll
            for (int ai = 0; ai < 2; ++ai)
#pragma unroll
                for (int m = 0; m < 4; ++m) {
                    const size_t off = (size_t)(row0 + ai * HALF + m * 16) * DM + col;
                    const f32x4 x0 = *(const f32x4*)(xin + off), x1 = *(const f32x4*)(xin + off + 4);
                    *(f32x4*)(out + off) = x0 + g0 * acc[ai][bj][m][0];
                    *(f32x4*)(out + off + 4) = x1 + g1 * acc[ai][bj][m][1];
                    asm volatile("" ::: "memory");
                }
        }
    }
};
struct EpiSwiglu {
    static constexpr bool PERM = true, AFTER_DRAIN = false;
    bf16_t* ACT; int npn;
    __device__ __forceinline__ void operator()(const f32x4 (&acc)[2][2][4][2], const Unit& u, int wr, int wc, int fr, int fq) const {
        const int row0 = u.pm * BM + wr * 64 + fr, col0 = (u.pn % npn) * HALF + wc * 32 + fq * 8;
#pragma unroll
        for (int ai = 0; ai < 2; ++ai)
#pragma unroll
            for (int m = 0; m < 4; ++m) {
                float s[8];
#pragma unroll
                for (int n = 0; n < 2; ++n)
#pragma unroll
                    for (int i = 0; i < 4; ++i) { const float g = acc[ai][0][m][n][i], up = acc[ai][1][m][n][i]; s[4 * n + i] = g / (1.0f + __expf(-g)) * up; }
                u32x4 w; w.x = pk2(s[0], s[1]); w.y = pk2(s[2], s[3]); w.z = pk2(s[4], s[5]); w.w = pk2(s[6], s[7]);
                *(u32x4*)(ACT + (size_t)(row0 + ai * HALF + m * 16) * DFF + col0) = w;
                asm volatile("" ::: "memory");
            }
    }
};
struct EpiMoeOut {
    static constexpr bool PERM = true, AFTER_DRAIN = false;
    float* out; const float* gate; const int* tok; const float* wrow;
    __device__ __forceinline__ void operator()(const f32x4 (&acc)[2][2][4][2], const Unit& u, int wr, int wc, int fr, int fq) const {
        const int row0 = u.pm * BM + wr * 64 + fr, col0 = (u.pn & 3) * BM + wc * 32 + fq * 8;
#pragma unroll
        for (int ai = 0; ai < 2; ++ai)
#pragma unroll
            for (int m = 0; m < 4; ++m) {
                const int r = row0 + ai * HALF + m * 16; const int id = tok[r];
                if (id >= 0) {
                    const int t = id >> 1; const float w = wrow[r]; const float* gp = gate + (size_t)(t / SEQ) * 6144;
#pragma unroll
                    for (int bj = 0; bj < 2; ++bj)
#pragma unroll
                        for (int n = 0; n < 2; ++n) {
                            const int col = col0 + bj * HALF + 4 * n; const f32x4 g = *(const f32x4*)(gp + col);
#pragma unroll
                            for (int i = 0; i < 4; ++i) __hip_atomic_fetch_add(out + (size_t)t * DM + col + i, g[i] * w * acc[ai][bj][m][n][i], __ATOMIC_RELAXED, __HIP_MEMORY_SCOPE_AGENT);
                        }
                }
                asm volatile("" ::: "memory");
            }
    }
};
struct MoeOrder {
    StaticOrder so; const int* tmap; int npn;
    __device__ __forceinline__ bool next(int i, Unit& u) const { if (!so.next(i, u)) return false; u.pn += tmap[u.pm] * npn; return true; }
    __device__ __forceinline__ void a_ready(const Unit&) const {}
    __device__ __forceinline__ void done(const Unit&) const {}
};
}
#define XB_TMO      128
#define XB_XCNT(j)  (256  + 64 * (j))
#define XB_XSUB(j)  (1280 + 64 * (j))
#define XB_XGEN(j)  (2304 + 64 * (j))
#define XB_TOP      3328
#define XB_TOPGEN   3392
#define XCD_BAR_WORDS 3456
#define XB_SPIN_CAP (1u << 18)

__device__ __forceinline__ unsigned xb_ld(unsigned* p)              { return __hip_atomic_load(p, __ATOMIC_RELAXED, __HIP_MEMORY_SCOPE_AGENT); }
__device__ __forceinline__ unsigned xb_add(unsigned* p, unsigned v) { return __hip_atomic_fetch_add(p, v, __ATOMIC_RELAXED, __HIP_MEMORY_SCOPE_AGENT); }
__device__ __forceinline__ unsigned xb_xcc_id() { return (unsigned)__builtin_amdgcn_s_getreg((3 << 11) | 20) & 0xFu; }
#define XB_SPIN(cond, bar) do { unsigned _sp = 0; while (cond) { __builtin_amdgcn_s_sleep(1); \
    if ((++_sp & 255u) == 0u) { if (xb_ld(&(bar)[XB_TMO])) break; if (_sp > XB_SPIN_CAP) { atomicAdd(&(bar)[XB_TMO], 1u); break; } } } } while (0)

struct XcdBarrier {
    unsigned* bar; unsigned x;
    volatile LAS unsigned* st;
};

__device__ __forceinline__ XcdBarrier xcd_barrier_post(unsigned* bar, volatile LAS unsigned* st) {
    XcdBarrier b; b.bar = bar; b.x = xb_xcc_id(); b.st = st;
    if (threadIdx.x == 0) (void)xb_add(&bar[XB_XCNT(b.x)], 1u);
    return b;
}
__device__ __forceinline__ void xcd_barrier_complete(unsigned* bar, unsigned x, unsigned& nloc, unsigned& nx) {
    const unsigned G = gridDim.x * gridDim.y * gridDim.z;
    unsigned sum, cnt, mine, sp = 0u;
    for (;;) {
        sum = 0u; cnt = 0u; mine = 0u;
#pragma unroll
        for (unsigned j = 0; j < 16; ++j) { const unsigned c = xb_ld(&bar[XB_XCNT(j)]); sum += c; cnt += (c > 0u) ? 1u : 0u; mine = (j == x) ? c : mine; }
        if (sum == G) break;
        __builtin_amdgcn_s_sleep(1);
        if ((++sp & 255u) == 0u) { if (xb_ld(&bar[XB_TMO])) break; if (sp > XB_SPIN_CAP) { atomicAdd(&bar[XB_TMO], 1u); break; } }
    }
    nloc = mine > 0u ? mine : 1u; nx = cnt > 0u ? cnt : 1u;
}

__device__ __forceinline__ void xcd_barrier(const XcdBarrier& b) {
    asm volatile("s_waitcnt vmcnt(0)" ::: "memory");
    __syncthreads();
    if (threadIdx.x == 0) {
        unsigned* bar = b.bar;
        __builtin_amdgcn_s_waitcnt(0);
        unsigned nloc = b.st[0], nx = b.st[1];
        if (nloc == 0u) { xcd_barrier_complete(bar, b.x, nloc, nx); b.st[0] = nloc; b.st[1] = nx; }
        const unsigned old = xb_add(&bar[XB_XSUB(b.x)], 1u);
        const unsigned gen = old / nloc;
        if (old + 1u == (gen + 1u) * nloc) {
            __builtin_amdgcn_fence(__ATOMIC_RELEASE, "agent");
            asm volatile("s_waitcnt vmcnt(0)" ::: "memory");
            const unsigned og = xb_add(&bar[XB_TOP], 1u);
            const unsigned tg = og / nx;
            if (og + 1u == (tg + 1u) * nx) xb_add(&bar[XB_TOPGEN], 1u);
            else XB_SPIN(xb_ld(&bar[XB_TOPGEN]) == tg, bar);
            __builtin_amdgcn_fence(__ATOMIC_ACQUIRE, "agent");
            xb_add(&bar[XB_XGEN(b.x)], 1u);
            asm volatile("s_waitcnt vmcnt(0)" ::: "memory");
        } else {
            XB_SPIN(xb_ld(&bar[XB_XGEN(b.x)]) == gen, bar);
            __builtin_amdgcn_fence(__ATOMIC_ACQUIRE, "agent");
            asm volatile("s_waitcnt vmcnt(0)" ::: "memory");
        }
    }
    __syncthreads();
}

__device__ __forceinline__ void tr_item(const float* W, size_t ldw, int col0, int k0, bf16* dst, int ldk, LAS float* scr, int lane) {
#pragma unroll 8
    for (int i = 0; i < 32; ++i) { const int kk = 2 * i + (lane >> 5); scr[kk * 33 + (lane & 31)] = W[(size_t)(k0 + kk) * ldw + col0 + (lane & 31)]; }
    LDS_WAIT(); asm volatile("" ::: "memory");
    const int c = lane & 7;
#pragma unroll
    for (int j = 0; j < 4; ++j) { const int n = (lane >> 3) + 8 * j; const LAS float* s = scr + (8 * c) * 33 + n;
        v4u o; o.x = pk2(s[0 * 33], s[1 * 33]); o.y = pk2(s[2 * 33], s[3 * 33]); o.z = pk2(s[4 * 33], s[5 * 33]); o.w = pk2(s[6 * 33], s[7 * 33]);
        *(GAS v4u*)(dst + (size_t)n * ldk + k0 + 8 * c) = o; }
    LDS_WAIT(); asm volatile("" ::: "memory");
}
__device__ __forceinline__ int map_qkv(int c0) { const int sec = c0 / QW, cs = c0 % QW, head = cs >> 6, bj = (cs >> 5) & 1; return sec * QW + (head >> 2) * 256 + bj * 128 + (head & 3) * 32; }
__device__ __forceinline__ int map_gu(int c0, int up) { return (c0 >> 7) * 256 + up * 128 + (c0 & 96); }

struct KArgs { const float* in[22]; float* out; unsigned char* ws; int ph_lo, ph_hi; };
__device__ __forceinline__ const float* karg_ptr(int i) { int j = i; asm volatile("" : "+s"(j));
    const __attribute__((address_space(4))) unsigned long long* kp = (const __attribute__((address_space(4))) unsigned long long*)__builtin_amdgcn_kernarg_segment_ptr(); return (const float*)kp[j]; }
#define AIN(k) karg_ptr(k)
#define AOUT ((float*)karg_ptr(22))

__device__ __forceinline__ void ffn_conv(const float* wg, const float* wu, const float* wd, bf16* w1t, bf16* w2t, int r, LAS float* scr, int lane) {
    if (r < 1408) { const int kb = r / 88, nb = r % 88; tr_item(wg, DFF, 32 * nb, 64 * kb, w1t + (size_t)map_gu(32 * nb, 0) * DM, DM, scr, lane); return; } r -= 1408;
    if (r < 1408) { const int kb = r / 88, nb = r % 88; tr_item(wu, DFF, 32 * nb, 64 * kb, w1t + (size_t)map_gu(32 * nb, 1) * DM, DM, scr, lane); return; } r -= 1408;
    { const int kb = r / 32, nb = r % 32; tr_item(wd, DM, 32 * nb, 64 * kb, w2t + (size_t)(32 * nb) * DFF, DFF, scr, lane); }
}

__device__ __forceinline__ void phase_prologue(const KArgs& a, LAS unsigned char* lds, int tid, int lane, int wave) {
    unsigned char* ws = a.ws;
    {
        LAS float* cond = (LAS float*)lds;
        LAS float* part = (LAS float*)(lds + 32768);
        const float* c = AIN(1);
        for (int i = tid; i < NB * DM; i += NTHR) { const float v = c[i]; cond[i] = v / (1.0f + __expf(-v)); }
        __syncthreads();
        float* mods = (float*)(ws + WS_MODS);
        for (int u = blockIdx.x; u < 2 * 96; u += gridDim.x) {
            const int l = u / 96, cg = u % 96, col = tid & 63, ks = tid >> 6;
            const float* w = AIN(2) + (size_t)l * DM * 6144 + cg * 64 + col;
            float acc[8];
#pragma unroll
            for (int b = 0; b < 8; ++b) acc[b] = 0.f;
            for (int k = ks * 128; k < ks * 128 + 128; ++k) { const float wv = w[(size_t)k * 6144];
#pragma unroll
                for (int b = 0; b < 8; ++b) acc[b] += cond[b * DM + k] * wv; }
#pragma unroll
            for (int b = 0; b < 8; ++b) part[(ks * 8 + b) * 64 + col] = acc[b];
            __syncthreads();
            { const int b = tid >> 6; float s = 0.f;
#pragma unroll
              for (int k2 = 0; k2 < 8; ++k2) s += part[(k2 * 8 + b) * 64 + col];
              mods[((size_t)l * NB + b) * 6144 + cg * 64 + col] = s + AIN(3)[(size_t)l * 6144 + cg * 64 + col]; }
            __syncthreads();
        }
        __syncthreads();
    }
    if (blockIdx.x == 0) { float* gains = (float*)(ws + WS_GAINS);
        for (int i = tid; i < 2 * 2 * QW; i += NTHR) { const int l = i / (2 * QW), r = i % (2 * QW); gains[i] = (r < QW) ? AIN(8)[l * QW + r] * C2 : AIN(9)[l * QW + r - QW]; } }
    LAS float* scr = (LAS float*)(lds + wave * 16384);
    const int gw = blockIdx.x * NWAVES + wave, NGW = gridDim.x * NWAVES;
    constexpr int PER_LAYER = 2304 + 1536 + 192 + 192 + 128 + 512, NITEMS = 2 * PER_LAYER + 9 * 4224;
    for (int it = gw; it < NITEMS; it += NGW) {
        if (it < 2 * PER_LAYER) {
            const int l = it / PER_LAYER; int r = it % PER_LAYER;
            const float* win = AIN(6) + (size_t)l * DM * IN_COLS; bf16* wint = (bf16*)(ws + WS_WIN) + (size_t)l * NIN * DM;
            if (r < 2304) { const int kb = r / 144, nb = r % 144; tr_item(win, IN_COLS, 32 * nb, 64 * kb, wint + (size_t)map_qkv(32 * nb) * DM, DM, scr, lane); continue; } r -= 2304;
            if (r < 1536) { const int kb = r / 96, nb = r % 96; tr_item(win, IN_COLS, 4614 + 32 * nb, 64 * kb, wint + (size_t)(4608 + 32 * nb) * DM, DM, scr, lane); continue; } r -= 1536;
            if (r < 192) { const int kb = r / 32, nb = r % 32; tr_item(AIN(10) + (size_t)l * FOXW * DM, DM, 32 * nb, 64 * kb, (bf16*)(ws + WS_WBF) + (size_t)l * DM * FOXW + (size_t)(32 * nb) * FOXW, FOXW, scr, lane); continue; } r -= 192;
            if (r < 192) { const int kb = r / 32, nb = r % 32; tr_item(AIN(11) + (size_t)l * MOBW * DM, DM, 32 * nb, 64 * kb, (bf16*)(ws + WS_WBM) + (size_t)l * DM * MOBW + (size_t)(32 * nb) * MOBW, MOBW, scr, lane); continue; } r -= 192;
            if (r < 128) { const int kb = r / 32, nb = r % 32; tr_item(AIN(12) + (size_t)l * DILW * DM, DM, 32 * nb, 64 * kb, (bf16*)(ws + WS_WBD) + (size_t)l * DM * DILW + (size_t)(32 * nb) * DILW, DILW, scr, lane); continue; } r -= 128;
            { const int kb = r / 32, nb = r % 32; tr_item(AIN(13) + (size_t)l * DM * DM, DM, 32 * nb, 64 * kb, (bf16*)(ws + WS_WOUT) + (size_t)l * DM * DM + (size_t)(32 * nb) * DM, DM, scr, lane); }
        } else {
            const int q = it - 2 * PER_LAYER, ex = q / 4224, r = q % 4224;
            if (ex == 0) ffn_conv(AIN(14), AIN(15), AIN(16), (bf16*)(ws + WS_WF1), (bf16*)(ws + WS_WF2), r, scr, lane);
            else { const size_t e = ex - 1; ffn_conv(AIN(19) + e * DM * DFF, AIN(20) + e * DM * DFF, AIN(21) + e * DFF * DM,
                                                     (bf16*)(ws + WS_WE1) + e * 5632 * DM, (bf16*)(ws + WS_WE2) + e * DM * DFF, r, scr, lane); }
        }
    }
}

template <int MODE>
__device__ __forceinline__ void phase_norm(const float* xs, const float* gain, const float* mods  , int shift_off, int scale_off,
                                           bf16* hout, const float* win, const float* bfg, float* flog, const float* wr, const float* br, int* sel, float* wt, const int* pos,
                                           LAS unsigned char* lds, int tid, int lane, int wave) {
    LAS float* wf = (LAS float*)lds;
    if (MODE == 0) { for (int i = tid; i < 6 * DM; i += NTHR) { const int hh = i / DM, k = i % DM; wf[i] = win[(size_t)k * IN_COLS + 4608 + hh]; } __syncthreads(); }
    if (MODE == 2) { for (int i = tid; i < 8 * DM; i += NTHR) { const int e = i / DM, k = i % DM; wf[i] = wr[(size_t)k * NE + e]; } __syncthreads(); }
    const int gw = blockIdx.x * NWAVES + wave, NGW = gridDim.x * NWAVES;
    const int tpw = (M + NGW - 1) / NGW;
    f32x4 g[4], sc[4], sh[4]; int curb = -1;
#pragma unroll
    for (int j = 0; j < 4; ++j) g[j] = *(const f32x4*)(gain + 4 * lane + 256 * j);
    for (int m = gw * tpw; m < (gw + 1) * tpw && m < M; ++m) {
        const int b = m / SEQ;
        if (b != curb) { curb = b;
#pragma unroll
            for (int j = 0; j < 4; ++j) { sc[j] = *(const f32x4*)(mods + (size_t)b * 6144 + scale_off + 4 * lane + 256 * j); sh[j] = *(const f32x4*)(mods + (size_t)b * 6144 + shift_off + 4 * lane + 256 * j); } }
        f32x4 v[4]; float ss = 0.f;
#pragma unroll
        for (int j = 0; j < 4; ++j) { v[j] = *(const f32x4*)(xs + (size_t)m * DM + 4 * lane + 256 * j); ss += (v[j].x * v[j].x + v[j].y * v[j].y) + (v[j].z * v[j].z + v[j].w * v[j].w); }
        const float rstd = 1.0f / sqrtf(wave_sum(ss) * (1.0f / DM) + RMS_EPS);
#pragma unroll
        for (int j = 0; j < 4; ++j) v[j] = v[j] * rstd * g[j] * (sc[j] + 1.0f) + sh[j];
        if (MODE == 0 || MODE == 1) {
            GAS unsigned long long* o8 = (GAS unsigned long long*)(hout + (size_t)m * DM) + lane;
#pragma unroll
            for (int j = 0; j < 4; ++j) o8[64 * j] = (unsigned long long)pk2(v[j].x, v[j].y) | ((unsigned long long)pk2(v[j].z, v[j].w) << 32);
        }
        if (MODE == 3) {
#pragma unroll
            for (int k2 = 0; k2 < 2; ++k2) { GAS unsigned long long* o8 = (GAS unsigned long long*)(hout + (size_t)pos[2 * m + k2] * DM) + lane;
#pragma unroll
                for (int j = 0; j < 4; ++j) o8[64 * j] = (unsigned long long)pk2(v[j].x, v[j].y) | ((unsigned long long)pk2(v[j].z, v[j].w) << 32); }
        }
        if (MODE == 0) {
            const int t = m % SEQ;
#pragma unroll
            for (int hh = 0; hh < 6; ++hh) { float d = 0.f;
#pragma unroll
                for (int j = 0; j < 4; ++j) { const f32x4 w = *(const LAS f32x4*)(wf + hh * DM + 4 * lane + 256 * j); d += (v[j].x * w.x + v[j].y * w.y) + (v[j].z * w.z + v[j].w * w.w); }
                d = wave_sum(d); if (lane == 0) flog[((size_t)b * 6 + hh) * SEQ + t] = d + bfg[hh]; }
        }
        if (MODE == 2) {
            float lg[8];
#pragma unroll
            for (int e = 0; e < 8; ++e) { float d = 0.f;
#pragma unroll
                for (int j = 0; j < 4; ++j) { const f32x4 w = *(const LAS f32x4*)(wf + e * DM + 4 * lane + 256 * j); d += (v[j].x * w.x + v[j].y * w.y) + (v[j].z * w.z + v[j].w * w.w); }
                lg[e] = wave_sum(d) + br[e]; }
            int i0 = 0; float v0 = lg[0];
#pragma unroll
            for (int e = 1; e < 8; ++e) if (lg[e] > v0) { v0 = lg[e]; i0 = e; }
            int i1 = -1; float v1 = -3.0e38f;
#pragma unroll
            for (int e = 0; e < 8; ++e) if (e != i0 && lg[e] > v1) { v1 = lg[e]; i1 = e; }
            const float e1 = __expf(v1 - v0), w0 = 1.0f / (1.0f + e1), w1 = e1 / (1.0f + e1);
            if (lane == 0) { sel[2 * m] = i0; sel[2 * m + 1] = i1; wt[2 * m] = w0; wt[2 * m + 1] = w1; }
        }
    }
}

__device__ __forceinline__ void phase_scan(const float* flog, float* fcum, const bf16* K, float* kmean, LAS unsigned char* lds, int tid, int lane, int wave) {
    LAS float* wtot = (LAS float*)lds;
    for (int u = blockIdx.x; u < NB * 6; u += gridDim.x) {
        const f32x4 f = *(const f32x4*)(flog + (size_t)u * SEQ + 4 * tid);
        float a[4];
#pragma unroll
        for (int i = 0; i < 4; ++i) { const float x = f[i]; a[i] = (fminf(x, 0.f) - log1pf(expf(-fabsf(x)))) * LOG2E; }
        a[1] += a[0]; a[2] += a[1]; a[3] += a[2];
        float incl = a[3];
#pragma unroll
        for (int o = 1; o < 64; o <<= 1) { const float t = __shfl_up(incl, o); if (lane >= o) incl += t; }
        if (lane == 63) wtot[wave] = incl;
        __syncthreads();
        float base = incl - a[3];
        for (int w = 0; w < wave; ++w) base += wtot[w];
        f32x4 o = {a[0] + base, a[1] + base, a[2] + base, a[3] + base};
        *(f32x4*)(fcum + (size_t)u * SEQ + 4 * tid) = o;
        __syncthreads();
    }
    const int gw = blockIdx.x * NWAVES + wave, NGW = gridDim.x * NWAVES;
    for (int it = gw; it < NB * 6 * 8; it += NGW) {
        const int b = it / 48, hm = (it / 8) % 6, blk = it % 8;
        const bf16* kp = K + ((size_t)b * SEQ + blk * 256) * QW + (6 + hm) * 64 + lane;
        float s = 0.f;
        for (int i = 0; i < 256; ++i) s += bflo((unsigned)kp[(size_t)i * QW]);
        kmean[(size_t)it * 64 + lane] = s * (1.0f / 256.0f);
    }
}

#define NA_LOADQ(qptr) do { const uint4* q4_ = (const uint4*)(qptr); _Pragma("unroll") for (int c_ = 0; c_ < 8; ++c_) { const uint4 w_ = q4_[c_]; \
    q[8*c_+0] = bflo(w_.x); q[8*c_+1] = bfhi(w_.x); q[8*c_+2] = bflo(w_.y); q[8*c_+3] = bfhi(w_.y); q[8*c_+4] = bflo(w_.z); q[8*c_+5] = bfhi(w_.z); q[8*c_+6] = bflo(w_.w); q[8*c_+7] = bfhi(w_.w); } } while (0)
#define NA_DOT(x, kptr) do { const uint4* k4_ = (const uint4*)(kptr); float s0_ = 0.f, s1_ = 0.f; _Pragma("unroll") for (int c_ = 0; c_ < 8; ++c_) { const uint4 w_ = k4_[c_]; \
    s0_ += q[8*c_+0] * bflo(w_.x) + q[8*c_+2] * bflo(w_.y) + q[8*c_+4] * bflo(w_.z) + q[8*c_+6] * bflo(w_.w); \
    s1_ += q[8*c_+1] * bfhi(w_.x) + q[8*c_+3] * bfhi(w_.y) + q[8*c_+5] * bfhi(w_.z) + q[8*c_+7] * bfhi(w_.w); } x = s0_ + s1_; } while (0)
#define NA_UPD(x, vptr) do { if ((x) > mx) { const float f_ = exp2f(mx - (x)); l *= f_; _Pragma("unroll") for (int d_ = 0; d_ < 64; ++d_) o[d_] *= f_; mx = (x); } \
    const float p_ = exp2f((x) - mx); l += p_; const uint4* v4_ = (const uint4*)(vptr); _Pragma("unroll") for (int c_ = 0; c_ < 8; ++c_) { const uint4 w_ = v4_[c_]; \
    o[8*c_+0] += p_ * bflo(w_.x); o[8*c_+1] += p_ * bfhi(w_.x); o[8*c_+2] += p_ * bflo(w_.y); o[8*c_+3] += p_ * bfhi(w_.y); o[8*c_+4] += p_ * bflo(w_.z); o[8*c_+5] += p_ * bfhi(w_.z); o[8*c_+6] += p_ * bflo(w_.w); o[8*c_+7] += p_ * bfhi(w_.w); } } while (0)
#define NA_STORE(optr) do { const float il_ = 1.0f / l; uint4* o4_ = (uint4*)(optr); _Pragma("unroll") for (int c_ = 0; c_ < 8; ++c_) { uint4 w_; \
    w_.x = pk2(o[8*c_+0] * il_, o[8*c_+1] * il_); w_.y = pk2(o[8*c_+2] * il_, o[8*c_+3] * il_); w_.z = pk2(o[8*c_+4] * il_, o[8*c_+5] * il_); w_.w = pk2(o[8*c_+6] * il_, o[8*c_+7] * il_); o4_[c_] = w_; } } while (0)

__device__ __forceinline__ void phase_attn_naive(const bf16* Q, const bf16* K, const bf16* V, const float* fcum, const float* kmean, bf16* OF, bf16* OM, bf16* OD, int tid, int wave) {
    for (int u = blockIdx.x; u < NB * 12 * 4; u += gridDim.x) {
        const int b = u / 48, h = (u / 4) % 12, ch = u % 4, t = ch * 512 + tid; const size_t m = (size_t)b * SEQ + t;
        float q[64], o[64], mx = -1e30f, l = 0.f;
#pragma unroll
        for (int d = 0; d < 64; ++d) o[d] = 0.f;
        NA_LOADQ(Q + m * QW + h * 64);
        const int smax = ch * 512 + wave * 64 + 63;
        const bf16* kb = K + (size_t)b * SEQ * QW + h * 64; const bf16* vb = V + (size_t)b * SEQ * QW + h * 64;
        if (h < 6) {
            const float* fc = fcum + ((size_t)b * 6 + h) * SEQ; const float fct = fc[t];
            for (int s = 0; s <= smax; ++s) {
                float x; NA_DOT(x, kb + (size_t)s * QW); x += fct - fc[s];
                if (s <= t) NA_UPD(x, vb + (size_t)s * QW);
            }
            NA_STORE(OF + m * FOXW + h * 64);
        } else {
            const int hm = h - 6, qblk = t >> 8; const float slope = alibi_slope(8 + hm) * LOG2E;
            float gt[8];
#pragma unroll
            for (int j = 0; j < 8; ++j) { const float* km = kmean + (((size_t)b * 6 + hm) * 8 + j) * 64; float d = 0.f;
#pragma unroll
                for (int e = 0; e < 64; ++e) d += q[e] * km[e];
                gt[j] = d; }
            unsigned allowed = 1u << qblk;
#pragma unroll
            for (int j = 0; j < 8; ++j) { int rank = 0;
#pragma unroll
                for (int i = 0; i < 8; ++i) if (i < qblk && i != j && (gt[i] > gt[j] || (gt[i] == gt[j] && i < j))) ++rank;
                if (j < qblk && rank < 3) allowed |= 1u << j; }
            for (int s = 0; s <= smax; ++s) {
                float x; NA_DOT(x, kb + (size_t)s * QW); x -= slope * (float)(t - s);
                if (s <= t && ((allowed >> (s >> 8)) & 1u)) NA_UPD(x, vb + (size_t)s * QW);
            }
            NA_STORE(OM + m * MOBW + hm * 64);
        }
    }
    for (int u = blockIdx.x; u < NB * 4 * 4; u += gridDim.x) {
        const int b = u / 16, slot = (u / 4) % 4, ch = u % 4, t = ch * 512 + tid; const size_t m = (size_t)b * SEQ + t;
        float q[64], o[64], mx = -1e30f, l = 0.f;
#pragma unroll
        for (int d = 0; d < 64; ++d) o[d] = 0.f;
#pragma unroll
        for (int g = 0; g < 3; ++g) {
            const int dil = (g == 0) ? 1 : (g == 1 ? 4 : 16), so = (g == 0) ? 0 : (g == 1 ? 4 : 14), head = 12 + 4 * g + slot;
            const float slope = alibi_slope(so + slot) * LOG2E;
            NA_LOADQ(Q + m * QW + head * 64);
            for (int j = 0; j <= 128; ++j) {
                const int s = t - j * dil;
                if (s >= 0) { const size_t kr = ((size_t)b * SEQ + s) * QW + head * 64; float x; NA_DOT(x, K + kr); x -= slope * (float)(j * dil); NA_UPD(x, V + kr); }
            }
        }
        NA_STORE(OD + m * DILW + slot * 64);
    }
}

__device__ __forceinline__ void phase_moe_pos(const int* sel, const float* wt, int* pos, int* tok, float* wrow, int* tile_e, LAS unsigned char* lds, int tid, int lane, int wave) {
    if (blockIdx.x != 0) return;
    LAS int* wtot = (LAS int*)lds;
    int base = 0, tile = 0;
    for (int e = 0; e < NE; ++e) {
        int c = 0;
        for (int i = 0; i < 64; ++i) c += (sel[64 * tid + i] == e) ? 1 : 0;
        int incl = c;
#pragma unroll
        for (int o = 1; o < 64; o <<= 1) { const int t = __shfl_up(incl, o); if (lane >= o) incl += t; }
        if (lane == 63) wtot[wave] = incl;
        __syncthreads();
        int wb = 0, total = 0;
        for (int w = 0; w < NWAVES; ++w) { const int x = wtot[w]; if (w < wave) wb += x; total += x; }
        int run = base + wb + incl - c;
        for (int i = 0; i < 64; ++i) { const int idx = 64 * tid + i; if (sel[idx] == e) { pos[idx] = run; tok[run] = idx; wrow[run] = wt[idx]; ++run; } }
        const int padded = (total + 255) & ~255;
        for (int p = base + total + tid; p < base + padded; p += NTHR) { tok[p] = -1; wrow[p] = 0.f; }
        for (int i = tid; i < padded / 256; i += NTHR) tile_e[tile + i] = e;
        base += padded; tile += padded / 256;
        __syncthreads();
    }
    if (tid == 0) tile_e[255] = tile;
}

#ifndef ONE_LAUNCH
#define ONE_LAUNCH 0
#endif
static_assert(WS_K - WS_Q == (size_t)M * QW * 2 && WS_V - WS_K == (size_t)M * QW * 2, "q|k|v stride");
constexpr int NPL = 11, NPH = 1 + 2 * NPL;
__global__ void __launch_bounds__(NTHR, 2) k_attn_naive(KArgs a) {
    unsigned char* ws = a.ws; const int tid = threadIdx.x, wave = tid >> 6;
    phase_attn_naive((const bf16*)(ws + WS_Q), (const bf16*)(ws + WS_K), (const bf16*)(ws + WS_V), (const float*)(ws + WS_FCUM), (const float*)(ws + WS_KMEAN), (bf16*)(ws + WS_OF), (bf16*)(ws + WS_OM), (bf16*)(ws + WS_OD), tid, wave);
}
__device__ __forceinline__ bool opq(unsigned char*& w, unsigned char* w0, int& tid, int& lane, int& wave) { w = w0; asm volatile("" : "+s"(w)); int t = threadIdx.x; asm volatile("" : "+v"(t)); tid = t; lane = t & 63; wave = __builtin_amdgcn_readfirstlane(t >> 6); return true; }
#define PH(k) (lo <= (k) && (k) < hi && opq(ws, ws0, tid, lane, wave))
#define SEAM(k) do { if (PH(k) && PH((k) + 1)) { XcdBarrier b_ = bar; asm volatile("" : "+s"(b_.bar)); xcd_barrier(b_); } } while (0)
#define mods ((float*)(ws + WS_MODS))
#define flog ((float*)(ws + WS_FLOG))
#define fcum ((float*)(ws + WS_FCUM))
#define kmean ((float*)(ws + WS_KMEAN))
#define sel ((int*)(ws + WS_SEL))
#define wt ((float*)(ws + WS_WT))
#define pos ((int*)(ws + WS_POS))
#define tok ((int*)(ws + WS_TOK))
#define wrow ((float*)(ws + WS_WROW))
#define tile_e ((int*)(ws + WS_TILEE))
#define Hb ((bf16*)(ws + WS_H))
#define Qb ((bf16*)(ws + WS_Q))
#define Kb ((bf16*)(ws + WS_K))
#define Vb ((bf16*)(ws + WS_V))
#define Gb ((bf16*)(ws + WS_G))
#define OF ((bf16*)(ws + WS_OF))
#define OM ((bf16*)(ws + WS_OM))
#define OD ((bf16*)(ws + WS_OD))
#define Y32 ((float*)(ws + WS_Y32))
#define YB ((bf16*)(ws + WS_YB))
template <int L> __device__ __forceinline__ void layer_body(unsigned char* const ws0, const int lo, const int hi, const XcdBarrier bar, LAS unsigned char* lds) {
    constexpr int l = L; unsigned char* ws = ws0; int tid = threadIdx.x, lane = tid & 63, wave = __builtin_amdgcn_readfirstlane(tid >> 6);
    const int G = (int)gridDim.x, bx = (int)blockIdx.x;
        const int p0 = 1 + NPL * l;
#define xs karg_ptr(l == 0 ? 0 : 22)
#define mods_l (mods + (size_t)l * NB * 6144)
#define win_l (AIN(6) + (size_t)l * DM * IN_COLS)
#define wint_l ((const bf16*)(ws + WS_WIN) + (size_t)l * NIN * DM)
        if (PH(p0 + 0)) phase_norm<0>(xs, AIN(4) + l * DM, mods_l, 0, 1024, Hb, win_l, AIN(7) + 6 * l, flog, nullptr, nullptr, nullptr, nullptr, nullptr, lds, tid, lane, wave);
        SEAM(p0 + 0);
        if (PH(p0 + 1)) {
            pg8::Gemm g{Hb, wint_l, M, NIN, DM}; pg8::StaticOrder S; S.init(M, NIN, G, bx);
            pg8::EpiInProj E{Qb, Gb, (const float*)(ws + WS_GAINS) + l * 2 * QW};
            pg8::gemm_phase<pg8::EpiInProj, pg8::StaticOrder, true, true>(lds, g, S, E);
        }
        SEAM(p0 + 1);
        if (PH(p0 + 2)) phase_scan(flog, fcum, Kb, kmean, lds, tid, lane, wave);
        SEAM(p0 + 2);
        SEAM(p0 + 3);
        if (PH(p0 + 4)) {
            { pg8::Gemm g{OF, (const bf16*)(ws + WS_WBF) + (size_t)l * DM * FOXW, M, DM, FOXW}; pg8::StaticOrder S; S.init(M, DM, G, bx);
              pg8::EpiBranch<0> E{Y32, YB, Gb, 0}; pg8::gemm_phase<pg8::EpiBranch<0>, pg8::StaticOrder, false, true>(lds, g, S, E); }
            { pg8::Gemm g{OM, (const bf16*)(ws + WS_WBM) + (size_t)l * DM * MOBW, M, DM, MOBW}; pg8::StaticOrder S; S.init(M, DM, G, bx);
              pg8::EpiBranch<1> E{Y32, YB, Gb, 1024}; pg8::gemm_phase<pg8::EpiBranch<1>, pg8::StaticOrder, false, true>(lds, g, S, E); }
            { pg8::Gemm g{OD, (const bf16*)(ws + WS_WBD) + (size_t)l * DM * DILW, M, DM, DILW}; pg8::StaticOrder S; S.init(M, DM, G, bx);
              pg8::EpiBranch<2> E{Y32, YB, Gb, 2048}; pg8::gemm_phase<pg8::EpiBranch<2>, pg8::StaticOrder, false, true>(lds, g, S, E); }
        }
        SEAM(p0 + 4);
        if (PH(p0 + 5)) {
            pg8::Gemm g{YB, (const bf16*)(ws + WS_WOUT) + (size_t)l * DM * DM, M, DM, DM}; pg8::StaticOrder S; S.init(M, DM, G, bx);
            pg8::EpiResid E{xs, AOUT, mods_l + 2048}; pg8::gemm_phase<pg8::EpiResid, pg8::StaticOrder, false, true>(lds, g, S, E);
        }
        SEAM(p0 + 5);
        if constexpr (l == 0) {
            if (PH(p0 + 6)) phase_norm<1>(AOUT, AIN(5) + l * DM, mods_l, 3072, 4096, Hb, nullptr, nullptr, nullptr, nullptr, nullptr, nullptr, nullptr, nullptr, lds, tid, lane, wave);
            SEAM(p0 + 6); SEAM(p0 + 7); SEAM(p0 + 8);
            if (PH(p0 + 9)) {
                pg8::Gemm g{Hb, (const bf16*)(ws + WS_WF1), M, 2 * DFF, DM}; pg8::StaticOrder S; S.init(M, 2 * DFF, G, bx);
                pg8::EpiSwiglu E{(bf16*)(ws + WS_ACT), 22}; pg8::gemm_phase<pg8::EpiSwiglu, pg8::StaticOrder, true, true>(lds, g, S, E);
            }
            SEAM(p0 + 9);
            if (PH(p0 + 10)) {
                pg8::Gemm g{(const bf16*)(ws + WS_ACT), (const bf16*)(ws + WS_WF2), M, DM, DFF}; pg8::StaticOrder S; S.init(M, DM, G, bx);
                pg8::EpiResid E{AOUT, AOUT, mods_l + 5120}; pg8::gemm_phase<pg8::EpiResid, pg8::StaticOrder, false, true>(lds, g, S, E);
            }
            SEAM(p0 + 10);
        } else {
            if (PH(p0 + 6)) phase_norm<2>(AOUT, AIN(5) + l * DM, mods_l, 3072, 4096, nullptr, nullptr, nullptr, nullptr, AIN(17), AIN(18), sel, wt, nullptr, lds, tid, lane, wave);
            SEAM(p0 + 6);
            if (PH(p0 + 7)) phase_moe_pos(sel, wt, pos, tok, wrow, tile_e, lds, tid, lane, wave);
            SEAM(p0 + 7);
            if (PH(p0 + 8)) phase_norm<3>(AOUT, AIN(5) + l * DM, mods_l, 3072, 4096, (bf16*)(ws + WS_HP), nullptr, nullptr, nullptr, nullptr, nullptr, nullptr, nullptr, pos, lds, tid, lane, wave);
            SEAM(p0 + 8);
            if (PH(p0 + 9)) {
                const int nt = __builtin_amdgcn_readfirstlane(tile_e[255]);
                pg8::Gemm g{(const bf16*)(ws + WS_HP), (const bf16*)(ws + WS_WE1), nt * 256, 2 * DFF, DM};
                pg8::MoeOrder S; S.so.init(nt * 256, 2 * DFF, G, bx); S.tmap = tile_e; S.npn = 22;
                pg8::EpiSwiglu E{(bf16*)(ws + WS_ACTE), 22}; pg8::gemm_phase<pg8::EpiSwiglu, pg8::MoeOrder, true, true>(lds, g, S, E);
            }
            SEAM(p0 + 9);
            if (PH(p0 + 10)) {
                const int nt = __builtin_amdgcn_readfirstlane(tile_e[255]);
                pg8::Gemm g{(const bf16*)(ws + WS_ACTE), (const bf16*)(ws + WS_WE2), nt * 256, DM, DFF};
                pg8::MoeOrder S; S.so.init(nt * 256, DM, G, bx); S.tmap = tile_e; S.npn = 4;
                pg8::EpiMoeOut E{AOUT, mods_l + 5120, tok, wrow}; pg8::gemm_phase<pg8::EpiMoeOut, pg8::MoeOrder, false, true>(lds, g, S, E);
            }
        }
}
__global__ void __launch_bounds__(NTHR, 2) mk_fwd(KArgs a) {
    extern __shared__ __attribute__((aligned(16))) unsigned char lds_raw[];
    LAS unsigned char* lds = (LAS unsigned char*)lds_raw;
    int tid = threadIdx.x, lane = tid & 63, wave = __builtin_amdgcn_readfirstlane(tid >> 6);
    volatile LAS unsigned* MISC = (volatile LAS unsigned*)(lds + MISC_OFF);
    for (int u = tid; u < (LDS_BYTES - RING_BYTES) / 4; u += NTHR) ((LAS unsigned*)(lds + RING_BYTES))[u] = 0u;
    __syncthreads();
    unsigned char* const ws0 = a.ws;
    unsigned char* ws = ws0;
    unsigned* ctl = (unsigned*)(ws + WS_CTL);
    const int lo = a.ph_lo, hi = a.ph_hi;
    XcdBarrier bar; bar.bar = ctl + CW_BAR; bar.x = 0; bar.st = nullptr;
    if (hi - lo > 1) bar = xcd_barrier_post(ctl + CW_BAR, MISC + 8);
    const int G = (int)gridDim.x, bx = (int)blockIdx.x;

    if (PH(0)) phase_prologue(a, lds, tid, lane, wave);
    SEAM(0);
    layer_body<0>(ws0, lo, hi, bar, lds);
    layer_body<1>(ws0, lo, hi, bar, lds);
#undef PH
#undef SEAM
}

extern "C" void kernel_launch(void* const* d_in, const int* in_sizes, int n_in, void* d_out, int out_size, void* d_ws, size_t ws_size, hipStream_t stream) {
    static int grid = 0;
    if (grid == 0) {
        if (n_in != 22 || out_size != M * DM || ws_size < WS_END) { fprintf(stderr, "kernel_launch: unexpected sizes n_in %d out %d ws %zu (need %zu)\n", n_in, out_size, ws_size, (size_t)WS_END); grid = -1; return; }
        int dev = 0, cus = 0, per_cu = 0;
        if (hipGetDevice(&dev) != hipSuccess || hipDeviceGetAttribute(&cus, hipDeviceAttributeMultiprocessorCount, dev) != hipSuccess) { grid = -1; return; }
        if (hipFuncSetAttribute((const void*)mk_fwd, hipFuncAttributeMaxDynamicSharedMemorySize, LDS_BYTES) != hipSuccess) { fprintf(stderr, "kernel_launch: hipFuncSetAttribute failed\n"); grid = -1; return; }
        if (hipOccupancyMaxActiveBlocksPerMultiprocessor(&per_cu, (const void*)mk_fwd, NTHR, LDS_BYTES) != hipSuccess || per_cu < 1) fprintf(stderr, "kernel_launch: occupancy query says %d\n", per_cu);
        (void)hipGetLastError();
        grid = cus;
    }
    if (grid < 0) return;
    (void)hipMemsetAsync((char*)d_ws + WS_CTL, 0, CTL_ZERO_BYTES, stream);
    KArgs a{};
    for (int i = 0; i < 22; ++i) a.in[i] = (const float*)d_in[i];
    a.out = (float*)d_out; a.ws = (unsigned char*)d_ws;
#if ONE_LAUNCH
    a.ph_lo = 0; a.ph_hi = NPH;
    hipLaunchKernelGGL(mk_fwd, dim3(grid), dim3(NTHR), LDS_BYTES, stream, a);
#else
    for (int p = 0; p < NPH; ++p) {
        if (p == 1 + 7 || p == 1 + 8) continue;
        a.ph_lo = p; a.ph_hi = p + 1;
        if (p == 1 + 3 || p == 1 + NPL + 3) hipLaunchKernelGGL(k_attn_naive, dim3(grid), dim3(NTHR), 0, stream, a);
        else hipLaunchKernelGGL(mk_fwd, dim3(grid), dim3(NTHR), LDS_BYTES, stream, a);
    }
#endif
}
```

```cpp
#include <hip/hip_runtime.h>
#include <cstdio>
#include <cstdint>

constexpr int NB = 8, SEQ = 2048, DM = 1024, M = NB * SEQ, NH = 24, HD = 64, QW = 1536;
constexpr int IN_COLS = 7686, NIN = 7680, DFF = 2816, NE = 8;
constexpr int FOXW = 384, MOBW = 384, DILW = 256;
constexpr float RMS_EPS = 1e-6f, LOG2E = 1.4426950408889634f, C2 = 0.125f * 1.4426950408889634f;
constexpr int PMAX = 2 * M + NE * 256;
constexpr int NWAVES = 8, NTHR = 512;

constexpr size_t MiB = 1u << 20, KiB = 1024;
constexpr size_t WS_CTL = 0, CTL_ZERO_BYTES = 1 * MiB;
constexpr size_t WS_MODS = 1 * MiB;
constexpr size_t WS_FLOG = WS_MODS + 384 * KiB;
constexpr size_t WS_FCUM = WS_FLOG + 384 * KiB;
constexpr size_t WS_KMEAN = WS_FCUM + 384 * KiB;
constexpr size_t WS_SEL = WS_KMEAN + 96 * KiB;
constexpr size_t WS_WT = WS_SEL + 128 * KiB;
constexpr size_t WS_CNT = WS_WT + 128 * KiB;
constexpr size_t WS_TOK = WS_CNT + 128 * KiB;
constexpr size_t WS_WROW = WS_TOK + 136 * KiB;
constexpr size_t WS_TILEE = WS_WROW + 136 * KiB;
constexpr size_t WS_GAINS = WS_TILEE + 1024;
static_assert(WS_GAINS + 2 * 2 * 1536 * 4 <= 5 * MiB, "small buffers");
constexpr size_t WS_WIN = 5 * MiB;
constexpr size_t WS_WBR = 35 * MiB;
constexpr size_t WS_WOUT = 39 * MiB;
constexpr size_t WS_WF1 = 43 * MiB;
constexpr size_t WS_WF2 = 54 * MiB;
constexpr size_t WS_WE1 = WS_WF2 + 5632 * KiB;
constexpr size_t WS_WE2 = WS_WE1 + 88 * MiB;
constexpr size_t WS_H = WS_WE2 + 44 * MiB;
constexpr size_t WS_O = WS_H;
constexpr size_t WS_Q = WS_H + 32 * MiB, WS_K = WS_Q + 48 * MiB, WS_V = WS_K + 48 * MiB;
constexpr size_t WS_G = WS_V + 48 * MiB;
constexpr size_t WS_OG1 = WS_G + 96 * MiB;
constexpr size_t WS_OG2 = WS_OG1 + 8 * MiB;
constexpr size_t WS_LSE = WS_OG2 + 8 * MiB;
constexpr size_t WS_END = WS_LSE + 768 * KiB;
constexpr size_t WS_XB = WS_WE1 + 44 * MiB;
constexpr size_t WS_H8 = WS_OG1;
constexpr size_t WS_WG8_OFF = 9 * MiB;
constexpr size_t WS_YB = WS_V;
constexpr size_t WS_ACT = WS_Q;
constexpr size_t WS_HP = WS_H;
constexpr size_t WS_YE = WS_H;
constexpr size_t WS_ACTE = WS_H + 68 * MiB;
static_assert(WS_ACTE + (size_t)PMAX * DFF * 2 <= WS_END, "moe act fits");
static_assert(WS_ACT + (size_t)M * DFF * 2 <= WS_V, "dense act fits under y");

constexpr size_t WS_KM = 256 * KiB;
constexpr int CW_BAR = 4096, CW_Q = 8192;
constexpr int RING_BYTES = 131072, MISC_OFF = RING_BYTES + 320, LDS_BYTES = 147456;

#define GAS __attribute__((address_space(1)))
#define LAS __attribute__((address_space(3)))
typedef unsigned short bf16;
typedef unsigned v4u __attribute__((ext_vector_type(4)));
typedef float f32x4 __attribute__((ext_vector_type(4)));
#define LDS_WAIT() asm volatile("s_waitcnt lgkmcnt(0)" ::: "memory")
#define VM_WAIT() asm volatile("s_waitcnt vmcnt(0)" ::: "memory")
__device__ __forceinline__ unsigned f2bf(float f) { unsigned u = __builtin_bit_cast(unsigned, f); return (u + 0x7fffu + ((u >> 16) & 1u)) >> 16; }
typedef float f32x2_t_ __attribute__((ext_vector_type(2))); typedef __bf16 bf16x2_t_ __attribute__((ext_vector_type(2)));
__device__ __forceinline__ unsigned pk2(float lo, float hi) { f32x2_t_ v = {lo, hi}; bf16x2_t_ b = __builtin_convertvector(v, bf16x2_t_); return __builtin_bit_cast(unsigned, b); }
typedef unsigned u32x2 __attribute__((ext_vector_type(2)));
__device__ __forceinline__ float ub8(unsigned w, int i) { return (float)((w >> (8 * i)) & 0xffu); }
__device__ __forceinline__ float bflo(unsigned w) { return __builtin_bit_cast(float, w << 16); }
__device__ __forceinline__ float bfhi(unsigned w) { return __builtin_bit_cast(float, w & 0xffff0000u); }
__device__ __forceinline__ int lane_opq() { unsigned z = 0u; asm volatile("" : "+v"(z)); return (int)__builtin_amdgcn_mbcnt_hi(~0u, __builtin_amdgcn_mbcnt_lo(~0u, z)); }
__device__ __forceinline__ float shfl_l(float v, int src_lane) { return __builtin_bit_cast(float, __builtin_amdgcn_ds_bpermute(src_lane << 2, __builtin_bit_cast(int, v))); }
__device__ __forceinline__ int shfl_li(int v, int src_lane) { return __builtin_amdgcn_ds_bpermute(src_lane << 2, v); }
__device__ __forceinline__ float wave_sum(float v) {
    const int l_ = lane_opq();
#pragma unroll
    for (int o = 1; o < 64; o <<= 1) v += shfl_l(v, l_ ^ o);
    return v;
}
__device__ __forceinline__ int kv_l2d(int head) { return head < 16 ? 0 : (head < 20 ? 2 : 4); }
__device__ __forceinline__ int kv_row(int t, int l2) { return ((t & ((1 << l2) - 1)) << (11 - l2)) + (t >> l2); }
__device__ __forceinline__ float alibi_slope(int i) { return exp2f(-8.0f * (float)(i + 1) / 18.0f); }

#ifndef MOE_FP8
#define MOE_FP8 1
#endif
static_assert(MOE_FP8 == 1, "WS_XB sits in the half of the expert up-projection slot that only the fp8 build leaves free");
constexpr float F8_WS = 32.f, F8_AS = 8.f;
__device__ __forceinline__ unsigned pk4_fp8(float a, float b, float c, float d) { int p = __builtin_amdgcn_cvt_pk_fp8_f32(a, b, 0, false); p = __builtin_amdgcn_cvt_pk_fp8_f32(c, d, p, true); return (unsigned)p; }
#ifndef V_FP8
#define V_FP8 1
#endif
#ifndef PROBE_CONVQ
#define PROBE_CONVQ 0
#endif
#ifndef PROBE_WDIL2
#define PROBE_WDIL2 0
#endif
#ifndef DENSE2_FP8
#define DENSE2_FP8 1
#endif
#ifndef MERGE_IN_QUEUE
#define MERGE_IN_QUEUE 1
#endif
#ifndef PROBE_FP8
#define PROBE_FP8 0
#endif
__device__ __forceinline__ float q8(float x, float s) { const int p = __builtin_amdgcn_cvt_pk_fp8_f32(x * s, x * s, 0, false); return __builtin_amdgcn_cvt_f32_fp8(p, 0) * (1.0f / s); }
namespace pg8 {
#define PG8_LAS __attribute__((address_space(3)))
typedef unsigned short bf16_t;
typedef short bf16x8 __attribute__((ext_vector_type(8)));
typedef float f32x4 __attribute__((ext_vector_type(4)));
typedef unsigned u32x4 __attribute__((ext_vector_type(4)));
constexpr int BM = 256, BK = 64, HALF = 128, HTB = HALF * BK * 2  , STAGE_BYTES = 8 * HTB, NXCD = 8, WGM = 8;

__host__ __device__ __forceinline__ int lds_byte(int r, int c) { const int st = (r >> 4) * 2 + (c >> 5), rr = r & 15, cc = c & 31, ob = rr * 64 + cc * 2; return st * 1024 + (ob ^ (((ob >> 9) & 1) << 5)); }
__host__ __device__ __forceinline__ void stage_rc(int b, int& R, int& C) { const int st = b / 1024, sb = b % 1024, swz = sb ^ (((sb >> 9) & 1) << 5); R = (st >> 1) * 16 + swz / 64; C = (st & 1) * 32 + (swz % 64) / 2; }
__host__ __device__ __forceinline__ int perm32(int rho) { const int n = rho >> 4, i = rho & 15; return 8 * (i >> 2) + 4 * n + (i & 3); }

struct Unit { int pm, pn; };
struct Gemm { const bf16_t* A; const bf16_t* Bt; int M, N, K; };

struct StaticOrder {
    int nM, nN, nwg, G, c;
    __host__ __device__ void init(int M, int N, int G_, int c_) { nM = M / BM; nN = N / BM; nwg = nM * nN; G = G_; c = c_; }
    __host__ __device__ bool next(int i, Unit& u) const {
        const long L = (long)i * G + c; if (L >= nwg) return false;
        int wgid = (int)L; { const int q = nwg / NXCD, r = nwg % NXCD, xcd = wgid % NXCD, off = wgid / NXCD; wgid = (xcd < r ? xcd * (q + 1) : r * (q + 1) + (xcd - r) * q) + off; }
        const int nig = WGM * nN, gid = wgid / nig, fm = gid * WGM, gsz = (nM - fm) < WGM ? (nM - fm) : WGM;
        u.pm = fm + ((wgid % nig) % gsz); u.pn = (wgid % nig) / gsz; return true;
    }
    __device__ __forceinline__ void a_ready(const Unit&) const {}
    __device__ __forceinline__ void done(const Unit&) const {}
};
template <class Epi, class Sched, bool ALIGN_EPI = false, bool SP2 = false, bool F8 = false>
__device__ __forceinline__ void gemm_phase(PG8_LAS unsigned char* lds, const Gemm g, const Sched& S, const Epi& E, int wave_k) {
    unsigned zt_ = 0u; asm volatile("" : "+v"(zt_)); asm volatile("" : "+s"(wave_k)); int tid_o = wave_k * 64 + (int)__builtin_amdgcn_mbcnt_hi(~0u, __builtin_amdgcn_mbcnt_lo(~0u, zt_));
    const int tid = tid_o, wid = __builtin_amdgcn_readfirstlane(tid >> 6), lane = tid & 63, wr = wid >> 2, wc = wid & 3, fr = lane & 15, fq = lane >> 4;
    const int K = g.K, nt = K / BK;
    unsigned voffA[2], voffB[2];
#pragma unroll
    for (int i = 0; i < 2; ++i) { int R, C; stage_rc(tid * 16 + i * 8192, R, C); const int Rb = Epi::PERM ? ((R & ~31) + perm32(R & 31)) : R;
        voffA[i] = (unsigned)(R * K + C) * 2u; voffB[i] = (unsigned)(Rb * K + C) * 2u; }
    const size_t kstep = (size_t)(BK * 2);
    const size_t hstep = (size_t)HALF * K * 2;
    const size_t tstep = 2 * hstep;
    const unsigned ldsw = (unsigned)wid * 1024u;
    const int aoff = lds_byte(wr * 64 + fr, fq * 8), boff = lds_byte(wc * 32 + fr, fq * 8);
#define PG8_SA(b, h) (((b) * 2 + (h)) * HTB)
#define PG8_SB(b, h) ((4 + (b) * 2 + (h)) * HTB)
#define PG8_STAGE(bufoff, gbase, voff) do { _Pragma("unroll") for (int _i = 0; _i < 2; ++_i) \
        __builtin_amdgcn_global_load_lds((const unsigned*)((const char*)(gbase) + (voff)[_i]), (PG8_LAS unsigned*)(lds + (bufoff) + ldsw + _i * 8192), 16, 0, 0); } while (0)
#define PG8_LDA(dst, b, h) do { _Pragma("unroll") for (int m = 0; m < 4; ++m) { dst[m].lo = *(const PG8_LAS bf16x8*)(lds + PG8_SA(b, h) + aoff + m * 2048); dst[m].hi = *(const PG8_LAS bf16x8*)(lds + PG8_SA(b, h) + aoff + m * 2048 + 1024); } } while (0)
#define PG8_LDB(dst, b, h) do { _Pragma("unroll") for (int n = 0; n < 2; ++n) { dst[n].lo = *(const PG8_LAS bf16x8*)(lds + PG8_SB(b, h) + boff + n * 2048); dst[n].hi = *(const PG8_LAS bf16x8*)(lds + PG8_SB(b, h) + boff + n * 2048 + 1024); } } while (0)
#define PG8_MMA(ai, bj, At, Bt) do { __builtin_amdgcn_s_setprio(1); _Pragma("unroll") for (int m = 0; m < 4; ++m) _Pragma("unroll") for (int n = 0; n < 2; ++n) { \
        if constexpr (F8) { typedef int i32x8 __attribute__((ext_vector_type(8))); \
            asm volatile("v_mfma_scale_f32_16x16x128_f8f6f4 %0, %1, %2, %0, %3, %3 op_sel_hi:[0,0,0]" : "+v"(acc[ai][bj][m][n]) : "v"(__builtin_bit_cast(i32x8, Bt[n])), "v"(__builtin_bit_cast(i32x8, At[m])), "v"(f8scale)); } \
        else { acc[ai][bj][m][n] = __builtin_amdgcn_mfma_f32_16x16x32_bf16(Bt[n].lo, At[m].lo, acc[ai][bj][m][n], 0, 0, 0); \
               acc[ai][bj][m][n] = __builtin_amdgcn_mfma_f32_16x16x32_bf16(Bt[n].hi, At[m].hi, acc[ai][bj][m][n], 0, 0, 0); } } \
        __builtin_amdgcn_s_setprio(0); } while (0)
#define PG8_WAIT_V(n) asm volatile("s_waitcnt vmcnt(" #n ")" ::: "memory")
#define PG8_WAIT_L(n) asm volatile("s_waitcnt lgkmcnt(" #n ")" ::: "memory")
#define PG8_BAR __builtin_amdgcn_s_barrier()
#define PG8_SCHED __builtin_amdgcn_sched_barrier(0)
    Unit cur, nxt; int ui = 0;
    if (!S.next(0, cur)) return;
    f32x4 acc[2][2][4][2];
#pragma unroll
    for (int a = 0; a < 2; ++a)
#pragma unroll
        for (int b = 0; b < 2; ++b)
#pragma unroll
            for (int m = 0; m < 4; ++m)
#pragma unroll
                for (int n = 0; n < 2; ++n) acc[a][b][m][n] = (f32x4){0.f, 0.f, 0.f, 0.f};
    const int f8scale = 0x7f7f7f7f;
    typedef short bf16x16 __attribute__((ext_vector_type(16)));
    bf16x16 At[4], B0[2], B1[2];
    const char* cA = (const char*)g.A + (size_t)cur.pm * tstep; const char* cB = (const char*)g.Bt + (size_t)cur.pn * tstep;
    S.a_ready(cur);
    if constexpr (SP2) {
        PG8_STAGE(PG8_SB(0, 0), cB, voffB); PG8_STAGE(PG8_SB(0, 1), cB + hstep, voffB); PG8_STAGE(PG8_SA(0, 0), cA, voffA); PG8_STAGE(PG8_SA(0, 1), cA + hstep, voffA);
        if (wr == 1) PG8_BAR;
        PG8_WAIT_V(2); PG8_BAR;
        PG8_STAGE(PG8_SB(1, 0), cB + kstep, voffB); PG8_STAGE(PG8_SA(1, 0), cA + kstep, voffA); PG8_STAGE(PG8_SB(1, 1), cB + hstep + kstep, voffB);
        PG8_WAIT_V(6); PG8_BAR;
    } else {
        PG8_STAGE(PG8_SB(0, 0), cB, voffB); PG8_STAGE(PG8_SA(0, 0), cA, voffA); PG8_STAGE(PG8_SB(0, 1), cB + hstep, voffB); PG8_STAGE(PG8_SA(0, 1), cA + hstep, voffA);
        if (wr == 1) PG8_BAR;
        PG8_WAIT_V(4); PG8_BAR;
        PG8_STAGE(PG8_SB(1, 0), cB + kstep, voffB); PG8_STAGE(PG8_SA(1, 0), cA + kstep, voffA); PG8_STAGE(PG8_SB(1, 1), cB + hstep + kstep, voffB);
        PG8_WAIT_V(6); PG8_BAR;
    }
    for (;;) {
        const bool has_next = S.next(ui + 1, nxt);
        const char* nA = has_next ? (const char*)g.A + (size_t)nxt.pm * tstep : cA; const char* nB = has_next ? (const char*)g.Bt + (size_t)nxt.pn * tstep : cB;
#pragma nounroll
        for (int t = 0; t < nt; t += 2) {
            const bool last = (t == nt - 2);
            const char* a1 = cA + (size_t)(t + 1) * kstep;
            const char* a2 = last ? nA : cA + (size_t)(t + 2) * kstep; const char* b2 = last ? nB : cB + (size_t)(t + 2) * kstep;
            const char* a3 = a2 + kstep; const char* b3 = b2 + kstep;
            if (last && has_next) S.a_ready(nxt);
            if constexpr (Epi::MIDK) { if (t == Epi::KT1 || t == Epi::KT2) E.mid(acc, cur, t, wr, wc, fr, fq); }
            if constexpr (SP2) {
            PG8_LDB(B0, 0, 0); PG8_LDB(B1, 0, 1); PG8_SCHED; PG8_LDA(At, 0, 0); PG8_STAGE(PG8_SA(1, 1), a1 + hstep, voffA);
            PG8_WAIT_V(8); PG8_WAIT_L(0); PG8_BAR; PG8_MMA(0, 0, At, B0); PG8_MMA(0, 1, At, B1); PG8_BAR; PG8_SCHED;
            PG8_LDA(At, 0, 1); PG8_STAGE(PG8_SB(0, 0), b2, voffB); PG8_STAGE(PG8_SB(0, 1), b2 + hstep, voffB); PG8_STAGE(PG8_SA(0, 0), a2, voffA);
            PG8_WAIT_V(8); PG8_WAIT_L(0); PG8_BAR; PG8_MMA(1, 0, At, B0); PG8_MMA(1, 1, At, B1); PG8_BAR; PG8_SCHED;
            PG8_LDB(B0, 1, 0); PG8_LDB(B1, 1, 1); PG8_SCHED; PG8_LDA(At, 1, 0); PG8_STAGE(PG8_SA(0, 1), a2 + hstep, voffA);
            PG8_WAIT_V(8); PG8_WAIT_L(0); PG8_BAR; PG8_MMA(0, 0, At, B0); PG8_MMA(0, 1, At, B1); PG8_BAR; PG8_SCHED;
            PG8_LDA(At, 1, 1); PG8_STAGE(PG8_SB(1, 0), b3, voffB); PG8_STAGE(PG8_SB(1, 1), b3 + hstep, voffB); PG8_STAGE(PG8_SA(1, 0), a3, voffA);
            PG8_WAIT_V(8); PG8_WAIT_L(0); PG8_BAR; PG8_MMA(1, 0, At, B0); PG8_MMA(1, 1, At, B1); PG8_BAR; PG8_SCHED;
            } else {
            PG8_LDB(B0, 0, 0); PG8_SCHED; PG8_LDA(At, 0, 0); PG8_STAGE(PG8_SA(1, 1), a1 + hstep, voffA);
            PG8_WAIT_L(8); PG8_BAR; PG8_WAIT_L(0); PG8_MMA(0, 0, At, B0); PG8_BAR; PG8_SCHED;
            PG8_LDB(B1, 0, 1); PG8_STAGE(PG8_SB(0, 0), b2, voffB);
            PG8_BAR; PG8_WAIT_L(0); PG8_MMA(0, 1, At, B1); PG8_BAR;
            PG8_LDA(At, 0, 1); PG8_STAGE(PG8_SA(0, 0), a2, voffA);
            PG8_BAR; PG8_WAIT_L(0); PG8_MMA(1, 0, At, B0); PG8_BAR; PG8_SCHED;
            PG8_STAGE(PG8_SB(0, 1), b2 + hstep, voffB);
            PG8_WAIT_V(6); PG8_BAR; PG8_MMA(1, 1, At, B1); PG8_BAR;
            PG8_LDB(B0, 1, 0); PG8_SCHED; PG8_LDA(At, 1, 0); PG8_STAGE(PG8_SA(0, 1), a2 + hstep, voffA);
            PG8_WAIT_L(8); PG8_BAR; PG8_WAIT_L(0); PG8_MMA(0, 0, At, B0); PG8_BAR; PG8_SCHED;
            PG8_LDB(B1, 1, 1); PG8_STAGE(PG8_SB(1, 0), b3, voffB);
            PG8_BAR; PG8_WAIT_L(0); PG8_MMA(0, 1, At, B1); PG8_BAR;
            PG8_LDA(At, 1, 1); PG8_STAGE(PG8_SA(1, 0), a3, voffA);
            PG8_BAR; PG8_WAIT_L(0); PG8_MMA(1, 0, At, B0); PG8_BAR; PG8_SCHED;
            PG8_STAGE(PG8_SB(1, 1), b3 + hstep, voffB);
            PG8_WAIT_V(6); PG8_BAR; PG8_MMA(1, 1, At, B1); PG8_BAR;
            }
        }
        if constexpr (ALIGN_EPI) { if (wr == 0) PG8_BAR; }
        if constexpr (F8) asm volatile("s_nop 15\n\ts_nop 15\n\ts_nop 15\n\ts_nop 15\n\ts_nop 15" ::: "memory");
        if constexpr (!Epi::AFTER_DRAIN) { E(acc, cur, wr, wc, fr, fq); S.done(cur); }
        if (!has_next) break;
#pragma unroll
        for (int a = 0; a < 2; ++a)
#pragma unroll
            for (int b = 0; b < 2; ++b)
#pragma unroll
                for (int m = 0; m < 4; ++m)
#pragma unroll
                    for (int n = 0; n < 2; ++n) acc[a][b][m][n] = (f32x4){0.f, 0.f, 0.f, 0.f};
        cur = nxt; cA = nA; cB = nB; ++ui;
        if constexpr (ALIGN_EPI) { if (wr == 1) PG8_BAR; }
    }
    PG8_WAIT_V(0);
    if constexpr (!ALIGN_EPI) { if (wr == 0) PG8_BAR; }
    PG8_BAR;
    if constexpr (Epi::AFTER_DRAIN) { E.fused(acc, cur, wr, wc, fr, fq, lds, wid, lane); S.done(cur); }
#undef PG8_SA
#undef PG8_SB
#undef PG8_STAGE
#undef PG8_LDA
#undef PG8_LDB
#undef PG8_MMA
#undef PG8_WAIT_V
#undef PG8_WAIT_L
#undef PG8_BAR
#undef PG8_SCHED
}
}

namespace pg8 {
struct EpiInProj {
    static constexpr bool PERM = true, AFTER_DRAIN = false, MIDK = false;
    bf16_t *Q, *G; const float *gains; float* kmean;
    __device__ __forceinline__ void operator()(const f32x4 (&acc)[2][2][4][2], const Unit& u, int wr, int wc, int, int) const {
        unsigned z_ = 0u; asm volatile("" : "+v"(z_)); const int ln_ = __builtin_amdgcn_mbcnt_hi(~0u, __builtin_amdgcn_mbcnt_lo(~0u, z_)); const int fr = ln_ & 15, fq = ln_ >> 4;
        const int row0 = u.pm * BM + wr * 64 + fr;
        if (u.pn < 18) {
            const int sec = u.pn / 6, head = (u.pn % 6) * 4 + wc;
            const int bb = (u.pm * BM) / SEQ; const int l2k = kv_l2d(head);
            const size_t doff = (size_t)sec * ((size_t)M * QW) + ((sec == 1) ? ((size_t)bb * 23 * SEQ + (size_t)head * SEQ) * 64 : (size_t)(head * 64));
            bf16_t* dst = Q + doff + fq * 8;
            f32x4 gn[2][2];
#pragma unroll
            for (int bj = 0; bj < 2; ++bj)
#pragma unroll
                for (int n = 0; n < 2; ++n) {
                    if (sec < 2) gn[bj][n] = *(const f32x4*)(gains + sec * QW + head * 64 + bj * 32 + fq * 8 + 4 * n);
                    else gn[bj][n] = (f32x4){1.f, 1.f, 1.f, 1.f};
                }
            const bool km_on = (sec == 1 && head >= 6 && head < 12);
            float cs[16];
#pragma unroll
            for (int i = 0; i < 16; ++i) cs[i] = 0.f;
#pragma unroll
            for (int ai = 0; ai < 2; ++ai)
#pragma unroll
                for (int m = 0; m < 4; ++m) {
                    float rs = 1.f;
                    if (sec < 2) {
                        float ss = 0.f;
#pragma unroll
                        for (int bj = 0; bj < 2; ++bj)
#pragma unroll
                            for (int n = 0; n < 2; ++n) { const f32x4 x = acc[ai][bj][m][n]; ss += (x[0] * x[0] + x[1] * x[1]) + (x[2] * x[2] + x[3] * x[3]); }
                        ss += shfl_l(ss, ln_ ^ 16); ss += shfl_l(ss, ln_ ^ 32);
                        rs = __builtin_amdgcn_rsqf(ss * (1.0f / 64.0f) + RMS_EPS);
                    }
                    const int rr_ = row0 + ai * HALF + m * 16;
                    bf16_t* rowp = dst + ((sec == 1) ? (size_t)(bb * SEQ + kv_row(rr_ - bb * SEQ, l2k)) * 64 : (size_t)rr_ * QW);
#pragma unroll
                    for (int bj = 0; bj < 2; ++bj) {
                        const f32x4 v0 = acc[ai][bj][m][0] * rs * gn[bj][0], v1 = acc[ai][bj][m][1] * rs * gn[bj][1];
                        if (km_on) {
#pragma unroll
                            for (int i = 0; i < 4; ++i) { cs[bj * 8 + i] += v0[i]; cs[bj * 8 + 4 + i] += v1[i]; } }
                        u32x4 w; w.x = pk2(v0[0], v0[1]); w.y = pk2(v0[2], v0[3]); w.z = pk2(v1[0], v1[1]); w.w = pk2(v1[2], v1[3]);
                        *(u32x4*)(rowp + bj * 32) = w;
                    }
                    asm volatile("" ::: "memory");
                }
            if (km_on) {
#pragma unroll
                for (int i = 0; i < 16; ++i) { float s = cs[i]; s += shfl_l(s, ln_ ^ 1); s += shfl_l(s, ln_ ^ 2); s += shfl_l(s, ln_ ^ 4); s += shfl_l(s, ln_ ^ 8); cs[i] = s; }
                if (fr == 0) { float* kp = kmean + (((size_t)(u.pm >> 3) * 6 + (head - 6)) * 8 + (u.pm & 7)) * 64 + fq * 8;
#pragma unroll
                    for (int bj = 0; bj < 2; ++bj)
#pragma unroll
                        for (int i = 0; i < 8; ++i) __hip_atomic_fetch_add(kp + bj * 32 + i, cs[bj * 8 + i] * (1.0f / 256.0f), __ATOMIC_RELAXED, __HIP_MEMORY_SCOPE_AGENT); }
            }
        }
    }
};
struct EpiGates8 {
    static constexpr bool PERM = true, AFTER_DRAIN = false, MIDK = false;
    bf16_t* G; bf16_t* V;
    __device__ __forceinline__ void operator()(const f32x4 (&acc)[2][2][4][2], const Unit& u, int wr, int wc, int, int) const {
        unsigned z_ = 0u; asm volatile("" : "+v"(z_)); const int ln_ = __builtin_amdgcn_mbcnt_hi(~0u, __builtin_amdgcn_mbcnt_lo(~0u, z_)); const int fr = ln_ & 15, fq = ln_ >> 4;
        const int row0 = u.pm * BM + wr * 64 + fr, col0 = u.pn * BM + wc * 32 + fq * 8;
        if (u.pn >= 12) {
            const int bb = (u.pm * BM) / SEQ, hv = (u.pn - 12) * 4 + wc, l2v = kv_l2d(hv); bf16_t* dst = V + ((size_t)bb * 24 + hv) * SEQ * 64 + fq * 8;
#pragma unroll
            for (int ai = 0; ai < 2; ++ai)
#pragma unroll
                for (int m = 0; m < 4; ++m) {
                    bf16_t* rowp = dst + (size_t)kv_row(row0 + ai * HALF + m * 16 - bb * SEQ, l2v) * 64;
#pragma unroll
                    for (int bj = 0; bj < 2; ++bj) { const f32x4 v0 = acc[ai][bj][m][0] * (1.0f / F8_WS), v1 = acc[ai][bj][m][1] * (1.0f / F8_WS);
                        u32x4 w; w.x = pk2(v0[0], v0[1]); w.y = pk2(v0[2], v0[3]); w.z = pk2(v1[0], v1[1]); w.w = pk2(v1[2], v1[3]);
                        *(u32x4*)(rowp + bj * 32) = w; }
                    asm volatile("" ::: "memory");
                }
            return;
        }
#pragma unroll
        for (int ai = 0; ai < 2; ++ai)
#pragma unroll
            for (int m = 0; m < 4; ++m) {
                unsigned char* rowp = (unsigned char*)G + (size_t)(row0 + ai * HALF + m * 16) * 3072 + col0;
#pragma unroll
                for (int bj = 0; bj < 2; ++bj) {
                    unsigned w0 = 0u, w1 = 0u;
#pragma unroll
                    for (int i = 0; i < 4; ++i) {
                        w0 = __builtin_amdgcn_cvt_pk_u8_f32(fmaxf(255.0f * __builtin_amdgcn_rcpf(1.0f + __builtin_amdgcn_exp2f((-LOG2E / F8_WS) * acc[ai][bj][m][0][i])), 1.0f), i, w0);
                        w1 = __builtin_amdgcn_cvt_pk_u8_f32(fmaxf(255.0f * __builtin_amdgcn_rcpf(1.0f + __builtin_amdgcn_exp2f((-LOG2E / F8_WS) * acc[ai][bj][m][1][i])), 1.0f), i, w1); }
                    *(u32x2*)(rowp + bj * HALF) = (u32x2){w0, w1};
                }
                asm volatile("" ::: "memory");
            }
    }
};
struct GateOrder {
    int G, c;
    __device__ __forceinline__ bool next(int i, Unit& u) const {
        int L;
        if (G == 256) { if (c >= 128) { if (i >= 4) return false; L = (c - 128) + 128 * i; } else { if (i >= 2) return false; L = 512 + c + 128 * i; } }
        else { L = i * G + c; if (L >= 768) return false; }
        u.pm = L / 12; u.pn = L % 12; return true;
    }
    __device__ __forceinline__ void a_ready(const Unit&) const {}
    __device__ __forceinline__ void done(const Unit&) const {}
};
struct EpiBranch {
    static constexpr bool PERM = true, AFTER_DRAIN = false, MIDK = true; static constexpr int KT1 = 6, KT2 = 12;
    bf16_t* YB; const bf16_t* G;
    __device__ __forceinline__ void mid(f32x4 (&acc)[2][2][4][2], const Unit& u, int t, int wr, int wc, int, int) const {
        unsigned z_ = 0u; asm volatile("" : "+v"(z_)); const int ln_ = __builtin_amdgcn_mbcnt_hi(~0u, __builtin_amdgcn_mbcnt_lo(~0u, z_)); const int fr = ln_ & 15, fq = ln_ >> 4;
        const int row0 = u.pm * BM + wr * 64 + fr, col0 = u.pn * BM + wc * 32 + fq * 8; const int goff = (t == KT1) ? 0 : 1024;
#pragma unroll
        for (int ai = 0; ai < 2; ++ai)
#pragma unroll
            for (int m = 0; m < 4; ++m) {
                const unsigned char* gp = (const unsigned char*)G + (size_t)(row0 + ai * HALF + m * 16) * 3072 + goff + col0;
#pragma unroll
                for (int bj = 0; bj < 2; ++bj) {
                    const u32x2 ga = *(const u32x2*)(gp + bj * HALF), gb = *(const u32x2*)(gp + bj * HALF + 1024);
                    f32x4 r0 = {ub8(ga.x, 0) * __builtin_amdgcn_rcpf(ub8(gb.x, 0)), ub8(ga.x, 1) * __builtin_amdgcn_rcpf(ub8(gb.x, 1)), ub8(ga.x, 2) * __builtin_amdgcn_rcpf(ub8(gb.x, 2)), ub8(ga.x, 3) * __builtin_amdgcn_rcpf(ub8(gb.x, 3))};
                    f32x4 r1 = {ub8(ga.y, 0) * __builtin_amdgcn_rcpf(ub8(gb.y, 0)), ub8(ga.y, 1) * __builtin_amdgcn_rcpf(ub8(gb.y, 1)), ub8(ga.y, 2) * __builtin_amdgcn_rcpf(ub8(gb.y, 2)), ub8(ga.y, 3) * __builtin_amdgcn_rcpf(ub8(gb.y, 3))};
                    acc[ai][bj][m][0] = acc[ai][bj][m][0] * r0; acc[ai][bj][m][1] = acc[ai][bj][m][1] * r1;
                }
            }
    }
    __device__ __forceinline__ void operator()(const f32x4 (&acc)[2][2][4][2], const Unit& u, int wr, int wc, int, int) const {
        unsigned z_ = 0u; asm volatile("" : "+v"(z_)); const int ln_ = __builtin_amdgcn_mbcnt_hi(~0u, __builtin_amdgcn_mbcnt_lo(~0u, z_)); const int fr = ln_ & 15, fq = ln_ >> 4;
        const int row0 = u.pm * BM + wr * 64 + fr, col0 = u.pn * BM + wc * 32 + fq * 8;
        u32x2 gw[2][4][2];
#pragma unroll
        for (int ai = 0; ai < 2; ++ai)
#pragma unroll
            for (int m = 0; m < 4; ++m)
#pragma unroll
                for (int bj = 0; bj < 2; ++bj) gw[ai][m][bj] = *(const u32x2*)((const unsigned char*)G + (size_t)(row0 + ai * HALF + m * 16) * 3072 + 2048 + col0 + bj * HALF);
        constexpr float k8 = 1.0f / 255.0f;
#pragma unroll
        for (int ai = 0; ai < 2; ++ai)
#pragma unroll
            for (int m = 0; m < 4; ++m) {
                const size_t row = (size_t)(row0 + ai * HALF + m * 16);
#pragma unroll
                for (int bj = 0; bj < 2; ++bj) {
                    const int col = col0 + bj * HALF; const u32x2 g = gw[ai][m][bj];
                    const f32x4 g0 = {ub8(g.x, 0) * k8, ub8(g.x, 1) * k8, ub8(g.x, 2) * k8, ub8(g.x, 3) * k8}, g1 = {ub8(g.y, 0) * k8, ub8(g.y, 1) * k8, ub8(g.y, 2) * k8, ub8(g.y, 3) * k8};
                    const f32x4 v0 = acc[ai][bj][m][0] * g0, v1 = acc[ai][bj][m][1] * g1;
                    u32x4 w; w.x = pk2(v0[0], v0[1]); w.y = pk2(v0[2], v0[3]); w.z = pk2(v1[0], v1[1]); w.w = pk2(v1[2], v1[3]); *(u32x4*)(YB + row * DM + col) = w;
                }
            }
    }
};
template <bool XBF> struct EpiResid {
    static constexpr bool PERM = true, AFTER_DRAIN = false, MIDK = false;
    const void* xin; bf16_t* xb; const float* gate; float rs;
    __device__ __forceinline__ void operator()(const f32x4 (&acc)[2][2][4][2], const Unit& u, int wr, int wc, int, int) const {
        unsigned z_ = 0u; asm volatile("" : "+v"(z_)); const int ln_ = __builtin_amdgcn_mbcnt_hi(~0u, __builtin_amdgcn_mbcnt_lo(~0u, z_)); const int fr = ln_ & 15, fq = ln_ >> 4;
        const int row0 = u.pm * BM + wr * 64 + fr, col0 = u.pn * BM + wc * 32 + fq * 8;
        const float* gp = gate + (size_t)((u.pm * BM) / SEQ) * 6144;
#pragma unroll
        for (int bj = 0; bj < 2; ++bj) {
            const int col = col0 + bj * HALF;
            const f32x4 g0 = *(const f32x4*)(gp + col) * rs, g1 = *(const f32x4*)(gp + col + 4) * rs;
            f32x4 xa[2][4], xc[2][4]; u32x4 xw[2][4];
#pragma unroll
            for (int ai = 0; ai < 2; ++ai)
#pragma unroll
                for (int m = 0; m < 4; ++m) {
                    const size_t off = (size_t)(row0 + ai * HALF + m * 16) * DM + col;
                    if (XBF) xw[ai][m] = *(const u32x4*)((const bf16_t*)xin + off);
                    else { xa[ai][m] = *(const f32x4*)((const float*)xin + off); xc[ai][m] = *(const f32x4*)((const float*)xin + off + 4); }
                }
#pragma unroll
            for (int ai = 0; ai < 2; ++ai)
#pragma unroll
                for (int m = 0; m < 4; ++m) {
                    const size_t off = (size_t)(row0 + ai * HALF + m * 16) * DM + col;
                    f32x4 x0, x1;
                    if (XBF) { const u32x4 q = xw[ai][m]; x0 = (f32x4){bflo(q.x), bfhi(q.x), bflo(q.y), bfhi(q.y)}; x1 = (f32x4){bflo(q.z), bfhi(q.z), bflo(q.w), bfhi(q.w)}; }
                    else { x0 = xa[ai][m]; x1 = xc[ai][m]; }
                    x0 = x0 + g0 * acc[ai][bj][m][0]; x1 = x1 + g1 * acc[ai][bj][m][1];
                    u32x4 w; w.x = pk2(x0[0], x0[1]); w.y = pk2(x0[2], x0[3]); w.z = pk2(x1[0], x1[1]); w.w = pk2(x1[2], x1[3]);
                    *(u32x4*)(xb + off) = w;
                }
            asm volatile("" ::: "memory");
        }
    }
};
struct EpiSwiglu {
    static constexpr bool PERM = true, AFTER_DRAIN = false, MIDK = false;
    bf16_t* ACT; int npn; float qs;
    __device__ __forceinline__ void operator()(const f32x4 (&acc)[2][2][4][2], const Unit& u, int wr, int wc, int, int) const {
        unsigned z_ = 0u; asm volatile("" : "+v"(z_)); const int ln_ = __builtin_amdgcn_mbcnt_hi(~0u, __builtin_amdgcn_mbcnt_lo(~0u, z_)); const int fr = ln_ & 15, fq = ln_ >> 4;
        const int row0 = u.pm * BM + wr * 64 + fr, col0 = (u.pn % npn) * HALF + wc * 32 + fq * 8;
#pragma unroll
        for (int ai = 0; ai < 2; ++ai)
#pragma unroll
            for (int m = 0; m < 4; ++m) {
                float s[8];
#pragma unroll
                for (int n = 0; n < 2; ++n)
#pragma unroll
                    for (int i = 0; i < 4; ++i) { const float g = acc[ai][0][m][n][i], up = acc[ai][1][m][n][i]; s[4 * n + i] = g * __builtin_amdgcn_rcpf(1.0f + __builtin_amdgcn_exp2f(-LOG2E * g)) * up; if (PROBE_FP8 && qs != 0.f) s[4 * n + i] = q8(s[4 * n + i], qs); }
                u32x4 w; w.x = pk2(s[0], s[1]); w.y = pk2(s[2], s[3]); w.z = pk2(s[4], s[5]); w.w = pk2(s[6], s[7]);
                *(u32x4*)(ACT + (size_t)(row0 + ai * HALF + m * 16) * DFF + col0) = w;
                asm volatile("" ::: "memory");
            }
    }
};
struct EpiSwiglu8 {
    static constexpr bool PERM = true, AFTER_DRAIN = false, MIDK = false;
    unsigned char* ACT; int npn; float sg, su;
    __device__ __forceinline__ void operator()(const f32x4 (&acc)[2][2][4][2], const Unit& u, int wr, int wc, int, int) const {
        unsigned z_ = 0u; asm volatile("" : "+v"(z_)); const int ln_ = __builtin_amdgcn_mbcnt_hi(~0u, __builtin_amdgcn_mbcnt_lo(~0u, z_)); const int fr = ln_ & 15, fq = ln_ >> 4;
        const int row0 = u.pm * BM + wr * 64 + fr, col0 = (u.pn % npn) * HALF + wc * 32 + fq * 8;
#pragma unroll
        for (int ai = 0; ai < 2; ++ai)
#pragma unroll
            for (int m = 0; m < 4; ++m) {
                float s[8];
#pragma unroll
                for (int n = 0; n < 2; ++n)
#pragma unroll
                    for (int i = 0; i < 4; ++i) { const float g = acc[ai][0][m][n][i] * sg, up = acc[ai][1][m][n][i] * su; s[4 * n + i] = g * __builtin_amdgcn_rcpf(1.0f + __builtin_amdgcn_exp2f(-LOG2E * g)) * up; }
                unsigned long long w = (unsigned long long)pk4_fp8(s[0], s[1], s[2], s[3]) | ((unsigned long long)pk4_fp8(s[4], s[5], s[6], s[7]) << 32);
                *(unsigned long long*)(ACT + (size_t)(row0 + ai * HALF + m * 16) * DFF + col0) = w;
                asm volatile("" ::: "memory");
            }
    }
};
struct EpiMoeY {
    static constexpr bool PERM = true, AFTER_DRAIN = false, MIDK = false;
    bf16_t* Y; const float* gate; const int* tok; const float* wrow; float sc;
    __device__ __forceinline__ void operator()(const f32x4 (&acc)[2][2][4][2], const Unit& u, int wr, int wc, int, int) const {
        unsigned z_ = 0u; asm volatile("" : "+v"(z_)); const int ln_ = __builtin_amdgcn_mbcnt_hi(~0u, __builtin_amdgcn_mbcnt_lo(~0u, z_)); const int fr = ln_ & 15, fq = ln_ >> 4;
        const int row0 = u.pm * BM + wr * 64 + fr, col0 = (u.pn & 3) * BM + wc * 32 + fq * 8;
        int ids[2][4]; float wsc[2][4];
#pragma unroll
        for (int ai = 0; ai < 2; ++ai)
#pragma unroll
            for (int m = 0; m < 4; ++m) { const int r = row0 + ai * HALF + m * 16; ids[ai][m] = tok[r]; wsc[ai][m] = wrow[r] * sc; }
#pragma unroll
        for (int ai = 0; ai < 2; ++ai) {
            f32x4 gq[4][2][2];
#pragma unroll
            for (int m = 0; m < 4; ++m) { const int id = ids[ai][m]; const float* gp = gate + (size_t)(((id >= 0) ? (id >> 1) : 0) / SEQ) * 6144;
#pragma unroll
                for (int bj = 0; bj < 2; ++bj) { gq[m][bj][0] = *(const f32x4*)(gp + col0 + bj * HALF); gq[m][bj][1] = *(const f32x4*)(gp + col0 + bj * HALF + 4); } }
#pragma unroll
            for (int m = 0; m < 4; ++m) { const int id = ids[ai][m];
                if (id >= 0) { const float w = wsc[ai][m];
#pragma unroll
                    for (int bj = 0; bj < 2; ++bj) {
                        const int col = col0 + bj * HALF; const f32x4 g0 = gq[m][bj][0] * w, g1 = gq[m][bj][1] * w;
                        const f32x4 v0 = acc[ai][bj][m][0] * g0, v1 = acc[ai][bj][m][1] * g1;
                        u32x4 o; o.x = pk2(v0[0], v0[1]); o.y = pk2(v0[2], v0[3]); o.z = pk2(v1[0], v1[1]); o.w = pk2(v1[2], v1[3]);
                        *(u32x4*)(Y + (size_t)id * DM + col) = o;
                    }
                }
            }
            asm volatile("" ::: "memory");
        }
    }
};
struct MoeOrder {
    StaticOrder so; const int* tmap; int npn;
    __device__ __forceinline__ bool next(int i, Unit& u) const { if (!so.next(i, u)) return false; u.pn += tmap[u.pm] * npn; return true; }
    __device__ __forceinline__ void a_ready(const Unit&) const {}
    __device__ __forceinline__ void done(const Unit&) const {}
};
}
#define XB_TMO      128
#define XB_XCNT(j)  (256  + 64 * (j))
#define XB_XSUB(j)  (1280 + 64 * (j))
#define XB_XGEN(j)  (2304 + 64 * (j))
#define XB_TOP      3328
#define XB_TOPGEN   3392
#define XCD_BAR_WORDS 3456
#define XB_SPIN_CAP (1u << 18)

__device__ __forceinline__ unsigned xb_ld(unsigned* p)              { return __hip_atomic_load(p, __ATOMIC_RELAXED, __HIP_MEMORY_SCOPE_AGENT); }
__device__ __forceinline__ unsigned xb_add(unsigned* p, unsigned v) { return __hip_atomic_fetch_add(p, v, __ATOMIC_RELAXED, __HIP_MEMORY_SCOPE_AGENT); }
__device__ __forceinline__ unsigned xb_xcc_id() { return (unsigned)__builtin_amdgcn_s_getreg((3 << 11) | 20) & 0xFu; }
#define XB_SPIN(cond, bar) do { unsigned _sp = 0; while (cond) { __builtin_amdgcn_s_sleep(1); \
    if ((++_sp & 255u) == 0u) { if (xb_ld(&(bar)[XB_TMO])) break; if (_sp > XB_SPIN_CAP) { atomicAdd(&(bar)[XB_TMO], 1u); break; } } } } while (0)

struct XcdBarrier {
    unsigned* bar; unsigned x;
    volatile LAS unsigned* st;
};

__device__ __forceinline__ XcdBarrier xcd_barrier_post(unsigned* bar, volatile LAS unsigned* st, bool t0) {
    XcdBarrier b; b.bar = bar; b.x = xb_xcc_id(); b.st = st;
    if (t0) (void)xb_add(&bar[XB_XCNT(b.x)], 1u);
    return b;
}
__device__ __forceinline__ void xcd_barrier_complete(unsigned* bar, unsigned x, unsigned& nloc, unsigned& nx) {
    const unsigned G = gridDim.x * gridDim.y * gridDim.z;
    unsigned sum, cnt, mine, sp = 0u;
    for (;;) {
        sum = 0u; cnt = 0u; mine = 0u;
#pragma unroll
        for (unsigned j = 0; j < 16; ++j) { const unsigned c = xb_ld(&bar[XB_XCNT(j)]); sum += c; cnt += (c > 0u) ? 1u : 0u; mine = (j == x) ? c : mine; }
        if (sum == G) break;
        __builtin_amdgcn_s_sleep(1);
        if ((++sp & 255u) == 0u) { if (xb_ld(&bar[XB_TMO])) break; if (sp > XB_SPIN_CAP) { atomicAdd(&bar[XB_TMO], 1u); break; } }
    }
    nloc = mine > 0u ? mine : 1u; nx = cnt > 0u ? cnt : 1u;
}

__device__ __forceinline__ void xcd_barrier(const XcdBarrier& b, int wave_k) {
    asm volatile("s_waitcnt vmcnt(0)" ::: "memory");
    __syncthreads();
    if (wave_k == 0 && lane_opq() == 0) {
        unsigned* bar = b.bar;
        __builtin_amdgcn_s_waitcnt(0);
        unsigned nloc = b.st[0], nx = b.st[1];
        if (nloc == 0u) { xcd_barrier_complete(bar, b.x, nloc, nx); b.st[0] = nloc; b.st[1] = nx; }
        const unsigned old = xb_add(&bar[XB_XSUB(b.x)], 1u);
        const unsigned gen = old / nloc;
        if (old + 1u == (gen + 1u) * nloc) {
            __builtin_amdgcn_fence(__ATOMIC_RELEASE, "agent");
            asm volatile("s_waitcnt vmcnt(0)" ::: "memory");
            const unsigned og = xb_add(&bar[XB_TOP], 1u);
            const unsigned tg = og / nx;
            if (og + 1u == (tg + 1u) * nx) xb_add(&bar[XB_TOPGEN], 1u);
            else XB_SPIN(xb_ld(&bar[XB_TOPGEN]) == tg, bar);
            __builtin_amdgcn_fence(__ATOMIC_ACQUIRE, "agent");
            xb_add(&bar[XB_XGEN(b.x)], 1u);
            asm volatile("s_waitcnt vmcnt(0)" ::: "memory");
        } else {
            XB_SPIN(xb_ld(&bar[XB_XGEN(b.x)]) == gen, bar);
            __builtin_amdgcn_fence(__ATOMIC_ACQUIRE, "agent");
            asm volatile("s_waitcnt vmcnt(0)" ::: "memory");
        }
    }
    __syncthreads();
}

struct ConvItem { const float* src; size_t ldw; unsigned char* dst; int ldk; int fp8; };
__device__ __forceinline__ void conv_load(const ConvItem& d, float (&v)[32], int lane) {
#pragma unroll
    for (int i = 0; i < 32; ++i) v[i] = d.src[(size_t)(2 * i + (lane >> 5)) * d.ldw + (lane & 31)];
}
__device__ __forceinline__ void conv_store(const ConvItem& d, const float (&v)[32], LAS float* scr, int lane) {
    const float qs = d.fp8 ? F8_WS : 1.0f;
#pragma unroll
    for (int i = 0; i < 32; ++i) scr[(2 * i + (lane >> 5)) * 33 + (lane & 31)] = v[i] * qs;
    LDS_WAIT(); asm volatile("" ::: "memory");
    if (d.fp8) { const int c = lane & 3;
#pragma unroll
        for (int j = 0; j < 2; ++j) { const int n = (lane >> 2) + 16 * j; const LAS float* s = scr + (16 * c) * 33 + n;
            v4u o; o.x = pk4_fp8(s[0 * 33], s[1 * 33], s[2 * 33], s[3 * 33]); o.y = pk4_fp8(s[4 * 33], s[5 * 33], s[6 * 33], s[7 * 33]);
            o.z = pk4_fp8(s[8 * 33], s[9 * 33], s[10 * 33], s[11 * 33]); o.w = pk4_fp8(s[12 * 33], s[13 * 33], s[14 * 33], s[15 * 33]);
            *(GAS v4u*)(d.dst + (size_t)n * d.ldk + 16 * c) = o; } }
    else { const int c = lane & 7;
#pragma unroll
        for (int j = 0; j < 4; ++j) { const int n = (lane >> 3) + 8 * j; const LAS float* s = scr + (8 * c) * 33 + n;
            v4u o; o.x = pk2(s[0 * 33], s[1 * 33]); o.y = pk2(s[2 * 33], s[3 * 33]); o.z = pk2(s[4 * 33], s[5 * 33]); o.w = pk2(s[6 * 33], s[7 * 33]);
            *(GAS v4u*)(d.dst + (size_t)n * d.ldk + 16 * c) = o; } }
    LDS_WAIT(); asm volatile("" ::: "memory");
}
__device__ __forceinline__ int map_qkv(int c0) { const int sec = c0 / QW, cs = c0 % QW, head = cs >> 6, bj = (cs >> 5) & 1; return sec * QW + (head >> 2) * 256 + bj * 128 + (head & 3) * 32; }
__device__ __forceinline__ int map_gu(int c0, int up) { return (c0 >> 7) * 256 + up * 128 + (c0 & 96); }

struct KArgs { const float* in[22]; float* out; unsigned char* ws; int ph_lo, ph_hi; };
__device__ __forceinline__ const float* karg_ptr(int i) { int j = i; asm volatile("" : "+s"(j));
    const __attribute__((address_space(4))) unsigned long long* kp = (const __attribute__((address_space(4))) unsigned long long*)__builtin_amdgcn_kernarg_segment_ptr(); return (const float*)(const GAS float*)kp[j]; }
#define AIN(k) karg_ptr(k)
#define AOUT ((float*)karg_ptr(22))

constexpr int CONV_PER_LAYER = 2304 + 1536 + 192 + 192 + 128 + 512, CONV_NITEMS = 2 * CONV_PER_LAYER + 9 * 4224;
__device__ __forceinline__ void conv_decode(int it, GAS unsigned char* ws, ConvItem& d) {
    d.fp8 = 0;
    if (it < 2 * CONV_PER_LAYER) {
        const int l = it / CONV_PER_LAYER; int r = it % CONV_PER_LAYER;
        const float* win = AIN(6) + (size_t)l * DM * IN_COLS;
        if (r < 2304) { const int kb = r / 144, nb = r % 144; d.src = win + (size_t)(64 * kb) * IN_COLS + 32 * nb; d.ldw = IN_COLS;
            if (V_FP8 && nb >= 96) { d.ldk = DM; d.fp8 = 1;
                d.dst = (unsigned char*)(ws + WS_WIN) + (size_t)l * 15 * MiB + WS_WG8_OFF + (size_t)map_qkv(32 * nb) * DM + 64 * kb; return; }
            d.ldk = DM * 2; d.dst = (unsigned char*)(ws + WS_WIN) + (size_t)l * 15 * MiB + (size_t)map_qkv(32 * nb) * DM * 2 + 64 * kb * 2; return; } r -= 2304;
        if (r < 1536) { const int kb = r / 96, nb = r % 96; d.src = win + (size_t)(64 * kb) * IN_COLS + 4614 + 32 * nb; d.ldw = IN_COLS; d.ldk = DM; d.fp8 = 1;
            d.dst = (unsigned char*)(ws + WS_WIN) + (size_t)l * 15 * MiB + WS_WG8_OFF + (size_t)(32 * nb) * DM + 64 * kb; return; } r -= 1536;
        unsigned char* wbr = (unsigned char*)(ws + WS_WBR) + (size_t)l * DM * DM * 2;
        if (r < 192) { const int kb = r / 32, nb = r % 32; d.src = AIN(10) + (size_t)l * FOXW * DM + (size_t)(64 * kb) * DM + 32 * nb; d.ldw = DM; d.ldk = DM * 2; d.dst = wbr + (size_t)(32 * nb) * DM * 2 + (64 * kb) * 2; return; } r -= 192;
        if (r < 192) { const int kb = r / 32, nb = r % 32; d.src = AIN(11) + (size_t)l * MOBW * DM + (size_t)(64 * kb) * DM + 32 * nb; d.ldw = DM; d.ldk = DM * 2; d.dst = wbr + (size_t)(32 * nb) * DM * 2 + (384 + 64 * kb) * 2; return; } r -= 192;
        if (r < 128) { const int kb = r / 32, nb = r % 32; d.src = AIN(12) + (size_t)l * DILW * DM + (size_t)(64 * kb) * DM + 32 * nb; d.ldw = DM; d.ldk = DM * 2; d.dst = wbr + (size_t)(32 * nb) * DM * 2 + (768 + 64 * kb) * 2; return; } r -= 128;
        { const int kb = r / 32, nb = r % 32; d.src = AIN(13) + (size_t)l * DM * DM + (size_t)(64 * kb) * DM + 32 * nb; d.ldw = DM; d.ldk = DM * 2;
          d.dst = (unsigned char*)(ws + WS_WOUT) + (size_t)l * DM * DM * 2 + (size_t)(32 * nb) * DM * 2 + (64 * kb) * 2; return; }
    }
    const int q = it - 2 * CONV_PER_LAYER, ex = q / 4224; int r = q % 4224;
    const int f8 = ((ex > 0 && MOE_FP8) || (ex == 0 && DENSE2_FP8 && r >= 2816)) ? 1 : 0, eb = f8 ? 1 : 2;
    const size_t e = ex > 0 ? ex - 1 : 0;
    const float* wg = ex == 0 ? AIN(14) : AIN(19) + e * DM * DFF; const float* wu = ex == 0 ? AIN(15) : AIN(20) + e * DM * DFF; const float* wd = ex == 0 ? AIN(16) : AIN(21) + e * DFF * DM;
    unsigned char* w1t = ex == 0 ? (unsigned char*)(ws + WS_WF1) : (unsigned char*)(ws + WS_WE1) + e * 5632 * DM * eb;
    unsigned char* w2t = ex == 0 ? (unsigned char*)(ws + WS_WF2) : (unsigned char*)(ws + WS_WE2) + e * DM * DFF * eb;
    d.fp8 = f8;
    if (r < 2816) { const int up = r >= 1408; r -= up * 1408; const int kb = r / 88, nb = r % 88; d.src = (up ? wu : wg) + (size_t)(64 * kb) * DFF + 32 * nb; d.ldw = DFF; d.ldk = DM * eb;
        d.dst = w1t + ((size_t)map_gu(32 * nb, up) * DM + 64 * kb) * eb; return; } r -= 2816;
    { const int kb = r / 32, nb = r % 32; d.src = wd + (size_t)(64 * kb) * DM + 32 * nb; d.ldw = DM; d.ldk = DFF * eb; d.dst = w2t + ((size_t)(32 * nb) * DFF + 64 * kb) * eb; }
}
__device__ __forceinline__ void phase_mods(GAS unsigned char* ws, LAS unsigned char* lds, int tid, int lane, int wave) {
    __syncthreads();
    {
        LAS float* cond = (LAS float*)lds;
        LAS float* part = (LAS float*)(lds + 32768);
        const float* c = AIN(1);
        { float cv[NB * DM / NTHR];
#pragma unroll
          for (int i = 0; i < NB * DM / NTHR; ++i) cv[i] = c[tid + NTHR * i];
#pragma unroll
          for (int i = 0; i < NB * DM / NTHR; ++i) cond[tid + NTHR * i] = cv[i] / (1.0f + __expf(-cv[i])); }
        __syncthreads();
        float* mods = (float*)(ws + WS_MODS);
        for (int u = blockIdx.x; u < 2 * 96; u += gridDim.x) {
            const int l = u / 96, cg = u % 96, col = tid & 63, ks = tid >> 6;
            const float* w = AIN(2) + (size_t)l * DM * 6144 + cg * 64 + col;
            float acc[8];
#pragma unroll
            for (int b = 0; b < 8; ++b) acc[b] = 0.f;
            for (int k0 = ks * 128; k0 < ks * 128 + 128; k0 += 32) {
                float wv[32];
#pragma unroll
                for (int kk = 0; kk < 32; ++kk) wv[kk] = w[(size_t)(k0 + kk) * 6144];
#pragma unroll
                for (int kk = 0; kk < 32; ++kk) {
#pragma unroll
                    for (int b = 0; b < 8; ++b) acc[b] += cond[b * DM + k0 + kk] * wv[kk]; }
            }
#pragma unroll
            for (int b = 0; b < 8; ++b) part[(ks * 8 + b) * 64 + col] = acc[b];
            __syncthreads();
            { const int b = tid >> 6; float s = 0.f;
#pragma unroll
              for (int k2 = 0; k2 < 8; ++k2) s += part[(k2 * 8 + b) * 64 + col];
              mods[((size_t)l * NB + b) * 6144 + cg * 64 + col] = s + AIN(3)[(size_t)l * 6144 + cg * 64 + col]; }
            __syncthreads();
        }
        __syncthreads();
    }
    if (blockIdx.x == 0) { float* gains = (float*)(ws + WS_GAINS);
        for (int i = tid; i < 2 * 2 * QW; i += NTHR) { const int l = i / (2 * QW), r = i % (2 * QW); gains[i] = (r < QW) ? AIN(8)[l * QW + r] * C2 : AIN(9)[l * QW + r - QW]; } }
}
__device__ __forceinline__ void conv_run(GAS unsigned char* ws, LAS unsigned char* lds, int lane, int wave, int first, int stride, int end) {
    LAS float* scr = (LAS float*)(lds + wave * 16384);
    ConvItem cur, nxt; float va[32], vb[32];
    int it = first;
    if (it < end) { conv_decode(it, ws, cur); conv_load(cur, va, lane); }
    for (; it < end; it += 2 * stride) {
        const bool h1 = it + stride < end, h2 = it + 2 * stride < end;
        if (h1) { conv_decode(it + stride, ws, nxt); conv_load(nxt, vb, lane); }
        conv_store(cur, va, scr, lane);
        if (h2) { conv_decode(it + 2 * stride, ws, cur); conv_load(cur, va, lane); }
        if (h1) conv_store(nxt, vb, scr, lane);
    }
}
__device__ __forceinline__ void conv_run4(GAS unsigned char* ws, LAS unsigned char* lds, int lane, int wave, int first, int stride, int end) {
    LAS float* scr = (LAS float*)(lds + wave * 16384);
    ConvItem c0, c1, c2, c3; float v0[32], v1[32], v2[32], v3[32];
    const bool h0 = first < end, h1 = first + stride < end, h2 = first + 2 * stride < end, h3 = first + 3 * stride < end;
    if (h0) { conv_decode(first, ws, c0); conv_load(c0, v0, lane); }
    if (h1) { conv_decode(first + stride, ws, c1); conv_load(c1, v1, lane); }
    if (h2) { conv_decode(first + 2 * stride, ws, c2); conv_load(c2, v2, lane); }
    if (h3) { conv_decode(first + 3 * stride, ws, c3); conv_load(c3, v3, lane); }
    if (h0) conv_store(c0, v0, scr, lane);
    if (h1) conv_store(c1, v1, scr, lane);
    if (h2) conv_store(c2, v2, scr, lane);
    if (h3) conv_store(c3, v3, scr, lane);
}
constexpr int CONV_FIRST = 2304 + 1536, CONV_SPLIT = 2 * CONV_PER_LAYER + 5 * 4224, CONV_UNIT = 32;
__device__ __forceinline__ void phase_convert(GAS unsigned char* ws, LAS unsigned char* lds, int tid, int lane, int wave) {
    __syncthreads();
    conv_run(ws, lds, lane, wave, blockIdx.x * NWAVES + wave, gridDim.x * NWAVES, CONV_FIRST);
}

template <int MODE, bool XBF>
__device__ __forceinline__ void phase_norm(const void* xs, const float* gain, const float* mods  , int shift_off, int scale_off,
                                           bf16* hout, unsigned char* h8out, const float* win, const float* bfg, float* flog, const float* wr, const float* br, int* sel, float* wt, int* rcnt, int* tok, float* wrow, int* tile_e,
                                           LAS unsigned char* lds, int tid, int lane, int wave) {
    LAS float* wf = (LAS float*)lds;
    if (MODE == 0) { for (int i = tid; i < 6 * DM; i += NTHR) { const int hh = i / DM, k = i % DM; wf[i] = win[(size_t)k * IN_COLS + 4608 + hh]; } __syncthreads(); }
    if (MODE == 2) { for (int i = tid; i < 8 * DM; i += NTHR) { const int e = i / DM, k = i % DM; wf[i] = wr[(size_t)k * NE + e]; } __syncthreads(); }
    const int gw = blockIdx.x * NWAVES + wave, NGW = gridDim.x * NWAVES;
    const int tpw = (M + NGW - 1) / NGW;
    int cntv = 0;
    if (MODE == 3) {
        LAS int* part = (LAS int*)lds;
        LAS int* tab = (LAS int*)(lds + 2048);
        const int cpp = (NGW + 63) / 64, g0 = blockIdx.x * NWAVES;
        { const int e = tid & 7, p = tid >> 3; int s = 0; for (int gi = p * cpp; gi < (p + 1) * cpp && gi < NGW; ++gi) s += rcnt[gi * 8 + e]; part[p * 8 + e] = s; }
        __syncthreads();
        if (tid < 8) { int T = 0, S = 0; const int pf = g0 / cpp; for (int p = 0; p < 64; ++p) { const int x = part[p * 8 + tid]; T += x; if (p < pf) S += x; }
            for (int gi = pf * cpp; gi < g0; ++gi) S += rcnt[gi * 8 + tid]; tab[tid] = T; tab[8 + tid] = S; }
        __syncthreads();
        if (tid == 0) { int bse = 0; for (int e = 0; e < 8; ++e) { tab[16 + e] = bse; bse += (tab[e] + 255) & ~255; } tab[24] = bse; }
        __syncthreads();
        if (lane < 8) { int v = tab[16 + lane] + tab[8 + lane]; for (int w = 0; w < wave; ++w) v += rcnt[(g0 + w) * 8 + lane]; cntv = v; }
        if (blockIdx.x == 0) {
            for (int e = 0; e < 8; ++e) { const int lo_ = tab[16 + e] + tab[e], hi_ = tab[16 + e + 1]; for (int p = lo_ + tid; p < hi_; p += NTHR) { tok[p] = -1; wrow[p] = 0.f; }
                for (int i = tab[16 + e] / 256 + tid; i < hi_ / 256; i += NTHR) tile_e[i] = e; }
            if (tid == 0) tile_e[255] = tab[24] / 256;
        }
    }
    f32x4 g[4], sc[4], sh[4]; int curb = -1;
#pragma unroll
    for (int j = 0; j < 4; ++j) g[j] = *(const f32x4*)(gain + 4 * lane + 256 * j);
#define NRM_LOAD(RF, RH, mm) do { _Pragma("unroll") for (int j_ = 0; j_ < 4; ++j_) { \
        if (XBF) RH[j_] = *((const GAS unsigned long long*)((const bf16*)xs + (size_t)(mm) * DM + 256 * j_) + lane); \
        else RF[j_] = *(const f32x4*)((const float*)xs + (size_t)(mm) * DM + 4 * lane + 256 * j_); } } while (0)
    const int m0 = gw * tpw, m1 = ((gw + 1) * tpw < M) ? (gw + 1) * tpw : M;
    int selv = 0; float wtv = 0.f;
    const bool pre3 = (MODE == 3) && tpw <= 32;
    if (pre3) { if (2 * m0 + lane < 2 * m1) { selv = sel[2 * m0 + lane]; wtv = wt[2 * m0 + lane]; } }
    f32x4 curf[4], nxtf[4]; unsigned long long curh[4], nxth[4];
#pragma unroll
    for (int j = 0; j < 4; ++j) { curf[j] = (f32x4){0.f, 0.f, 0.f, 0.f}; nxtf[j] = curf[j]; curh[j] = 0ull; nxth[j] = 0ull; }
    if (m0 < m1) NRM_LOAD(curf, curh, m0);
    for (int m = m0; m < m1; ++m) {
        if (m + 1 < m1) NRM_LOAD(nxtf, nxth, m + 1);
        const int b = m / SEQ;
        if (b != curb) { curb = b;
#pragma unroll
            for (int j = 0; j < 4; ++j) { sc[j] = *(const f32x4*)(mods + (size_t)b * 6144 + scale_off + 4 * lane + 256 * j); sh[j] = *(const f32x4*)(mods + (size_t)b * 6144 + shift_off + 4 * lane + 256 * j); } }
        f32x4 v[4]; float ss = 0.f;
#pragma unroll
        for (int j = 0; j < 4; ++j) {
            if (XBF) { const unsigned lo_ = (unsigned)curh[j], hi_ = (unsigned)(curh[j] >> 32); v[j] = (f32x4){bflo(lo_), bfhi(lo_), bflo(hi_), bfhi(hi_)}; }
            else v[j] = curf[j];
            ss += (v[j].x * v[j].x + v[j].y * v[j].y) + (v[j].z * v[j].z + v[j].w * v[j].w); }
#pragma unroll
        for (int j = 0; j < 4; ++j) { curf[j] = nxtf[j]; curh[j] = nxth[j]; }
        const float rstd = 1.0f / sqrtf(wave_sum(ss) * (1.0f / DM) + RMS_EPS);
#pragma unroll
        for (int j = 0; j < 4; ++j) v[j] = v[j] * rstd * g[j] * (sc[j] + 1.0f) + sh[j];
        if (MODE == 1 && PROBE_FP8 == 2) {
#pragma unroll
            for (int j = 0; j < 4; ++j) { v[j].x = q8(v[j].x, 1.f); v[j].y = q8(v[j].y, 1.f); v[j].z = q8(v[j].z, 1.f); v[j].w = q8(v[j].w, 1.f); } }
        if (MODE == 0 || MODE == 1) {
            GAS unsigned long long* o8 = (GAS unsigned long long*)(hout + (size_t)m * DM) + lane;
#pragma unroll
            for (int j = 0; j < 4; ++j) o8[64 * j] = (unsigned long long)pk2(v[j].x, v[j].y) | ((unsigned long long)pk2(v[j].z, v[j].w) << 32);
        }
        if (MODE == 0) { GAS unsigned* o4 = (GAS unsigned*)(h8out + (size_t)m * DM) + lane;
#pragma unroll
            for (int j = 0; j < 4; ++j) o4[64 * j] = pk4_fp8(v[j].x, v[j].y, v[j].z, v[j].w); }
        if (MODE == 3) {
            if (PROBE_FP8) {
#pragma unroll
                for (int j = 0; j < 4; ++j) { v[j].x = q8(v[j].x, 1.f); v[j].y = q8(v[j].y, 1.f); v[j].z = q8(v[j].z, 1.f); v[j].w = q8(v[j].w, 1.f); } }
#pragma unroll
            for (int k2 = 0; k2 < 2; ++k2) { const int ex = pre3 ? shfl_li(selv, 2 * (m - m0) + k2) : sel[2 * m + k2]; const float wk = pre3 ? shfl_l(wtv, 2 * (m - m0) + k2) : wt[2 * m + k2]; const int p = shfl_li(cntv, ex); if (lane == ex) ++cntv;
                if (lane == 0) { tok[p] = 2 * m + k2; wrow[p] = wk; }
                if (MOE_FP8) { GAS unsigned* o4 = (GAS unsigned*)((unsigned char*)hout + (size_t)p * DM) + lane;
#pragma unroll
                    for (int j = 0; j < 4; ++j) o4[64 * j] = pk4_fp8(v[j].x, v[j].y, v[j].z, v[j].w); }
                else { GAS unsigned long long* o8 = (GAS unsigned long long*)(hout + (size_t)p * DM) + lane;
#pragma unroll
                    for (int j = 0; j < 4; ++j) o8[64 * j] = (unsigned long long)pk2(v[j].x, v[j].y) | ((unsigned long long)pk2(v[j].z, v[j].w) << 32); } }
        }
        if (MODE == 0) {
            const int t = m % SEQ;
#pragma unroll
            for (int hh = 0; hh < 6; ++hh) { float d = 0.f;
#pragma unroll
                for (int j = 0; j < 4; ++j) { const f32x4 w = *(const LAS f32x4*)(wf + hh * DM + 4 * lane + 256 * j); d += (v[j].x * w.x + v[j].y * w.y) + (v[j].z * w.z + v[j].w * w.w); }
                d = wave_sum(d) + bfg[hh]; if (lane == 0) flog[((size_t)b * 6 + hh) * SEQ + t] = (fminf(d, 0.f) - log1pf(expf(-fabsf(d)))) * LOG2E; }
        }
        if (MODE == 2) {
            float lg[8];
#pragma unroll
            for (int e = 0; e < 8; ++e) { float d = 0.f;
#pragma unroll
                for (int j = 0; j < 4; ++j) { const f32x4 w = *(const LAS f32x4*)(wf + e * DM + 4 * lane + 256 * j); d += (v[j].x * w.x + v[j].y * w.y) + (v[j].z * w.z + v[j].w * w.w); }
                lg[e] = wave_sum(d) + br[e]; }
            int i0 = 0; float v0 = lg[0];
#pragma unroll
            for (int e = 1; e < 8; ++e) if (lg[e] > v0) { v0 = lg[e]; i0 = e; }
            int i1 = -1; float v1 = -3.0e38f;
#pragma unroll
            for (int e = 0; e < 8; ++e) if (e != i0 && lg[e] > v1) { v1 = lg[e]; i1 = e; }
            const float e1 = __expf(v1 - v0), w0 = 1.0f / (1.0f + e1), w1 = e1 / (1.0f + e1);
            if (lane == 0) { sel[2 * m] = i0; sel[2 * m + 1] = i1; wt[2 * m] = w0; wt[2 * m + 1] = w1; }
            if (lane == i0 || lane == i1) ++cntv;
        }
    }
    if (MODE == 2) { if (lane < 8) rcnt[gw * 8 + lane] = cntv; }
}

__device__ __forceinline__ void phase_scan(const float* flog, float* fcum, const bf16* K, float* kmean, LAS unsigned char* lds, int tid, int lane, int wave) {
    LAS float* wtot = (LAS float*)lds;
    for (int u = blockIdx.x; u < NB * 6; u += gridDim.x) {
        const f32x4 f = *(const f32x4*)(flog + (size_t)u * SEQ + 4 * tid);
        float a[4];
#pragma unroll
        for (int i = 0; i < 4; ++i) { const float x = f[i]; a[i] = (fminf(x, 0.f) - log1pf(expf(-fabsf(x)))) * LOG2E; }
        a[1] += a[0]; a[2] += a[1]; a[3] += a[2];
        float incl = a[3];
#pragma unroll
        for (int o = 1; o < 64; o <<= 1) { const float t = shfl_l(incl, (lane - o) & 63); if (lane >= o) incl += t; }
        if (lane == 63) wtot[wave] = incl;
        __syncthreads();
        float base = incl - a[3];
        for (int w = 0; w < wave; ++w) base += wtot[w];
        f32x4 o = {a[0] + base, a[1] + base, a[2] + base, a[3] + base};
        *(f32x4*)(fcum + (size_t)u * SEQ + 4 * tid) = o;
        __syncthreads();
    }
    const int gw = blockIdx.x * NWAVES + wave, NGW = gridDim.x * NWAVES;
    for (int it = gw; it < NB * 6 * 8; it += NGW) {
        const int b = it / 48, hm = (it / 8) % 6, blk = it % 8;
        const bf16* kp = K + ((size_t)b * SEQ + blk * 256) * QW + (6 + hm) * 64 + lane;
        float s = 0.f;
        for (int i = 0; i < 256; ++i) s += bflo((unsigned)kp[(size_t)i * QW]);
        kmean[(size_t)it * 64 + lane] = s * (1.0f / 256.0f);
    }
}

__device__ __forceinline__ void phase_moe_combine(float* out, const bf16* XB, const bf16* Y, int tid) {
    const int stride = gridDim.x * NTHR, NIT = M * (DM / 8);
    for (int it0 = blockIdx.x * NTHR + tid; it0 < NIT; it0 += 4 * stride) {
        v4u a[4], bq[4], x[4];
#pragma unroll
        for (int q = 0; q < 4; ++q) { const int it = it0 + q * stride; if (it < NIT) { const int t = it >> 7, ch = it & 127;
            a[q] = *(const v4u*)(Y + (size_t)(2 * t) * DM + ch * 8); bq[q] = *(const v4u*)(Y + (size_t)(2 * t + 1) * DM + ch * 8); x[q] = *(const v4u*)(XB + (size_t)t * DM + ch * 8); } }
#pragma unroll
        for (int q = 0; q < 4; ++q) { const int it = it0 + q * stride; if (it < NIT) { const int t = it >> 7, ch = it & 127;
            float* op = out + (size_t)t * DM + ch * 8;
            f32x4 x0, x1;
            x0.x = bflo(x[q].x) + (bflo(a[q].x) + bflo(bq[q].x)); x0.y = bfhi(x[q].x) + (bfhi(a[q].x) + bfhi(bq[q].x)); x0.z = bflo(x[q].y) + (bflo(a[q].y) + bflo(bq[q].y)); x0.w = bfhi(x[q].y) + (bfhi(a[q].y) + bfhi(bq[q].y));
            x1.x = bflo(x[q].z) + (bflo(a[q].z) + bflo(bq[q].z)); x1.y = bfhi(x[q].z) + (bfhi(a[q].z) + bfhi(bq[q].z)); x1.z = bflo(x[q].w) + (bflo(a[q].w) + bflo(bq[q].w)); x1.w = bfhi(x[q].w) + (bfhi(a[q].w) + bfhi(bq[q].w));
            *(f32x4*)op = x0; *(f32x4*)(op + 4) = x1; } }
    }
}

#define NA_LOADQ(qptr) do { const uint4* q4_ = (const uint4*)(qptr); _Pragma("unroll") for (int c_ = 0; c_ < 8; ++c_) { const uint4 w_ = q4_[c_]; \
    q[8*c_+0] = bflo(w_.x); q[8*c_+1] = bfhi(w_.x); q[8*c_+2] = bflo(w_.y); q[8*c_+3] = bfhi(w_.y); q[8*c_+4] = bflo(w_.z); q[8*c_+5] = bfhi(w_.z); q[8*c_+6] = bflo(w_.w); q[8*c_+7] = bfhi(w_.w); } } while (0)
#define NA_DOT(x, kptr) do { const uint4* k4_ = (const uint4*)(kptr); float s0_ = 0.f, s1_ = 0.f; _Pragma("unroll") for (int c_ = 0; c_ < 8; ++c_) { const uint4 w_ = k4_[c_]; \
    s0_ += q[8*c_+0] * bflo(w_.x) + q[8*c_+2] * bflo(w_.y) + q[8*c_+4] * bflo(w_.z) + q[8*c_+6] * bflo(w_.w); \
    s1_ += q[8*c_+1] * bfhi(w_.x) + q[8*c_+3] * bfhi(w_.y) + q[8*c_+5] * bfhi(w_.z) + q[8*c_+7] * bfhi(w_.w); } x = s0_ + s1_; } while (0)
#define NA_UPD(x, vptr) do { if ((x) > mx) { const float f_ = exp2f(mx - (x)); l *= f_; _Pragma("unroll") for (int d_ = 0; d_ < 64; ++d_) o[d_] *= f_; mx = (x); } \
    const float p_ = exp2f((x) - mx); l += p_; const uint4* v4_ = (const uint4*)(vptr); _Pragma("unroll") for (int c_ = 0; c_ < 8; ++c_) { const uint4 w_ = v4_[c_]; \
    o[8*c_+0] += p_ * bflo(w_.x); o[8*c_+1] += p_ * bfhi(w_.x); o[8*c_+2] += p_ * bflo(w_.y); o[8*c_+3] += p_ * bfhi(w_.y); o[8*c_+4] += p_ * bflo(w_.z); o[8*c_+5] += p_ * bfhi(w_.z); o[8*c_+6] += p_ * bflo(w_.w); o[8*c_+7] += p_ * bfhi(w_.w); } } while (0)
#define NA_STORE(optr) do { const float il_ = 1.0f / l; uint4* o4_ = (uint4*)(optr); _Pragma("unroll") for (int c_ = 0; c_ < 8; ++c_) { uint4 w_; \
    w_.x = pk2(o[8*c_+0] * il_, o[8*c_+1] * il_); w_.y = pk2(o[8*c_+2] * il_, o[8*c_+3] * il_); w_.z = pk2(o[8*c_+4] * il_, o[8*c_+5] * il_); w_.w = pk2(o[8*c_+6] * il_, o[8*c_+7] * il_); o4_[c_] = w_; } } while (0)

__device__ __forceinline__ void phase_attn_naive(const bf16* Q, const bf16* K, const bf16* V, const float* fcum, const float* kmean, bf16* O, int tid, int wave) {
    for (int u = blockIdx.x; u < NB * 12 * 4; u += gridDim.x) {
        const int b = u / 48, h = (u / 4) % 12, ch = u % 4, t = ch * 512 + tid; const size_t m = (size_t)b * SEQ + t;
        float q[64], o[64], mx = -1e30f, l = 0.f;
#pragma unroll
        for (int d = 0; d < 64; ++d) o[d] = 0.f;
        NA_LOADQ(Q + m * QW + h * 64);
        const int smax = ch * 512 + wave * 64 + 63;
        const bf16* kb = K + (size_t)b * SEQ * QW + h * 64; const bf16* vb = V + (size_t)b * SEQ * QW + h * 64;
        if (h < 6) {
            const float* fc = fcum + ((size_t)b * 6 + h) * SEQ; const float fct = fc[t];
            for (int s = 0; s <= smax; ++s) {
                float x; NA_DOT(x, kb + (size_t)s * QW); x += fct - fc[s];
                if (s <= t) NA_UPD(x, vb + (size_t)s * QW);
            }
            NA_STORE(O + m * DM + h * 64);
        } else {
            const int hm = h - 6, qblk = t >> 8; const float slope = alibi_slope(8 + hm) * LOG2E;
            float gt[8];
#pragma unroll
            for (int j = 0; j < 8; ++j) { const float* km = kmean + (((size_t)b * 6 + hm) * 8 + j) * 64; float d = 0.f;
#pragma unroll
                for (int e = 0; e < 64; ++e) d += q[e] * km[e];
                gt[j] = d; }
            unsigned allowed = 1u << qblk;
#pragma unroll
            for (int j = 0; j < 8; ++j) { int rank = 0;
#pragma unroll
                for (int i = 0; i < 8; ++i) if (i < qblk && i != j && (gt[i] > gt[j] || (gt[i] == gt[j] && i < j))) ++rank;
                if (j < qblk && rank < 3) allowed |= 1u << j; }
            for (int s = 0; s <= smax; ++s) {
                float x; NA_DOT(x, kb + (size_t)s * QW); x -= slope * (float)(t - s);
                if (s <= t && ((allowed >> (s >> 8)) & 1u)) NA_UPD(x, vb + (size_t)s * QW);
            }
            NA_STORE(O + m * DM + 384 + hm * 64);
        }
    }
    for (int u = blockIdx.x; u < NB * 4 * 4; u += gridDim.x) {
        const int b = u / 16, slot = (u / 4) % 4, ch = u % 4, t = ch * 512 + tid; const size_t m = (size_t)b * SEQ + t;
        float q[64], o[64], mx = -1e30f, l = 0.f;
#pragma unroll
        for (int d = 0; d < 64; ++d) o[d] = 0.f;
#pragma unroll
        for (int g = 0; g < 3; ++g) {
            const int dil = (g == 0) ? 1 : (g == 1 ? 4 : 16), so = (g == 0) ? 0 : (g == 1 ? 4 : 14), head = 12 + 4 * g + slot;
            const float slope = alibi_slope(so + slot) * LOG2E;
            NA_LOADQ(Q + m * QW + head * 64);
            for (int j = 0; j <= 128; ++j) {
                const int s = t - j * dil;
                if (s >= 0) { const size_t kr = ((size_t)b * SEQ + s) * QW + head * 64; float x; NA_DOT(x, K + kr); x -= slope * (float)(j * dil); NA_UPD(x, V + kr); }
            }
        }
        NA_STORE(O + m * DM + 768 + slot * 64);
    }
}


namespace att {
typedef short bf16x8 __attribute__((ext_vector_type(8)));
typedef short s16x4 __attribute__((ext_vector_type(4)));
typedef float f32x16 __attribute__((ext_vector_type(16)));
typedef unsigned u32x4 __attribute__((ext_vector_type(4)));
typedef float f32x2_t __attribute__((ext_vector_type(2))); typedef __bf16 bf16x2_t __attribute__((ext_vector_type(2)));
constexpr int A_K = 0, A_V = 32768, A_BT = 57344, A_WSF = 65536, A_OST = 67584, A_KB = A_OST, A_Z = 100352, A_BYTES = 100368, SLOT = 8192;
constexpr float THRL = 8.0f;
__device__ __forceinline__ int crow(int r, int hi) { return (r & 3) + 8 * (r >> 2) + 4 * hi; }
__device__ __forceinline__ void glds16(const void* gsrc, unsigned lds_dst) { unsigned keep;
    asm volatile("s_mov_b32 %0, m0\n\ts_mov_b32 m0, %2\n\ts_nop 0\n\tglobal_load_lds_dwordx4 %1, off\n\ts_mov_b32 m0, %0" : "=&s"(keep) : "v"(gsrc), "s"(lds_dst) : "memory"); }
__device__ __forceinline__ void glds16s(const void* sbase, unsigned voff, unsigned lds_dst) { unsigned keep;
    asm volatile("s_mov_b32 %0, m0\n\ts_mov_b32 m0, %3\n\ts_nop 0\n\tglobal_load_lds_dwordx4 %1, %2\n\ts_mov_b32 m0, %0" : "=&s"(keep) : "v"(voff), "s"(sbase), "s"(lds_dst) : "memory"); }
__device__ __forceinline__ unsigned cvtpk(float lo, float hi) { f32x2_t v = {lo, hi}; bf16x2_t b = __builtin_convertvector(v, bf16x2_t); return __builtin_bit_cast(unsigned, b); }
__device__ __forceinline__ void qkt(f32x16& p0, f32x16& p1, const LAS char* Kslot, const bf16x8* qr, const f32x16& negm, int r32, int hi) {
    const LAS char* kb = Kslot + hi * 1024 + r32 * 16;
#pragma unroll
    for (int d0 = 0; d0 < 4; ++d0) {
        const bf16x8 b0 = *(const LAS bf16x8*)(kb + d0 * 2048);
        const bf16x8 b1 = *(const LAS bf16x8*)(kb + d0 * 2048 + 512);
        if (d0 == 0) { p0 = __builtin_amdgcn_mfma_f32_32x32x16_bf16(b0, qr[0], negm, 0, 0, 0); p1 = __builtin_amdgcn_mfma_f32_32x32x16_bf16(b1, qr[0], negm, 0, 0, 0); }
        else { p0 = __builtin_amdgcn_mfma_f32_32x32x16_bf16(b0, qr[d0], p0, 0, 0, 0); p1 = __builtin_amdgcn_mfma_f32_32x32x16_bf16(b1, qr[d0], p1, 0, 0, 0); }
    }
}
__device__ __forceinline__ void qkt0(f32x16& p0, f32x16& p1, const LAS char* Kslot, const bf16x8* qr, int r32, int hi) {
    const LAS char* kb = Kslot + hi * 1024 + r32 * 16; const f32x16 z = f32x16{};
#pragma unroll
    for (int d0 = 0; d0 < 4; ++d0) {
        const bf16x8 b0 = *(const LAS bf16x8*)(kb + d0 * 2048);
        const bf16x8 b1 = *(const LAS bf16x8*)(kb + d0 * 2048 + 512);
        if (d0 == 0) { p0 = __builtin_amdgcn_mfma_f32_32x32x16_bf16(b0, qr[0], z, 0, 0, 0); p1 = __builtin_amdgcn_mfma_f32_32x32x16_bf16(b1, qr[0], z, 0, 0, 0); }
        else { p0 = __builtin_amdgcn_mfma_f32_32x32x16_bf16(b0, qr[d0], p0, 0, 0, 0); p1 = __builtin_amdgcn_mfma_f32_32x32x16_bf16(b1, qr[d0], p1, 0, 0, 0); }
    }
}
__device__ __forceinline__ void pv(f32x16* o, int vb, bf16x8 pa0, bf16x8 pa1, bf16x8 pa2, bf16x8 pa3) {
#pragma unroll
    for (int d0 = 0; d0 < 2; ++d0) { s16x4 lo[4], hi[4];
#pragma unroll
        for (int ks = 0; ks < 4; ++ks) {
            asm volatile("ds_read_b64_tr_b16 %0,%1 offset:%c2" : "=&v"(lo[ks]) : "v"(vb), "i"(d0 * 4096 + ks * 1024) : "memory");
            asm volatile("ds_read_b64_tr_b16 %0,%1 offset:%c2" : "=&v"(hi[ks]) : "v"(vb), "i"(d0 * 4096 + ks * 1024 + 512) : "memory"); }
        asm volatile("s_waitcnt lgkmcnt(0)" ::: "memory"); __builtin_amdgcn_sched_barrier(0);
#define ATT_PK(k) (bf16x8){lo[k][0], lo[k][1], lo[k][2], lo[k][3], hi[k][0], hi[k][1], hi[k][2], hi[k][3]}
        o[d0] = __builtin_amdgcn_mfma_f32_32x32x16_bf16(pa0, ATT_PK(0), o[d0], 0, 0, 0);
        o[d0] = __builtin_amdgcn_mfma_f32_32x32x16_bf16(pa1, ATT_PK(1), o[d0], 0, 0, 0);
        o[d0] = __builtin_amdgcn_mfma_f32_32x32x16_bf16(pa2, ATT_PK(2), o[d0], 0, 0, 0);
        o[d0] = __builtin_amdgcn_mfma_f32_32x32x16_bf16(pa3, ATT_PK(3), o[d0], 0, 0, 0);
#undef ATT_PK
    }
}
#define ATT_SHFL(v, src) __builtin_bit_cast(float, __builtin_amdgcn_ds_bpermute((src) << 2, __builtin_bit_cast(int, (float)(v))))
#define ATT_BAR() asm volatile("s_waitcnt lgkmcnt(0)\n\ts_barrier" ::: "memory")
#define ATT_WAIT_BAR(N) asm volatile("s_waitcnt vmcnt(" #N ") lgkmcnt(0)\n\ts_barrier" ::: "memory")

template <int MODE, int SKEL = 0>
__device__ __forceinline__ void attn_unit(const bf16* Q, const bf16* K, const bf16* V, int b, int head, int d, int res, int n0, int kt0, int jlo, int jhi,
                                          const float* fc  , float slope2, const float* km  , int qb,
                                          bf16* O, int opitch, int ocol, float* lse_out  , LAS unsigned char* lds, int wid) {
    if (MODE != 2) { d = 1; res = 0; kt0 = 0; jlo = 0; }
    unsigned z_ = 0u; asm volatile("" : "+v"(z_));
    const int lane = __builtin_amdgcn_mbcnt_hi(~0u, __builtin_amdgcn_mbcnt_lo(~0u, z_)), r32 = lane & 31, hi = lane >> 5; const int tid_o = wid * 64 + lane;
    const int L = SEQ / d;
    const size_t tokbase = (size_t)b * SEQ;
    const unsigned lds0 = (unsigned)(size_t)lds;
    LAS float* BT = (LAS float*)(lds + A_BT);
    LAS float* wsf = (LAS float*)(lds + A_WSF) + wid * 64;
#define ATT_UNI64(p) ((const bf16*)(((unsigned long long)(unsigned)__builtin_amdgcn_readfirstlane((int)((unsigned long long)(p) >> 32)) << 32) | (unsigned long long)(unsigned)__builtin_amdgcn_readfirstlane((int)(unsigned)(unsigned long long)(p))))
    const bf16* Kh = ATT_UNI64(K + ((size_t)b * 24 + head) * SEQ * 64); const bf16* Vh = ATT_UNI64(V + ((size_t)b * 24 + head) * SEQ * 64);
#undef ATT_UNI64
    const unsigned kdst = lds0 + A_K + wid * 1024, vdst = lds0 + A_V + wid * 1024;
#define ATT_DMA_K(j, slot) glds16s(Kh, (unsigned)(lane * 128 + wid * 16) + (unsigned)(kt0 + 64 * (j)) * 128u, (unsigned)__builtin_amdgcn_readfirstlane(kdst + (slot) * SLOT))
#define ATT_DMA_V(j, slot) do { int lq_ = lane; asm volatile("" : "+v"(lq_));     \
        glds16s(Vh, (unsigned)(((16 * (wid & 3) + (lq_ >> 2)) * 64 + (wid >> 2) * 32 + (lq_ & 3) * 8) * 2) + (unsigned)(kt0 + 64 * (j)) * 128u, (unsigned)__builtin_amdgcn_readfirstlane(vdst + (slot) * SLOT)); } while (0)
    ATT_DMA_K(jlo, 0); if (jlo + 1 < jhi) ATT_DMA_K(jlo + 1, 1); ATT_DMA_V(jlo, 0);
    const int nq = n0 + wid * 32 + r32;
    const bool wactive = (n0 + wid * 32) < L;
    bf16x8 qr[4];
    { const bf16* qp = Q + (tokbase + (size_t)(wactive ? nq : n0) * d + res) * QW + head * 64 + hi * 8;
#pragma unroll
      for (int d0 = 0; d0 < 4; ++d0) qr[d0] = *(const bf16x8*)(qp + d0 * 16); }
    f32x4 fca = {0.f, 0.f, 0.f, 0.f}; float kmv = 0.f;
    { const int kmax_ = (n0 + 256 < L) ? n0 + 256 : L;
      if (MODE == 0) { if (4 * tid_o < kmax_) fca = *(const f32x4*)(fc + 4 * tid_o); }
      if (MODE == 1) kmv = km[tid_o]; }
    { const int kmax = (n0 + 256 < L) ? n0 + 256 : L;
      if (MODE == 0) {
          LAS float* wtot = (LAS float*)(lds + A_WSF);
          f32x4 a = fca;
          a.y += a.x; a.z += a.y; a.w += a.z;
          float incl = a.w;
#pragma unroll
          for (int o_ = 1; o_ < 64; o_ <<= 1) { const float t_ = ATT_SHFL(incl, (lane - o_) & 63); if (lane >= o_) incl += t_; }
          if (lane == 63) wtot[wid] = incl;
          ATT_BAR();
          float base = incl - a.w;
          for (int w_ = 0; w_ < wid; ++w_) base += wtot[w_];
          if (4 * tid_o < kmax) *(LAS f32x4*)(BT + 4 * tid_o) = (f32x4){-(a.x + base), -(a.y + base), -(a.z + base), -(a.w + base)};
      } else { for (int k = tid_o; k < kmax; k += NTHR) BT[k] = slope2 * (float)(k * d); } }
    unsigned allowed = 0xffu;
    if (MODE == 1) {
        LAS float* kml = (LAS float*)(lds + A_WSF);
        kml[tid_o] = kmv;
        ATT_BAR();
        float gt[8];
#pragma unroll
        for (int j = 0; j < 8; ++j) { float s = 0.f;
#pragma unroll
            for (int d0 = 0; d0 < 4; ++d0) { const f32x4 k0 = *(const LAS f32x4*)(kml + j * 64 + d0 * 16 + hi * 8), k1 = *(const LAS f32x4*)(kml + j * 64 + d0 * 16 + hi * 8 + 4);
                const u32x4 qw = __builtin_bit_cast(u32x4, qr[d0]);
                s += bflo(qw.x) * k0.x + bfhi(qw.x) * k0.y + bflo(qw.y) * k0.z + bfhi(qw.y) * k0.w + bflo(qw.z) * k1.x + bfhi(qw.z) * k1.y + bflo(qw.w) * k1.z + bfhi(qw.w) * k1.w; }
            s += ATT_SHFL(s, lane ^ 32); gt[j] = s; }
        allowed = 1u << qb;
#pragma unroll
        for (int j = 0; j < 8; ++j) { int rank = 0;
#pragma unroll
            for (int i = 0; i < 8; ++i) if (i < qb && i != j && (gt[i] > gt[j] || (gt[i] == gt[j] && i < j))) ++rank;
            if (j < qb && rank < 3) allowed |= 1u << j; }
    }
    { ATT_BAR();
      const int kmax = (n0 + 256 < L) ? n0 + 256 : L;
      for (int k = tid_o; k < kmax; k += NTHR) { const float bv = BT[k]; const unsigned h16 = f2bf(bv); const unsigned l16 = f2bf(bv - __builtin_bit_cast(float, h16 << 16));
          unsigned one2_ = 0x3F803F80u, z1_ = 0u; asm volatile("" : "+v"(one2_), "+v"(z1_)); *(LAS u32x4*)(lds + A_KB + k * 16) = (u32x4){h16 | (l16 << 16), one2_, z1_, z1_}; }
      if (tid_o == 0) { unsigned z0_ = 0u; asm volatile("" : "+v"(z0_)); *(LAS u32x4*)(lds + A_Z) = (u32x4){z0_, z0_, z0_, z0_}; } }
#define ATT_QX() do { const bool inf_ = !(msub < 3.0e38f); const unsigned mh_ = f2bf(inf_ ? 0.f : msub), ml_ = f2bf(inf_ ? 0.f : msub - __builtin_bit_cast(float, mh_ << 16)); \
        const unsigned w1_ = inf_ ? 0x0000FF80u : (((mh_ ^ 0x8000u) & 0xFFFFu) | ((ml_ ^ 0x8000u) << 16));     \
        unsigned zq_ = 0u; asm volatile("" : "+v"(zq_)); const u32x4 qv_ = {(hi == 0) ? 0x3F803F80u : zq_, (hi == 0) ? w1_ : zq_, zq_, zq_}; qx = __builtin_bit_cast(bf16x8, qv_); } while (0)
    float msub = 0.f, l_reg = 0.f; f32x16 o[2]; o[0] = f32x16{}; o[1] = f32x16{};
    const LAS char* vp0 = (const LAS char*)(lds + A_V) + ((lane >> 4) & 1) * 32 + (lane & 3) * 8 + (4 * hi + ((lane & 15) >> 2)) * 64;
    const int nmin = n0 + wid * 32, nmax = nmin + 31;
    int ja = jlo, jb = jhi - 1;
    { const int jd = (nmax - kt0) >> 6; if (jd < jb) jb = jd;
      if (MODE == 2) { const int jf = (nmin - 128 - kt0) >> 6; if (jf > ja) ja = jf; }
      if (!wactive) { ja = jhi; jb = jlo - 1; } }
#define ATT_BIAS(C0, C1, KB) do { \
        _Pragma("unroll") for (int i_ = 0; i_ < 4; ++i_) { const f32x4 b0_ = *(const LAS f32x4*)(BT + (KB) + 4 * hi + 8 * i_), b1_ = *(const LAS f32x4*)(BT + (KB) + 32 + 4 * hi + 8 * i_); \
            _Pragma("unroll") for (int e_ = 0; e_ < 4; ++e_) { C0[4 * i_ + e_] += b0_[e_] - msub; C1[4 * i_ + e_] += b1_[e_] - msub; } } } while (0)
#define ATT_MASK(C0, C1, KB) do { \
        _Pragma("unroll") for (int r_ = 0; r_ < 16; ++r_) { const int kv_ = (KB) + crow(r_, hi); if (kv_ > nq) C0[r_] = -INFINITY; if (kv_ + 32 > nq) C1[r_] = -INFINITY; } \
        if (MODE == 2) { _Pragma("unroll") for (int r_ = 0; r_ < 16; ++r_) { const int kv_ = (KB) + crow(r_, hi); if (nq - kv_ > 128) C0[r_] = -INFINITY; if (nq - kv_ - 32 > 128) C1[r_] = -INFINITY; } } } while (0)
#define ATT_ROWMAX(RM, C0, C1) do { float a_ = fmaxf(fmaxf(C0[0], C0[1]), C1[0]), b_ = fmaxf(fmaxf(C0[2], C0[3]), C1[1]); a_ = fmaxf(fmaxf(a_, C1[2]), C1[3]); \
        _Pragma("unroll") for (int r_ = 4; r_ < 16; r_ += 4) { a_ = fmaxf(fmaxf(a_, C0[r_]), C0[r_ + 1]); b_ = fmaxf(fmaxf(b_, C0[r_ + 2]), C0[r_ + 3]); a_ = fmaxf(fmaxf(a_, C1[r_]), C1[r_ + 1]); b_ = fmaxf(fmaxf(b_, C1[r_ + 2]), C1[r_ + 3]); } \
        RM = fmaxf(a_, b_); { auto rr_ = __builtin_amdgcn_permlane32_swap(__float_as_uint(RM), __float_as_uint(RM), false, false); RM = fmaxf(__uint_as_float(rr_[0]), __uint_as_float(rr_[1])); } } while (0)
#define ATT_RESC(RM, C0, C1) do { if (__any((RM) > THRL)) { const float dl_ = fmaxf((RM), 0.f); msub += dl_; \
        _Pragma("unroll") for (int r_ = 0; r_ < 16; ++r_) { C0[r_] -= dl_; C1[r_] -= dl_; } \
        const float f_ = __builtin_amdgcn_exp2f(-dl_); l_reg *= f_; if (hi == 0) wsf[r32] = f_; \
        asm volatile("s_waitcnt lgkmcnt(0)" ::: "memory"); \
        _Pragma("unroll") for (int r_ = 0; r_ < 16; ++r_) { const float fr_ = wsf[crow(r_, hi)]; o[0][r_] *= fr_; o[1][r_] *= fr_; } } } while (0)
#define ATT_VTR(p) __builtin_bit_cast(s16x4, __builtin_amdgcn_ds_read_tr16_b64_v4i16((LAS v4i16_t*)(p)))
    typedef short v4i16_t __attribute__((ext_vector_type(4)));
    f32x16 c0 = f32x16{}, c1 = f32x16{};
    bool blk_ok = true;
#define ATT_EXP_PACK() \
            float sacc = 0.f; \
            _Pragma("unroll") for (int r = 0; r < 16; ++r) { c0[r] = __builtin_amdgcn_exp2f(c0[r]); c1[r] = __builtin_amdgcn_exp2f(c1[r]); sacc += c0[r] + c1[r]; } \
            l_reg += sacc; \
            const u32x4 pw0 = {cvtpk(c0[0], c0[1]), cvtpk(c0[2], c0[3]), cvtpk(c0[4], c0[5]), cvtpk(c0[6], c0[7])}; \
            const u32x4 pw1 = {cvtpk(c0[8], c0[9]), cvtpk(c0[10], c0[11]), cvtpk(c0[12], c0[13]), cvtpk(c0[14], c0[15])}; \
            const u32x4 pw2 = {cvtpk(c1[0], c1[1]), cvtpk(c1[2], c1[3]), cvtpk(c1[4], c1[5]), cvtpk(c1[6], c1[7])}; \
            const u32x4 pw3 = {cvtpk(c1[8], c1[9]), cvtpk(c1[10], c1[11]), cvtpk(c1[12], c1[13]), cvtpk(c1[14], c1[15])};
#define ATT_KFP(KN_, g) (*(const LAS bf16x8*)((KN_) + hi * 1024 + r32 * 16 + ((g) >> 1) * 2048 + ((g) & 1) * 512))
#define ATT_CEP(A0, A1, idx) (((idx) < 16) ? A0[(idx) & 15] : A1[(idx) & 15])
#define ATT_FUSED_P(MASKED, C0, C1, N0, N1, KN_, VP_, KBN_) do { \
            u32x4 pw[4]; \
            bf16x8 kf[8]; kf[0] = ATT_KFP(KN_, 0); kf[1] = ATT_KFP(KN_, 1); \
            _Pragma("unroll") for (int g = 0; g < 8; ++g) { \
                if (g + 2 < 8) kf[g + 2] = ATT_KFP(KN_, g + 2); \
                float e0_ = ATT_CEP(C0, C1, 4 * g), e1_ = ATT_CEP(C0, C1, 4 * g + 1), e2_ = ATT_CEP(C0, C1, 4 * g + 2), e3_ = ATT_CEP(C0, C1, 4 * g + 3); \
                if (SKEL != 2) { e0_ = __builtin_amdgcn_exp2f(e0_); e1_ = __builtin_amdgcn_exp2f(e1_); e2_ = __builtin_amdgcn_exp2f(e2_); e3_ = __builtin_amdgcn_exp2f(e3_); }     \
                if (SKEL == 4) { if (g == 0) N0 = C0; if (g == 1) N1 = C1; } else \
                if (g == 0) N0 = __builtin_amdgcn_mfma_f32_32x32x16_bf16(kf[g], qr[0], f32x16{}, 0, 0, 0); else if (g == 1) N1 = __builtin_amdgcn_mfma_f32_32x32x16_bf16(kf[g], qr[0], f32x16{}, 0, 0, 0); \
                else if (g & 1) N1 = __builtin_amdgcn_mfma_f32_32x32x16_bf16(kf[g], qr[g >> 1], N1, 0, 0, 0); else N0 = __builtin_amdgcn_mfma_f32_32x32x16_bf16(kf[g], qr[g >> 1], N0, 0, 0, 0); \
                asm volatile("" : "+v"(e0_), "+v"(e1_), "+v"(e2_), "+v"(e3_));     \
                l_reg += (e0_ + e1_) + (e2_ + e3_);     \
                pw[g >> 1][2 * (g & 1)] = cvtpk(e0_, e1_); pw[g >> 1][2 * (g & 1) + 1] = cvtpk(e2_, e3_); \
                asm volatile("" : "+v"(l_reg)); \
                __builtin_amdgcn_sched_barrier(0); } \
            { bf16x8 qx; ATT_QX(); const LAS char* kx_ = hi ? (const LAS char*)(lds + A_Z) : (const LAS char*)(lds + A_KB) + ((KBN_) + r32) * 16; const bf16x8 kx0_ = *(const LAS bf16x8*)kx_, kx1_ = *(const LAS bf16x8*)(kx_ + (hi ? 0 : 512)); \
              N0 = __builtin_amdgcn_mfma_f32_32x32x16_bf16(kx0_, qx, N0, 0, 0, 0); N1 = __builtin_amdgcn_mfma_f32_32x32x16_bf16(kx1_, qx, N1, 0, 0, 0); }     \
            s16x4 vl[8], vh[8]; vl[0] = ATT_VTR(VP_); vh[0] = ATT_VTR(VP_ + 512); vl[1] = ATT_VTR(VP_ + 4096); vh[1] = ATT_VTR(VP_ + 4096 + 512); \
            _Pragma("unroll") for (int g = 0; g < 8; ++g) { \
                if (g + 2 < 8) { vl[g + 2] = ATT_VTR(VP_ + ((g + 2) & 1) * 4096 + ((g + 2) >> 1) * 1024); vh[g + 2] = ATT_VTR(VP_ + ((g + 2) & 1) * 4096 + ((g + 2) >> 1) * 1024 + 512); } \
                if (SKEL != 3) o[g & 1] = __builtin_amdgcn_mfma_f32_32x32x16_bf16(__builtin_bit_cast(bf16x8, pw[g >> 1]), (bf16x8){vl[g][0], vl[g][1], vl[g][2], vl[g][3], vh[g][0], vh[g][1], vh[g][2], vh[g][3]}, o[g & 1], 0, 0, 0);     \
                if (MASKED) _Pragma("unroll") for (int e = 0; e < 4; ++e) { const int ix = 4 * g + e; float x = (ix < 16) ? N0[ix & 15] : N1[ix & 15]; \
                    { const int kv_ = KBN_ + ((g >= 4) ? 32 : 0) + crow(ix & 15, hi); if (kv_ > nq) x = -INFINITY; if (MODE == 2) { if (nq - kv_ > 128) x = -INFINITY; } } \
                    if (ix < 16) N0[ix & 15] = x; else N1[ix & 15] = x; \
                    } \
                if (MASKED) { if (g < 3) asm volatile("" : "+v"(o[g & 1]), "+v"(N0[(4 * g + 4) & 15]), "+v"(N0[(4 * g + 5) & 15]), "+v"(N0[(4 * g + 6) & 15]), "+v"(N0[(4 * g + 7) & 15])); \
                              else if (g < 7) asm volatile("" : "+v"(o[g & 1]), "+v"(N1[(4 * g + 4) & 15]), "+v"(N1[(4 * g + 5) & 15]), "+v"(N1[(4 * g + 6) & 15]), "+v"(N1[(4 * g + 7) & 15])); }     \
                __builtin_amdgcn_sched_barrier(0); } \
            float rm = -1.0f; asm volatile("" : "+v"(rm));     \
            ATT_RESC(rm, N0, N1); \
            } while (0)
    bool ref_set = false;
    f32x16 d0_ = f32x16{}, d1_ = f32x16{};
#define ATT_SYNC(j) do { const int fly_ = ((j) >= jlo) ? (((j) + 2 < jhi) ? 1 : 0) + (((j) + 1 < jhi) ? 1 : 0) : ((jlo + 1 < jhi) ? 2 : 1); \
        if (fly_ == 2) { ATT_WAIT_BAR(2); } else if (fly_ == 1) { ATT_WAIT_BAR(1); } else { ATT_WAIT_BAR(0); } \
        if ((j) + 3 < jhi) ATT_DMA_K((j) + 3, ((j) + 3 - jlo) & 3); \
        if ((j) + 2 < jhi) ATT_DMA_V((j) + 2, ((j) + 2 - jlo) % 3); \
        if (!ref_set) { ref_set = true; if (wactive) msub = BT[nq]; } \
        if (MODE == 1) { const int kb_ = kt0 + 64 * ((j) + 1); if (((j) + 1 >= ja) && ((j) + 1 <= jb) && (kb_ & 255) == 0) { blk_ok = (allowed >> (kb_ >> 8)) & 1u; msub = blk_ok ? BT[nq] : INFINITY; } } } while (0)
#define ATT_KN(j) ((const LAS char*)(lds + A_K + (((j) + 1 - jlo) & 3) * SLOT))
#define ATT_VP(j) (vp0 + (((j) - jlo + 3) % 3) * SLOT)
#define ATT_MASKED(j) (((kt0 + 64 * ((j) + 1) + 63) > nmin) || (MODE == 2 && (kt0 + 64 * ((j) + 1)) < nmax - 128))
#define ATT_DOA(j) (((j) + 1 >= ja) && ((j) + 1 <= jb))
#define ATT_DOP(j) (((j) >= ja) && ((j) <= jb))
    asm volatile("" : "+v"(qr[0]), "+v"(qr[1]), "+v"(qr[2]), "+v"(qr[3]));
    int j = jlo - 1;
#pragma nounroll
    while (j < jhi) {
        ATT_SYNC(j);
        const bool doA = ATT_DOA(j), doP = ATT_DOP(j), masked = ATT_MASKED(j);
        const int kbn = kt0 + 64 * (j + 1);
        const LAS char* Kn = ATT_KN(j);
        const LAS char* vp = ATT_VP(j);
        if (SKEL == 1) { ++j; }
        else if (doP && doA && !masked && (j + 1 < jhi) && ATT_DOA(j + 1) && !ATT_MASKED(j + 1)) {
            ATT_FUSED_P(false, c0, c1, d0_, d1_, Kn, vp, kbn);
            ATT_SYNC(j + 1);
            ATT_FUSED_P(false, d0_, d1_, c0, c1, ATT_KN(j + 1), ATT_VP(j + 1), (kbn + 64));
            j += 2;
        } else {
            if (doP && doA) { if (masked) { ATT_FUSED_P(true, c0, c1, d0_, d1_, Kn, vp, kbn); } else { ATT_FUSED_P(false, c0, c1, d0_, d1_, Kn, vp, kbn); } c0 = d0_; c1 = d1_; }
            else if (doA) {
                f32x16 n0_, n1_; qkt0(n0_, n1_, Kn, qr, r32, hi);
                ATT_BIAS(n0_, n1_, kbn); if (masked) ATT_MASK(n0_, n1_, kbn);
                c0 = n0_; c1 = n1_;
            } else if (doP) {
                ATT_EXP_PACK()
                pv(o, (int)(lds0 + A_V) + ((lane >> 4) & 1) * 32 + (lane & 3) * 8 + (4 * hi + ((lane & 15) >> 2)) * 64 + ((j - jlo + 3) % 3) * SLOT,
                   __builtin_bit_cast(bf16x8, pw0), __builtin_bit_cast(bf16x8, pw1), __builtin_bit_cast(bf16x8, pw2), __builtin_bit_cast(bf16x8, pw3));
            }
            ++j;
        }
    }
#undef ATT_SYNC
#undef ATT_QX
#undef ATT_KN
#undef ATT_VP
#undef ATT_MASKED
#undef ATT_DOA
#undef ATT_DOP
#undef ATT_FUSED_P
#undef ATT_KFP
#undef ATT_CEP
#undef ATT_EXP_PACK
#undef ATT_BIAS
#undef ATT_MASK
    ATT_BAR();
#undef ATT_ROWMAX
#undef ATT_RESC
#undef ATT_VTR
    if (wactive && SKEL == 0) {
        unsigned z2_ = 0u; asm volatile("" : "+v"(z2_));
        const int lane2 = __builtin_amdgcn_mbcnt_hi(~0u, __builtin_amdgcn_mbcnt_lo(~0u, z2_)), r2 = lane2 & 31, h2 = lane2 >> 5;
        l_reg += ATT_SHFL(l_reg, lane2 ^ 32);
        LAS float* wsf2 = (LAS float*)(lds + A_WSF) + wid * 64;
        int b2_ = b; asm volatile("" : "+s"(b2_)); const size_t tb2_ = (size_t)b2_ * SEQ;
        if (h2 == 0) wsf2[32 + r2] = l_reg;
        if (MODE == 2) { if (h2 == 0) lse_out[(tokbase + (size_t)nq * d + res) * 4] = __builtin_amdgcn_logf(l_reg); }
        asm volatile("s_waitcnt lgkmcnt(0)" ::: "memory");
        LAS unsigned short* stl = (LAS unsigned short*)(lds + A_OST) + wid * 2048;
#pragma unroll
        for (int r = 0; r < 16; ++r) { const int orow = crow(r, h2); const float rl = __builtin_amdgcn_rcpf(wsf2[32 + orow]);
#pragma unroll
            for (int d0 = 0; d0 < 2; ++d0) stl[orow * 64 + d0 * 32 + r2] = (unsigned short)f2bf(o[d0][r] * rl); }
        asm volatile("s_waitcnt lgkmcnt(0)" ::: "memory");
#pragma unroll
        for (int i = 0; i < 4; ++i) { const int row = i * 8 + (lane2 >> 3), ch = lane2 & 7; const u32x4 v = *(const LAS u32x4*)(stl + row * 64 + ch * 8);
            *(u32x4*)(O + (tb2_ + (size_t)(n0 + wid * 32 + row) * d + res) * opitch + ocol + ch * 8) = v; }
    }
#undef ATT_DMA_K
#undef ATT_DMA_V
}

__device__ __forceinline__ void dil_merge_tokens(bf16* O, const bf16* OG1, const bf16* OG2, const float* lse, int tid, int m_lo) {
#pragma unroll
    for (int trip = 0; trip < 2; ++trip) {
        v4u a[2], bq[2], c[2]; float l0[2], l1[2], l2[2];
#pragma unroll
        for (int q = 0; q < 2; ++q) { const int it = tid + NTHR * (2 * trip + q); const int m = m_lo + (it >> 5), ch = it & 31, slot = ch >> 3;
            l0[q] = lse[(size_t)m * 4 + slot]; l1[q] = lse[(size_t)(M + m) * 4 + slot]; l2[q] = lse[(size_t)(2 * M + m) * 4 + slot];
            a[q] = *(const v4u*)(O + (size_t)m * DM + 768 + ch * 8); bq[q] = *(const v4u*)(OG1 + (size_t)m * DILW + ch * 8); c[q] = *(const v4u*)(OG2 + (size_t)m * DILW + ch * 8); }
#pragma unroll
        for (int q = 0; q < 2; ++q) { const int it = tid + NTHR * (2 * trip + q); const int m = m_lo + (it >> 5), ch = it & 31;
            const float mx = fmaxf(l0[q], fmaxf(l1[q], l2[q])); float w0 = exp2f(l0[q] - mx), w1 = exp2f(l1[q] - mx), w2 = exp2f(l2[q] - mx); const float inv = 1.0f / (w0 + w1 + w2); w0 *= inv; w1 *= inv; w2 *= inv;
            v4u o;
            o.x = pk2(w0 * bflo(a[q].x) + w1 * bflo(bq[q].x) + w2 * bflo(c[q].x), w0 * bfhi(a[q].x) + w1 * bfhi(bq[q].x) + w2 * bfhi(c[q].x));
            o.y = pk2(w0 * bflo(a[q].y) + w1 * bflo(bq[q].y) + w2 * bflo(c[q].y), w0 * bfhi(a[q].y) + w1 * bfhi(bq[q].y) + w2 * bfhi(c[q].y));
            o.z = pk2(w0 * bflo(a[q].z) + w1 * bflo(bq[q].z) + w2 * bflo(c[q].z), w0 * bfhi(a[q].z) + w1 * bfhi(bq[q].z) + w2 * bfhi(c[q].z));
            o.w = pk2(w0 * bflo(a[q].w) + w1 * bflo(bq[q].w) + w2 * bflo(c[q].w), w0 * bfhi(a[q].w) + w1 * bfhi(bq[q].w) + w2 * bfhi(c[q].w));
            *(v4u*)(O + (size_t)m * DM + 768 + ch * 8) = o; }
    }
}
__device__ __forceinline__ void wdil_unit(GAS unsigned char* ws, LAS unsigned char* lds, int wid, int w) {
    unsigned z_ = 0u; asm volatile("" : "+v"(z_));
    const int lane = __builtin_amdgcn_mbcnt_hi(~0u, __builtin_amdgcn_mbcnt_lo(~0u, z_)), r32 = lane & 31, hi = lane >> 5;
    const int g = w >> 11, v = w & 2047;
    int b, slot, res, rb, d, head, si, opitch, ocol; bf16* O; float* lse_out;
    if (g == 0) { b = v >> 8; slot = (v >> 6) & 3; res = 0; rb = v & 63; d = 1; head = 12 + slot; si = slot; O = (bf16*)(ws + WS_O); opitch = DM; ocol = 768 + slot * 64; lse_out = (float*)(ws + WS_LSE) + slot; }
    else if (g == 1) { b = v >> 8; slot = (v >> 6) & 3; res = (v >> 4) & 3; rb = v & 15; d = 4; head = 16 + slot; si = 4 + slot; O = (bf16*)(ws + WS_OG1); opitch = DILW; ocol = slot * 64; lse_out = (float*)(ws + WS_LSE) + (size_t)M * 4 + slot; }
    else { b = v >> 8; slot = (v >> 6) & 3; res = (v >> 2) & 15; rb = v & 3; d = 16; head = 20 + slot; si = 14 + slot; O = (bf16*)(ws + WS_OG2); opitch = DILW; ocol = slot * 64; lse_out = (float*)(ws + WS_LSE) + (size_t)2 * M * 4 + slot; }
    const float slope2 = alibi_slope(si) * LOG2E * (float)d;
    const size_t tokbase = (size_t)b * SEQ;
    const bf16* Q = (const bf16*)(ws + WS_Q);
    const char* Kb = (const char*)((const bf16*)(ws + WS_K) + (((size_t)b * 24 + head) * SEQ + (size_t)res * (SEQ / d)) * 64);
    const char* Vb = (const char*)((const bf16*)(ws + WS_V) + (((size_t)b * 24 + head) * SEQ + (size_t)res * (SEQ / d)) * 64);
    const unsigned rstride = 64 * 2;
    const int nq = 32 * rb + r32;
    const int k0 = (32 * rb - 128 > 0) ? 32 * rb - 128 : 0, nt = (32 * rb + 32 - k0 + 63) >> 6;
    LAS unsigned char* mine = lds + wid * 16384;
    const unsigned vdst = (unsigned)(size_t)mine;
    bf16x8 qr[4];
    { const bf16* qp = Q + (tokbase + (size_t)nq * d + res) * QW + head * 64 + hi * 8;
#pragma unroll
      for (int d0 = 0; d0 < 4; ++d0) qr[d0] = *(const bf16x8*)(qp + d0 * 16); }
    const unsigned koff0 = (unsigned)(k0 + r32) * rstride + hi * 16;
    const unsigned voff0 = (unsigned)(k0 + (lane >> 2)) * rstride + (lane & 3) * 16;
#define WD_H2(kb) ((kb) + 32 <= 32 * rb + 31)
#define WD_LDK(t_, h2_) do { const unsigned ko_ = koff0 + (unsigned)(t_) * 64u * rstride; \
        _Pragma("unroll") for (int g_ = 0; g_ < 8; g_ += 2) kf[g_] = *(const bf16x8*)(Kb + (size_t)(ko_ + (g_ >> 1) * 32)); \
        if (h2_) { const unsigned k2_ = ko_ + 32u * rstride; _Pragma("unroll") for (int g_ = 1; g_ < 8; g_ += 2) kf[g_] = *(const bf16x8*)(Kb + (size_t)(k2_ + (g_ >> 1) * 32)); } } while (0)
#define WD_DMAV(t_, sl, h2_) do { const unsigned vo_ = voff0 + (unsigned)(t_) * 64u * rstride; \
        _Pragma("unroll") for (int p_ = 0; p_ < 8; ++p_) if ((p_ & 2) == 0 || (h2_)) \
            glds16s(Vb, vo_ + (unsigned)(16 * (p_ & 3)) * rstride + (p_ >> 2) * 64, (unsigned)__builtin_amdgcn_readfirstlane(vdst + (sl) * 8192 + p_ * 1024)); } while (0)
    bf16x8 kf[8];
#pragma unroll
    for (int g_ = 0; g_ < 8; ++g_) kf[g_] = qr[0];
    { const bool h2 = WD_H2(k0); WD_DMAV(0, 0, h2); WD_LDK(0, h2); }
    float l_reg = 0.f; f32x16 o[2]; o[0] = f32x16{}; o[1] = f32x16{};
    const int vlane = ((lane >> 4) & 1) * 32 + (lane & 3) * 8 + (4 * hi + ((lane & 15) >> 2)) * 64;
    const float s32 = slope2 * 32.0f;
#pragma nounroll
    for (int t = 0; t < nt; ++t) {
        const int kb = k0 + 64 * t; const bool h2 = WD_H2(kb);
        f32x16 c0, c1 = f32x16{};
        c0 = __builtin_amdgcn_mfma_f32_32x32x16_bf16(kf[0], qr[0], f32x16{}, 0, 0, 0);
#pragma unroll
        for (int d0 = 1; d0 < 4; ++d0) c0 = __builtin_amdgcn_mfma_f32_32x32x16_bf16(kf[2 * d0], qr[d0], c0, 0, 0, 0);
        if (h2) {
#pragma unroll
            for (int d0 = 0; d0 < 4; ++d0) c1 = __builtin_amdgcn_mfma_f32_32x32x16_bf16(kf[2 * d0 + 1], qr[d0], c1, 0, 0, 0); }
        if (t + 1 < nt) { asm volatile("" : "+v"(c0), "+v"(c1)); const bool n2 = WD_H2(kb + 64); WD_DMAV(t + 1, (t + 1) & 1, n2); WD_LDK(t + 1, n2); }
        const int dk = kb - nq + 4 * hi; const float fdk = slope2 * (float)dk;
        const bool mcaus = (kb + (h2 ? 63 : 31)) > 32 * rb, mwin = kb < 32 * rb + 31 - 128;
        if (mcaus || mwin) {
#pragma unroll
            for (int r = 0; r < 16; ++r) { const int cr = (r & 3) + 8 * (r >> 2); const float tb = fdk + slope2 * (float)cr;
                float x0 = c0[r] + tb, x1 = c1[r] + (tb + s32);
                const int q0 = dk + cr, q1 = q0 + 32;
                if (q0 > 0 || q0 < -128) x0 = -INFINITY; if (q1 > 0 || q1 < -128) x1 = -INFINITY;
                c0[r] = x0; c1[r] = x1; }
        } else {
#pragma unroll
            for (int r = 0; r < 16; ++r) { const int cr = (r & 3) + 8 * (r >> 2); const float tb = fdk + slope2 * (float)cr; c0[r] += tb; c1[r] += tb + s32; }
        }
        const int vb = (int)vdst + (t & 1) * 8192 + vlane;
        if (h2) {
            float sacc = 0.f;
#pragma unroll
            for (int r = 0; r < 16; ++r) { c0[r] = __builtin_amdgcn_exp2f(c0[r]); c1[r] = __builtin_amdgcn_exp2f(c1[r]); sacc += c0[r] + c1[r]; }
            l_reg += sacc;
            const u32x4 pw0 = {cvtpk(c0[0], c0[1]), cvtpk(c0[2], c0[3]), cvtpk(c0[4], c0[5]), cvtpk(c0[6], c0[7])};
            const u32x4 pw1 = {cvtpk(c0[8], c0[9]), cvtpk(c0[10], c0[11]), cvtpk(c0[12], c0[13]), cvtpk(c0[14], c0[15])};
            const u32x4 pw2 = {cvtpk(c1[0], c1[1]), cvtpk(c1[2], c1[3]), cvtpk(c1[4], c1[5]), cvtpk(c1[6], c1[7])};
            const u32x4 pw3 = {cvtpk(c1[8], c1[9]), cvtpk(c1[10], c1[11]), cvtpk(c1[12], c1[13]), cvtpk(c1[14], c1[15])};
            pv(o, vb, __builtin_bit_cast(bf16x8, pw0), __builtin_bit_cast(bf16x8, pw1), __builtin_bit_cast(bf16x8, pw2), __builtin_bit_cast(bf16x8, pw3));
        } else {
            float sacc = 0.f;
#pragma unroll
            for (int r = 0; r < 16; ++r) { c0[r] = __builtin_amdgcn_exp2f(c0[r]); sacc += c0[r]; }
            l_reg += sacc;
            const u32x4 pw0 = {cvtpk(c0[0], c0[1]), cvtpk(c0[2], c0[3]), cvtpk(c0[4], c0[5]), cvtpk(c0[6], c0[7])};
            const u32x4 pw1 = {cvtpk(c0[8], c0[9]), cvtpk(c0[10], c0[11]), cvtpk(c0[12], c0[13]), cvtpk(c0[14], c0[15])};
#pragma unroll
            for (int d0 = 0; d0 < 2; ++d0) { s16x4 lo[2], hh[2];
#pragma unroll
                for (int ks = 0; ks < 2; ++ks) {
                    asm volatile("ds_read_b64_tr_b16 %0,%1 offset:%c2" : "=&v"(lo[ks]) : "v"(vb), "i"(d0 * 4096 + ks * 1024) : "memory");
                    asm volatile("ds_read_b64_tr_b16 %0,%1 offset:%c2" : "=&v"(hh[ks]) : "v"(vb), "i"(d0 * 4096 + ks * 1024 + 512) : "memory"); }
                asm volatile("s_waitcnt lgkmcnt(0)" ::: "memory"); __builtin_amdgcn_sched_barrier(0);
                o[d0] = __builtin_amdgcn_mfma_f32_32x32x16_bf16(__builtin_bit_cast(bf16x8, pw0), (bf16x8){lo[0][0], lo[0][1], lo[0][2], lo[0][3], hh[0][0], hh[0][1], hh[0][2], hh[0][3]}, o[d0], 0, 0, 0);
                o[d0] = __builtin_amdgcn_mfma_f32_32x32x16_bf16(__builtin_bit_cast(bf16x8, pw1), (bf16x8){lo[1][0], lo[1][1], lo[1][2], lo[1][3], hh[1][0], hh[1][1], hh[1][2], hh[1][3]}, o[d0], 0, 0, 0);
            }
        }
    }
#undef WD_H2
#undef WD_LDK
#undef WD_DMAV
    asm volatile("s_waitcnt vmcnt(0) lgkmcnt(0)" ::: "memory");
    l_reg += ATT_SHFL(l_reg, lane ^ 32);
    LAS float* wsf2 = (LAS float*)(mine + 8192);
    if (hi == 0) { wsf2[r32] = l_reg; const float lg_ = __builtin_amdgcn_logf(l_reg); asm volatile("global_store_dword %0, %1, off sc1" :: "v"(lse_out + (tokbase + (size_t)nq * d + res) * 4), "v"(lg_) : "memory"); }
    asm volatile("s_waitcnt lgkmcnt(0)" ::: "memory");
    LAS unsigned short* stl = (LAS unsigned short*)mine;
#pragma unroll
    for (int r = 0; r < 16; ++r) { const int orow = crow(r, hi); const float rl = __builtin_amdgcn_rcpf(wsf2[orow]);
#pragma unroll
        for (int d0 = 0; d0 < 2; ++d0) stl[orow * 64 + d0 * 32 + r32] = (unsigned short)f2bf(o[d0][r] * rl); }
    asm volatile("s_waitcnt lgkmcnt(0)" ::: "memory");
#pragma unroll
    for (int i = 0; i < 4; ++i) { const int row = i * 8 + (lane >> 3), ch = lane & 7; const u32x4 vv = *(const LAS u32x4*)(stl + row * 64 + ch * 8);
        asm volatile("global_store_dwordx4 %0, %1, off sc1\n\ts_nop 1" :: "v"(O + (tokbase + (size_t)(32 * rb + row) * d + res) * opitch + ocol + ch * 8), "v"(vv) : "memory"); }
    asm volatile("s_waitcnt lgkmcnt(0)" ::: "memory");
}

template <int SKEL = 0>
__device__ __forceinline__ void attn_phase(GAS unsigned char* ws0, int l, volatile LAS unsigned*  , LAS unsigned char* lds0, int tid, int ulo = 0, int uhi = 768, int qoff = 0) {
    const int wv0 = __builtin_amdgcn_readfirstlane(tid >> 6);
    if (SKEL == 0 && (qoff == 0 || !MERGE_IN_QUEUE)) {
        for (int rp_ = 0; rp_ < 1 + ((qoff == 0) ? PROBE_WDIL2 : 0); ++rp_)
        for (int w = blockIdx.x * NWAVES + wv0; w < 3 * 2048; w += gridDim.x * NWAVES) {
            GAS unsigned char* ws = ws0; asm volatile("" : "+s"(ws));
            LAS unsigned char* lds = lds0; asm volatile("" : "+s"(lds));
            int wv = wv0; asm volatile("" : "+s"(wv));
            wdil_unit(ws, lds, wv, w);
        }
        asm volatile("s_waitcnt vmcnt(0)" ::: "memory");
        if (MERGE_IN_QUEUE && qoff == 0 && lane_opq() == 0) (void)xb_add((unsigned*)(ws0 + WS_CTL) + CW_Q + 64 * l + 32, 1u);
        __syncthreads();
    }
    const int c_lo = (l == 0) ? CONV_FIRST : CONV_SPLIT, c_hi = (l == 0) ? CONV_SPLIT : CONV_NITEMS;
    const int NC = (qoff == 0 || PROBE_CONVQ) ? (c_hi - c_lo + CONV_UNIT - 1) / CONV_UNIT : 0;
    const int NA = uhi - ulo, NP = (NA < NC) ? NA : NC;
    const int NM = (MERGE_IN_QUEUE && qoff == 0) ? M / 64 : 0;
    const int NU = NA + NC + NM;
    for (;;) {
        GAS unsigned char* ws = ws0; asm volatile("" : "+s"(ws));
        LAS unsigned char* lds = lds0; asm volatile("" : "+s"(lds));
        int wv = wv0; asm volatile("" : "+s"(wv));
        volatile LAS unsigned* misc = (volatile LAS unsigned*)(lds + MISC_OFF);
        { GAS unsigned* qctr = (GAS unsigned*)(ws + WS_CTL) + CW_Q + 64 * l + qoff;
          const bool t1 = (wv == 0) && (lane_opq() == 0);
          if (t1) misc[0] = __hip_atomic_fetch_add(qctr, 1u, __ATOMIC_RELAXED, __HIP_MEMORY_SCOPE_AGENT); }
        __syncthreads();
        const int uq = __builtin_amdgcn_readfirstlane((int)misc[0]);
        __syncthreads();
        if (uq >= NU) break;
        if (uq >= NA + NC) {
            if (misc[2] != (unsigned)(l + 1)) {
                if (wv == 0 && lane_opq() == 0) { unsigned* dctr = (unsigned*)(ws + WS_CTL) + CW_Q + 64 * l + 32; unsigned sp_ = 0u;
                    while (xb_ld(dctr) < gridDim.x * NWAVES) { __builtin_amdgcn_s_sleep(2); if (++sp_ > (1u << 24)) break; }
                    __builtin_amdgcn_fence(__ATOMIC_ACQUIRE, "agent"); asm volatile("s_waitcnt vmcnt(0)" ::: "memory"); }
                __syncthreads();
                if (wv == 0 && lane_opq() == 0) misc[2] = (unsigned)(l + 1);
                __syncthreads();
            }
            dil_merge_tokens((bf16*)(ws + WS_O), (const bf16*)(ws + WS_OG1), (const bf16*)(ws + WS_OG2), (const float*)(ws + WS_LSE), wv * 64 + lane_opq(), 64 * (uq - NA - NC));
            continue;
        }
        const bool isc = (uq < 2 * NP) ? ((uq & 1) != 0) : (NC > NA);
        if (isc) {
            const int cu = (uq < 2 * NP) ? (uq >> 1) : uq - NA;
            const int base = c_lo + CONV_UNIT * cu, end = (base + CONV_UNIT < c_hi) ? base + CONV_UNIT : c_hi;
            conv_run4(ws, lds, lane_opq(), wv, base + wv, NWAVES, end);
            VM_WAIT();
            continue;
        }
        const int ua = (uq < 2 * NP) ? (uq >> 1) : uq - NC;
        const bf16* Q = (const bf16*)(ws + WS_Q); const bf16* K = (const bf16*)(ws + WS_K); const bf16* V = (const bf16*)(ws + WS_V);
        bf16* O = (bf16*)(ws + WS_O);
        const float* fcum = (const float*)(ws + WS_FLOG); const float* kmean = (const float*)(ws + WS_KM) + (size_t)l * 8 * 6 * 8 * 64;
        const int u = ua + ulo;
        const int qb = 7 - u / 96, r = u % 96, type = r / 48, bh = r % 48, b = bh / 6, h = bh % 6;
        if (type == 0) attn_unit<0, SKEL>(Q, K, V, b, h, 1, 0, 256 * qb, 0, 0, 4 * (qb + 1), fcum + (size_t)bh * SEQ, 0.f, nullptr, qb, O, DM, h * 64, nullptr, lds, wv);
        else attn_unit<1, SKEL>(Q, K, V, b, 6 + h, 1, 0, 256 * qb, 0, 0, 4 * (qb + 1), nullptr, alibi_slope(8 + h) * LOG2E, kmean + (size_t)bh * 512, qb, O, DM, 384 + h * 64, nullptr, lds, wv);
    }
}
__device__ __forceinline__ void phase_dil_merge(bf16* O, const bf16* OG1, const bf16* OG2, const float* lse, int tid) {
    const int stride = gridDim.x * NTHR;
    for (int it0 = blockIdx.x * NTHR + tid; it0 < M * 32; it0 += 2 * stride) {
        v4u a[2], bq[2], c[2]; float l0[2], l1[2], l2[2];
#pragma unroll
        for (int q = 0; q < 2; ++q) { const int it = it0 + q * stride; if (it < M * 32) { const int m = it >> 5, ch = it & 31, slot = ch >> 3;
            l0[q] = lse[(size_t)m * 4 + slot]; l1[q] = lse[(size_t)(M + m) * 4 + slot]; l2[q] = lse[(size_t)(2 * M + m) * 4 + slot];
            a[q] = *(const v4u*)(O + (size_t)m * DM + 768 + ch * 8); bq[q] = *(const v4u*)(OG1 + (size_t)m * DILW + ch * 8); c[q] = *(const v4u*)(OG2 + (size_t)m * DILW + ch * 8); } }
#pragma unroll
        for (int q = 0; q < 2; ++q) { const int it = it0 + q * stride; if (it < M * 32) { const int m = it >> 5, ch = it & 31;
            const float mx = fmaxf(l0[q], fmaxf(l1[q], l2[q])); float w0 = exp2f(l0[q] - mx), w1 = exp2f(l1[q] - mx), w2 = exp2f(l2[q] - mx); const float inv = 1.0f / (w0 + w1 + w2); w0 *= inv; w1 *= inv; w2 *= inv;
            v4u o;
            o.x = pk2(w0 * bflo(a[q].x) + w1 * bflo(bq[q].x) + w2 * bflo(c[q].x), w0 * bfhi(a[q].x) + w1 * bfhi(bq[q].x) + w2 * bfhi(c[q].x));
            o.y = pk2(w0 * bflo(a[q].y) + w1 * bflo(bq[q].y) + w2 * bflo(c[q].y), w0 * bfhi(a[q].y) + w1 * bfhi(bq[q].y) + w2 * bfhi(c[q].y));
            o.z = pk2(w0 * bflo(a[q].z) + w1 * bflo(bq[q].z) + w2 * bflo(c[q].z), w0 * bfhi(a[q].z) + w1 * bfhi(bq[q].z) + w2 * bfhi(c[q].z));
            o.w = pk2(w0 * bflo(a[q].w) + w1 * bflo(bq[q].w) + w2 * bflo(c[q].w), w0 * bfhi(a[q].w) + w1 * bfhi(bq[q].w) + w2 * bfhi(c[q].w));
            *(v4u*)(O + (size_t)m * DM + 768 + ch * 8) = o; } }
    }
}
#undef ATT_BAR
#undef ATT_WAIT_BAR
#undef ATT_SHFL
}

#ifndef ONE_LAUNCH
#define ONE_LAUNCH 1
#endif
#ifndef REP_PHASE
#define REP_PHASE -1
#endif
#ifndef REP_N
#define REP_N 2
#endif
#define REPN(pid) ((REP_PHASE == (pid)) ? REP_N : 1)
#ifndef PROBE_ATTN2
#define PROBE_ATTN2 0
#endif
#ifndef PROBE_BAR2
#define PROBE_BAR2 0
#endif
#ifndef PROBE_DUP
#define PROBE_DUP 0
#endif
#ifndef PROBE_CONV2
#define PROBE_CONV2 0
#endif
#ifndef PROBE_ATTN2_L
#define PROBE_ATTN2_L 0
#endif
#ifndef PROBE_SKEL
#define PROBE_SKEL 0
#endif
#ifndef PROBE_ULO
#define PROBE_ULO 0
#define PROBE_UHI 768
#endif
#ifndef NAIVE_ATTN
#define NAIVE_ATTN 0
#endif
static_assert(WS_K - WS_Q == (size_t)M * QW * 2 && WS_V - WS_K == (size_t)M * QW * 2, "q|k|v stride");
constexpr int NPL = 12, NPH = 1 + 2 * NPL + 1;
#if NAIVE_ATTN
__global__ void __launch_bounds__(NTHR, 2) k_attn_naive(KArgs a) {
    unsigned char* ws = a.ws; const int tid = threadIdx.x, wave = tid >> 6;
    phase_attn_naive((const bf16*)(ws + WS_Q), (const bf16*)(ws + WS_K), (const bf16*)(ws + WS_V), (const float*)(ws + WS_FCUM), (const float*)(ws + WS_KMEAN), (bf16*)(ws + WS_O), tid, wave);
}
#endif
__device__ __forceinline__ bool opq(GAS unsigned char*& w, GAS unsigned char* w0, int& tid, int& lane, int& wave, int wave_k) { w = w0; asm volatile("" : "+s"(w)); unsigned z = 0u; asm volatile("" : "+v"(z)); asm volatile("" : "+s"(wave_k)); lane = (int)__builtin_amdgcn_mbcnt_hi(~0u, __builtin_amdgcn_mbcnt_lo(~0u, z)); wave = wave_k; tid = wave_k * 64 + lane; return true; }
#define PH(k) (lo <= (k) && (k) < hi && opq(ws, ws0, tid, lane, wave, wave_k))
#define SEAM(k) do { if (PH(k) && PH((k) + 1)) { XcdBarrier b_ = bar; asm volatile("" : "+s"(b_.bar)); xcd_barrier(b_, wave_k); if (PROBE_BAR2) { XcdBarrier c_ = bar; asm volatile("" : "+s"(c_.bar)); xcd_barrier(c_, wave_k); } } } while (0)
#define mods ((float*)(ws + WS_MODS))
#define flog ((float*)(ws + WS_FLOG))
#define fcum ((float*)(ws + WS_FCUM))
#define kmean ((float*)(ws + WS_KM) + (size_t)l * 8 * 6 * 8 * 64)
#define sel ((int*)(ws + WS_SEL))
#define wt ((float*)(ws + WS_WT))
#define rcnt ((int*)(ws + WS_CNT))
#define tok ((int*)(ws + WS_TOK))
#define wrow ((float*)(ws + WS_WROW))
#define tile_e ((int*)(ws + WS_TILEE))
#define Hb ((bf16*)(ws + WS_H))
#define Qb ((bf16*)(ws + WS_Q))
#define Kb ((bf16*)(ws + WS_K))
#define Vb ((bf16*)(ws + WS_V))
#define Gb ((bf16*)(ws + WS_G))
#define Ob ((bf16*)(ws + WS_O))
#define YB ((bf16*)(ws + WS_YB))
template <int L> __device__ __forceinline__ void layer_body(GAS unsigned char* const ws0, const int lo, const int hi, const XcdBarrier bar, LAS unsigned char* lds, const int wave_k) {
    constexpr int l = L; GAS unsigned char* ws = ws0; int tid = 0, lane = 0, wave = wave_k;
    const int G = (int)gridDim.x, bx = (int)blockIdx.x;
        const int p0 = 1 + NPL * l;
#define XBp ((bf16*)(ws + WS_XB))
#define mods_l (mods + (size_t)l * NB * 6144)
#define win_l (AIN(6) + (size_t)l * DM * IN_COLS)
#define wint_l ((const bf16*)(ws + WS_WIN) + (size_t)l * NIN * DM)
        if constexpr (l == 0) { if (PH(p0 + 0)) { for (int rc_ = 0; rc_ < 1 + PROBE_CONV2; ++rc_) phase_convert(ws, lds, tid, lane, wave); __syncthreads(); } }
        if (PH(p0 + 0)) for (int rep_ = 0; rep_ < REPN(p0 + 0); ++rep_) phase_norm<0, (l != 0)>((l == 0) ? (const void*)AIN(0) : (const void*)XBp, AIN(4) + l * DM, mods_l, 0, 1024, Hb, (unsigned char*)(ws + WS_H8), win_l, AIN(7) + 6 * l, flog, nullptr, nullptr, nullptr, nullptr, nullptr, nullptr, nullptr, nullptr, lds, tid, lane, wave);
        SEAM(p0 + 0);
        if (PH(p0 + 1)) for (int rep_ = 0; rep_ < REPN(p0 + 1); ++rep_) {
#if V_FP8
            { pg8::Gemm g{Hb, wint_l, M, 2 * QW, DM}; pg8::StaticOrder S; S.init(M, 2 * QW, G, bx);
              pg8::EpiInProj E{Qb, Gb, (const float*)(ws + WS_GAINS) + l * 2 * QW, kmean};
              pg8::gemm_phase<pg8::EpiInProj, pg8::StaticOrder, true, true>(lds, g, S, E, wave); }
            { pg8::Gemm g{(const bf16*)(ws + WS_H8), (const bf16*)(ws + WS_WIN + (size_t)l * 15 * MiB + WS_WG8_OFF), M, 3072 + QW, DM / 2};
              pg8::StaticOrder S; S.init(M, 3072 + QW, G, bx); pg8::EpiGates8 E{Gb, Vb};
              pg8::gemm_phase<pg8::EpiGates8, pg8::StaticOrder, true, true, true>(lds, g, S, E, wave); }
#else
            { pg8::Gemm g{Hb, wint_l, M, 3 * QW, DM}; pg8::StaticOrder S; S.init(M, 3 * QW, G, bx);
              pg8::EpiInProj E{Qb, Gb, (const float*)(ws + WS_GAINS) + l * 2 * QW, kmean};
              pg8::gemm_phase<pg8::EpiInProj, pg8::StaticOrder, true, true>(lds, g, S, E, wave); }
            { pg8::Gemm g{(const bf16*)(ws + WS_H8), (const bf16*)(ws + WS_WIN + (size_t)l * 15 * MiB + WS_WG8_OFF), M, 3072, DM / 2};
              pg8::GateOrder S{G, bx}; pg8::EpiGates8 E{Gb, Vb};
              pg8::gemm_phase<pg8::EpiGates8, pg8::GateOrder, true, true, true>(lds, g, S, E, wave); }
#endif
        }
        SEAM(p0 + 1);
#if PROBE_ATTN2
        if (l == PROBE_ATTN2_L && PH(p0 + 3)) att::attn_phase<PROBE_SKEL>(ws, l, (volatile LAS unsigned*)(lds + MISC_OFF), lds, tid, PROBE_ULO, PROBE_UHI, 16);
#endif
        if (PH(p0 + 3)) att::attn_phase(ws, l, (volatile LAS unsigned*)(lds + MISC_OFF), lds, tid);
        SEAM(p0 + 3);
        if (!MERGE_IN_QUEUE) { if (PH(p0 + 4)) att::phase_dil_merge(Ob, (const bf16*)(ws + WS_OG1), (const bf16*)(ws + WS_OG2), (const float*)(ws + WS_LSE), tid);
                               SEAM(p0 + 4); }
        if (PH(p0 + 5)) for (int rep_ = 0; rep_ < REPN(p0 + 5); ++rep_) {
            pg8::Gemm g{Ob, (const bf16*)(ws + WS_WBR) + (size_t)l * DM * DM, M, DM, DM}; pg8::StaticOrder S; S.init(M, DM, G, bx);
            pg8::EpiBranch E{YB, Gb}; pg8::gemm_phase<pg8::EpiBranch, pg8::StaticOrder, false, true>(lds, g, S, E, wave);
        }
        SEAM(p0 + 5);
        if (PH(p0 + 6)) for (int rep_ = 0; rep_ < REPN(p0 + 6); ++rep_) {
            pg8::Gemm g{YB, (const bf16*)(ws + WS_WOUT) + (size_t)l * DM * DM, M, DM, DM}; pg8::StaticOrder S; S.init(M, DM, G, bx);
            if constexpr (l == 0) { pg8::EpiResid<false> E{(const void*)AIN(0), XBp, mods_l + 2048, 1.f}; pg8::gemm_phase<pg8::EpiResid<false>, pg8::StaticOrder, false, true>(lds, g, S, E, wave); }
            else { pg8::EpiResid<true> E{(const void*)XBp, XBp, mods_l + 2048, (rep_ == 0) ? 1.f : 0.f}; pg8::gemm_phase<pg8::EpiResid<true>, pg8::StaticOrder, false, true>(lds, g, S, E, wave); }
        }
        SEAM(p0 + 6);
        if constexpr (l == 0) {
            if (PH(p0 + 7)) for (int rep_ = 0; rep_ < REPN(p0 + 7); ++rep_) phase_norm<1, true>((const void*)XBp, AIN(5) + l * DM, mods_l, 3072, 4096, Hb, nullptr, nullptr, nullptr, nullptr, nullptr, nullptr, nullptr, nullptr, nullptr, nullptr, nullptr, nullptr, lds, tid, lane, wave);
            SEAM(p0 + 7);
            if (PH(p0 + 10)) for (int rep_ = 0; rep_ < REPN(p0 + 10); ++rep_) {
                pg8::Gemm g{Hb, (const bf16*)(ws + WS_WF1), M, 2 * DFF, DM}; pg8::StaticOrder S; S.init(M, 2 * DFF, G, bx);
#if DENSE2_FP8
                pg8::EpiSwiglu8 E{(unsigned char*)(ws + WS_ACT), 22, 1.0f, F8_AS}; pg8::gemm_phase<pg8::EpiSwiglu8, pg8::StaticOrder, true, true>(lds, g, S, E, wave);
#else
                pg8::EpiSwiglu E{(bf16*)(ws + WS_ACT), 22, (PROBE_FP8 == 2) ? 8.f : 0.f}; pg8::gemm_phase<pg8::EpiSwiglu, pg8::StaticOrder, true, true>(lds, g, S, E, wave);
#endif
            }
            SEAM(p0 + 10);
            if (PH(p0 + 11)) for (int rep_ = 0; rep_ < REPN(p0 + 11); ++rep_) {
#if DENSE2_FP8
                pg8::Gemm g{(const bf16*)(ws + WS_ACT), (const bf16*)(ws + WS_WF2), M, DM, DFF / 2}; pg8::StaticOrder S; S.init(M, DM, G, bx);
                pg8::EpiResid<true> E{(const void*)XBp, XBp, mods_l + 5120, (rep_ == 0) ? 1.0f / (F8_WS * F8_AS) : 0.f}; pg8::gemm_phase<pg8::EpiResid<true>, pg8::StaticOrder, false, true, true>(lds, g, S, E, wave);
#else
                pg8::Gemm g{(const bf16*)(ws + WS_ACT), (const bf16*)(ws + WS_WF2), M, DM, DFF}; pg8::StaticOrder S; S.init(M, DM, G, bx);
                pg8::EpiResid<true> E{(const void*)XBp, XBp, mods_l + 5120, (rep_ == 0) ? 1.f : 0.f}; pg8::gemm_phase<pg8::EpiResid<true>, pg8::StaticOrder, false, true>(lds, g, S, E, wave);
#endif
            }
            SEAM(p0 + 11);
        } else {
            if (PH(p0 + 7)) for (int rep_ = 0; rep_ < REPN(p0 + 7); ++rep_) phase_norm<2, true>((const void*)XBp, AIN(5) + l * DM, mods_l, 3072, 4096, nullptr, nullptr, nullptr, nullptr, nullptr, AIN(17), AIN(18), sel, wt, rcnt, nullptr, nullptr, nullptr, lds, tid, lane, wave);
            SEAM(p0 + 7);
            if (PH(p0 + 9)) for (int rep_ = 0; rep_ < REPN(p0 + 9); ++rep_) phase_norm<3, true>((const void*)XBp, AIN(5) + l * DM, mods_l, 3072, 4096, (bf16*)(ws + WS_HP), nullptr, nullptr, nullptr, nullptr, nullptr, nullptr, sel, wt, rcnt, tok, wrow, tile_e, lds, tid, lane, wave);
            SEAM(p0 + 9);
            if (PH(p0 + 10)) for (int rep_ = 0; rep_ < REPN(p0 + 10); ++rep_) {
                const int nt = __builtin_amdgcn_readfirstlane(tile_e[255]);
                pg8::MoeOrder S; S.so.init(nt * 256, 2 * DFF, G, bx); S.tmap = tile_e; S.npn = 22;
#if MOE_FP8
                pg8::Gemm g{(const bf16*)(ws + WS_HP), (const bf16*)(ws + WS_WE1), nt * 256, 2 * DFF, DM / 2};
                pg8::EpiSwiglu8 E{(unsigned char*)(ws + WS_ACTE), 22, 1.0f / F8_WS, F8_AS / F8_WS}; pg8::gemm_phase<pg8::EpiSwiglu8, pg8::MoeOrder, true, true, true>(lds, g, S, E, wave);
#if PROBE_DUP == 3
                pg8::gemm_phase<pg8::EpiSwiglu8, pg8::MoeOrder, true, true, true>(lds, g, S, E, wave);
#endif
#else
                pg8::Gemm g{(const bf16*)(ws + WS_HP), (const bf16*)(ws + WS_WE1), nt * 256, 2 * DFF, DM};
                pg8::EpiSwiglu E{(bf16*)(ws + WS_ACTE), 22, 8.f}; pg8::gemm_phase<pg8::EpiSwiglu, pg8::MoeOrder, true, true>(lds, g, S, E, wave);
#endif
            }
            SEAM(p0 + 10);
            if (PH(p0 + 11)) for (int rep_ = 0; rep_ < REPN(p0 + 11); ++rep_) {
                const int nt = __builtin_amdgcn_readfirstlane(tile_e[255]);
                pg8::MoeOrder S; S.so.init(nt * 256, DM, G, bx); S.tmap = tile_e; S.npn = 4;
#if MOE_FP8
                pg8::Gemm g{(const bf16*)(ws + WS_ACTE), (const bf16*)(ws + WS_WE2), nt * 256, DM, DFF / 2};
                pg8::EpiMoeY E{(bf16*)(ws + WS_YE), mods_l + 5120, tok, wrow, 1.0f / (F8_WS * F8_AS)}; pg8::gemm_phase<pg8::EpiMoeY, pg8::MoeOrder, true, true, true>(lds, g, S, E, wave);
#if PROBE_DUP == 4
                pg8::gemm_phase<pg8::EpiMoeY, pg8::MoeOrder, true, true, true>(lds, g, S, E, wave);
#endif
#else
                pg8::Gemm g{(const bf16*)(ws + WS_ACTE), (const bf16*)(ws + WS_WE2), nt * 256, DM, DFF};
                pg8::EpiMoeY E{(bf16*)(ws + WS_YE), mods_l + 5120, tok, wrow, 1.0f}; pg8::gemm_phase<pg8::EpiMoeY, pg8::MoeOrder, false, true>(lds, g, S, E, wave);
#endif
            }
            SEAM(p0 + 11);
            if (PH(p0 + 12)) phase_moe_combine(AOUT, XBp, (const bf16*)(ws + WS_YE), tid);
        }
}
__global__ void __launch_bounds__(NTHR, 2) mk_fwd(KArgs a) {
    extern __shared__ __attribute__((aligned(16))) unsigned char lds_raw[];
    LAS unsigned char* lds = (LAS unsigned char*)lds_raw;
    const int wave_k = __builtin_amdgcn_readfirstlane((int)threadIdx.x >> 6);
    int lane = lane_opq(), tid = wave_k * 64 + lane, wave = wave_k;
    volatile LAS unsigned* MISC = (volatile LAS unsigned*)(lds + MISC_OFF);
    for (int u = tid; u < (LDS_BYTES - RING_BYTES) / 4; u += NTHR) ((LAS unsigned*)(lds + RING_BYTES))[u] = 0u;
    __syncthreads();
    GAS unsigned char* const ws0 = (GAS unsigned char*)a.ws;
    GAS unsigned char* ws = ws0;
    unsigned* ctl = (unsigned*)(ws + WS_CTL);
    const int lo = a.ph_lo, hi = a.ph_hi;
    XcdBarrier bar; bar.bar = ctl + CW_BAR; bar.x = 0; bar.st = nullptr;
    if (hi - lo > 1) bar = xcd_barrier_post(ctl + CW_BAR, MISC + 8, tid == 0);
    const int G = (int)gridDim.x, bx = (int)blockIdx.x;

    if (PH(0)) { for (int rep_ = 0; rep_ < REPN(0); ++rep_) phase_mods(ws, lds, tid, lane, wave);
                 }
    SEAM(0);
    layer_body<0>(ws0, lo, hi, bar, lds, wave_k);
    layer_body<1>(ws0, lo, hi, bar, lds, wave_k);
#undef PH
#undef SEAM
}

extern "C" void kernel_launch(void* const* d_in, const int* in_sizes, int n_in, void* d_out, int out_size, void* d_ws, size_t ws_size, hipStream_t stream) {
    static int grid = 0;
    if (grid == 0) {
        if (n_in != 22 || out_size != M * DM || ws_size < WS_END) { fprintf(stderr, "kernel_launch: unexpected sizes n_in %d out %d ws %zu (need %zu)\n", n_in, out_size, ws_size, (size_t)WS_END); grid = -1; return; }
        int dev = 0, cus = 0, per_cu = 0;
        if (hipGetDevice(&dev) != hipSuccess || hipDeviceGetAttribute(&cus, hipDeviceAttributeMultiprocessorCount, dev) != hipSuccess) { grid = -1; return; }
        if (hipFuncSetAttribute((const void*)mk_fwd, hipFuncAttributeMaxDynamicSharedMemorySize, LDS_BYTES) != hipSuccess) { fprintf(stderr, "kernel_launch: hipFuncSetAttribute failed\n"); grid = -1; return; }
        if (hipOccupancyMaxActiveBlocksPerMultiprocessor(&per_cu, (const void*)mk_fwd, NTHR, LDS_BYTES) != hipSuccess || per_cu < 1) fprintf(stderr, "kernel_launch: occupancy query says %d\n", per_cu);
        (void)hipGetLastError();
        grid = cus;
    }
    if (grid < 0) return;
    (void)hipMemsetAsync((char*)d_ws + WS_CTL, 0, CTL_ZERO_BYTES, stream);
    KArgs a{};
    for (int i = 0; i < 22; ++i) a.in[i] = (const float*)d_in[i];
    a.out = (float*)d_out; a.ws = (unsigned char*)d_ws;
#if ONE_LAUNCH
    a.ph_lo = 0; a.ph_hi = NPH;
    hipLaunchKernelGGL(mk_fwd, dim3(grid), dim3(NTHR), LDS_BYTES, stream, a);
#else
    for (int p = 0; p < NPH; ++p) {
        if (p == 1 + 8 || p == 1 + 9) continue;
        if (NAIVE_ATTN && (p == 1 + 4 || p == 1 + NPL + 4)) continue;
        a.ph_lo = p; a.ph_hi = p + 1;
#if NAIVE_ATTN
        if (p == 1 + 3 || p == 1 + NPL + 3) { hipLaunchKernelGGL(k_attn_naive, dim3(grid), dim3(NTHR), 0, stream, a); continue; }
#endif
        hipLaunchKernelGGL(mk_fwd, dim3(grid), dim3(NTHR), LDS_BYTES, stream, a);
    }
#endif
}
```

```cpp
#include <hip/hip_runtime.h>
#include <cstdio>
#include <cstdint>

constexpr int NB = 8, SEQ = 2048, DM = 1024, M = NB * SEQ, NH = 24, HD = 64, QW = 1536;
constexpr int IN_COLS = 7686, NIN = 7680, DFF = 2816, NE = 8;
constexpr int FOXW = 384, MOBW = 384, DILW = 256;
constexpr float RMS_EPS = 1e-6f, LOG2E = 1.4426950408889634f, C2 = 0.125f * 1.4426950408889634f;
constexpr int PMAX = 2 * M + NE * 256;
constexpr int NWAVES = 8, NTHR = 512;

constexpr size_t MiB = 1u << 20, KiB = 1024;
constexpr size_t WS_CTL = 0, CTL_ZERO_BYTES = 1 * MiB;
constexpr size_t WS_MODS = 1 * MiB;
constexpr size_t WS_FLOG = WS_MODS + 384 * KiB;
constexpr size_t WS_FCUM = WS_FLOG + 384 * KiB;
constexpr size_t WS_KMEAN = WS_FCUM + 384 * KiB;
constexpr size_t WS_SEL = WS_KMEAN + 96 * KiB;
constexpr size_t WS_WT = WS_SEL + 128 * KiB;
constexpr size_t WS_CNT = WS_WT + 128 * KiB;
constexpr size_t WS_TOK = WS_CNT + 128 * KiB;
constexpr size_t WS_WROW = WS_TOK + 136 * KiB;
constexpr size_t WS_TILEE = WS_WROW + 136 * KiB;
constexpr size_t WS_GAINS = WS_TILEE + 1024;
static_assert(WS_GAINS + 2 * 2 * 1536 * 4 <= 5 * MiB, "small buffers");
constexpr size_t WS_WIN = 5 * MiB;
constexpr size_t WS_WBR = 35 * MiB;
constexpr size_t WS_WOUT = 39 * MiB;
constexpr size_t WS_WF1 = 43 * MiB;
constexpr size_t WS_WF2 = 54 * MiB;
constexpr size_t WS_WE1 = WS_WF2 + 5632 * KiB;
constexpr size_t WS_WE2 = WS_WE1 + 88 * MiB;
constexpr size_t WS_H = WS_WE2 + 44 * MiB;
constexpr size_t WS_O = WS_H;
constexpr size_t WS_Q = WS_H + 32 * MiB, WS_K = WS_Q + 48 * MiB, WS_V = WS_K + 48 * MiB;
constexpr size_t WS_G = WS_V + 48 * MiB;
constexpr size_t WS_OG1 = WS_G + 96 * MiB;
constexpr size_t WS_OG2 = WS_OG1 + 8 * MiB;
constexpr size_t WS_LSE = WS_OG2 + 8 * MiB;
constexpr size_t WS_END = WS_LSE + 768 * KiB;
constexpr size_t WS_XB = WS_WE1 + 44 * MiB;
constexpr size_t WS_H8 = WS_OG1;
constexpr size_t WS_WG8_OFF = 9 * MiB;
constexpr size_t WS_YB = WS_V;
constexpr size_t WS_ACT = WS_Q;
constexpr size_t WS_HP = WS_H;
constexpr size_t WS_YE = WS_H;
constexpr size_t WS_ACTE = WS_H + 68 * MiB;
static_assert(WS_ACTE + (size_t)PMAX * DFF * 2 <= WS_END, "moe act fits");
static_assert(WS_ACT + (size_t)M * DFF * 2 <= WS_V, "dense act fits under y");

constexpr size_t WS_KM = 256 * KiB;
constexpr int CW_BAR = 4096, CW_Q = 8192;
constexpr int RING_BYTES = 131072, MISC_OFF = RING_BYTES + 320, LDS_BYTES = 147456;

#define GAS __attribute__((address_space(1)))
#define LAS __attribute__((address_space(3)))
typedef unsigned short bf16;
typedef unsigned v4u __attribute__((ext_vector_type(4)));
typedef float f32x4 __attribute__((ext_vector_type(4)));
#define LDS_WAIT() asm volatile("s_waitcnt lgkmcnt(0)" ::: "memory")
#define VM_WAIT() asm volatile("s_waitcnt vmcnt(0)" ::: "memory")
__device__ __forceinline__ unsigned f2bf(float f) { unsigned u = __builtin_bit_cast(unsigned, f); return (u + 0x7fffu + ((u >> 16) & 1u)) >> 16; }
typedef float f32x2_t_ __attribute__((ext_vector_type(2))); typedef __bf16 bf16x2_t_ __attribute__((ext_vector_type(2)));
__device__ __forceinline__ unsigned pk2(float lo, float hi) { f32x2_t_ v = {lo, hi}; bf16x2_t_ b = __builtin_convertvector(v, bf16x2_t_); return __builtin_bit_cast(unsigned, b); }
typedef unsigned u32x2 __attribute__((ext_vector_type(2)));
__device__ __forceinline__ float ub8(unsigned w, int i) { return (float)((w >> (8 * i)) & 0xffu); }
__device__ __forceinline__ float bflo(unsigned w) { return __builtin_bit_cast(float, w << 16); }
__device__ __forceinline__ float bfhi(unsigned w) { return __builtin_bit_cast(float, w & 0xffff0000u); }
__device__ __forceinline__ int lane_opq() { unsigned z = 0u; asm volatile("" : "+v"(z)); return (int)__builtin_amdgcn_mbcnt_hi(~0u, __builtin_amdgcn_mbcnt_lo(~0u, z)); }
__device__ __forceinline__ float shfl_l(float v, int src_lane) { return __builtin_bit_cast(float, __builtin_amdgcn_ds_bpermute(src_lane << 2, __builtin_bit_cast(int, v))); }
__device__ __forceinline__ int shfl_li(int v, int src_lane) { return __builtin_amdgcn_ds_bpermute(src_lane << 2, v); }
__device__ __forceinline__ float wave_sum(float v) {
    const int l_ = lane_opq();
#pragma unroll
    for (int o = 1; o < 64; o <<= 1) v += shfl_l(v, l_ ^ o);
    return v;
}
__device__ __forceinline__ int kv_l2d(int head) { return head < 16 ? 0 : (head < 20 ? 2 : 4); }
__device__ __forceinline__ int kv_row(int t, int l2) { return ((t & ((1 << l2) - 1)) << (11 - l2)) + (t >> l2); }
__device__ __forceinline__ float alibi_slope(int i) { return exp2f(-8.0f * (float)(i + 1) / 18.0f); }

#ifndef MOE_FP8
#define MOE_FP8 1
#endif
static_assert(MOE_FP8 == 1, "WS_XB sits in the half of the expert up-projection slot that only the fp8 build leaves free");
constexpr float F8_WS = 32.f, F8_AS = 8.f;
__device__ __forceinline__ unsigned pk4_fp8(float a, float b, float c, float d) { int p = __builtin_amdgcn_cvt_pk_fp8_f32(a, b, 0, false); p = __builtin_amdgcn_cvt_pk_fp8_f32(c, d, p, true); return (unsigned)p; }
#ifndef V_FP8
#define V_FP8 1
#endif
#ifndef PROBE_CONVQ
#define PROBE_CONVQ 0
#endif
#ifndef PROBE_WDIL2
#define PROBE_WDIL2 0
#endif
#ifndef DENSE2_FP8
#define DENSE2_FP8 1
#endif
#ifndef MERGE_IN_QUEUE
#define MERGE_IN_QUEUE 1
#endif
#ifndef PROBE_FP8
#define PROBE_FP8 0
#endif
__device__ __forceinline__ float q8(float x, float s) { const int p = __builtin_amdgcn_cvt_pk_fp8_f32(x * s, x * s, 0, false); return __builtin_amdgcn_cvt_f32_fp8(p, 0) * (1.0f / s); }
namespace pg8 {
#define PG8_LAS __attribute__((address_space(3)))
typedef unsigned short bf16_t;
typedef short bf16x8 __attribute__((ext_vector_type(8)));
typedef float f32x4 __attribute__((ext_vector_type(4)));
typedef unsigned u32x4 __attribute__((ext_vector_type(4)));
constexpr int BM = 256, BK = 64, HALF = 128, HTB = HALF * BK * 2  , STAGE_BYTES = 8 * HTB, NXCD = 8, WGM = 8;

__host__ __device__ __forceinline__ int lds_byte(int r, int c) { const int st = (r >> 4) * 2 + (c >> 5), rr = r & 15, cc = c & 31, ob = rr * 64 + cc * 2; return st * 1024 + (ob ^ (((ob >> 9) & 1) << 5)); }
__host__ __device__ __forceinline__ void stage_rc(int b, int& R, int& C) { const int st = b / 1024, sb = b % 1024, swz = sb ^ (((sb >> 9) & 1) << 5); R = (st >> 1) * 16 + swz / 64; C = (st & 1) * 32 + (swz % 64) / 2; }
__host__ __device__ __forceinline__ int perm32(int rho) { const int n = rho >> 4, i = rho & 15; return 8 * (i >> 2) + 4 * n + (i & 3); }

struct Unit { int pm, pn; };
struct Gemm { const bf16_t* A; const bf16_t* Bt; int M, N, K; };

struct StaticOrder {
    int nM, nN, nwg, G, c;
    __host__ __device__ void init(int M, int N, int G_, int c_) { nM = M / BM; nN = N / BM; nwg = nM * nN; G = G_; c = c_; }
    __host__ __device__ bool next(int i, Unit& u) const {
        const long L = (long)i * G + c; if (L >= nwg) return false;
        int wgid = (int)L; { const int q = nwg / NXCD, r = nwg % NXCD, xcd = wgid % NXCD, off = wgid / NXCD; wgid = (xcd < r ? xcd * (q + 1) : r * (q + 1) + (xcd - r) * q) + off; }
        const int nig = WGM * nN, gid = wgid / nig, fm = gid * WGM, gsz = (nM - fm) < WGM ? (nM - fm) : WGM;
        u.pm = fm + ((wgid % nig) % gsz); u.pn = (wgid % nig) / gsz; return true;
    }
    __device__ __forceinline__ void a_ready(const Unit&) const {}
    __device__ __forceinline__ void done(const Unit&) const {}
};
template <class Epi, class Sched, bool ALIGN_EPI = false, bool SP2 = false, bool F8 = false>
__device__ __forceinline__ void gemm_phase(PG8_LAS unsigned char* lds, const Gemm g, const Sched& S, const Epi& E, int wave_k) {
    unsigned zt_ = 0u; asm volatile("" : "+v"(zt_)); asm volatile("" : "+s"(wave_k)); int tid_o = wave_k * 64 + (int)__builtin_amdgcn_mbcnt_hi(~0u, __builtin_amdgcn_mbcnt_lo(~0u, zt_));
    const int tid = tid_o, wid = __builtin_amdgcn_readfirstlane(tid >> 6), lane = tid & 63, wr = wid >> 2, wc = wid & 3, fr = lane & 15, fq = lane >> 4;
    const int K = g.K, nt = K / BK;
    unsigned voffA[2], voffB[2];
#pragma unroll
    for (int i = 0; i < 2; ++i) { int R, C; stage_rc(tid * 16 + i * 8192, R, C); const int Rb = Epi::PERM ? ((R & ~31) + perm32(R & 31)) : R;
        voffA[i] = (unsigned)(R * K + C) * 2u; voffB[i] = (unsigned)(Rb * K + C) * 2u; }
    const size_t kstep = (size_t)(BK * 2);
    const size_t hstep = (size_t)HALF * K * 2;
    const size_t tstep = 2 * hstep;
    const unsigned ldsw = (unsigned)wid * 1024u;
    const int aoff = lds_byte(wr * 64 + fr, fq * 8), boff = lds_byte(wc * 32 + fr, fq * 8);
#define PG8_SA(b, h) (((b) * 2 + (h)) * HTB)
#define PG8_SB(b, h) ((4 + (b) * 2 + (h)) * HTB)
#define PG8_STAGE(bufoff, gbase, voff) do { _Pragma("unroll") for (int _i = 0; _i < 2; ++_i) \
        __builtin_amdgcn_global_load_lds((const unsigned*)((const char*)(gbase) + (voff)[_i]), (PG8_LAS unsigned*)(lds + (bufoff) + ldsw + _i * 8192), 16, 0, 0); } while (0)
#define PG8_LDA(dst, b, h) do { _Pragma("unroll") for (int m = 0; m < 4; ++m) { dst[m].lo = *(const PG8_LAS bf16x8*)(lds + PG8_SA(b, h) + aoff + m * 2048); dst[m].hi = *(const PG8_LAS bf16x8*)(lds + PG8_SA(b, h) + aoff + m * 2048 + 1024); } } while (0)
#define PG8_LDB(dst, b, h) do { _Pragma("unroll") for (int n = 0; n < 2; ++n) { dst[n].lo = *(const PG8_LAS bf16x8*)(lds + PG8_SB(b, h) + boff + n * 2048); dst[n].hi = *(const PG8_LAS bf16x8*)(lds + PG8_SB(b, h) + boff + n * 2048 + 1024); } } while (0)
#define PG8_MMA(ai, bj, At, Bt) do { __builtin_amdgcn_s_setprio(1); _Pragma("unroll") for (int m = 0; m < 4; ++m) _Pragma("unroll") for (int n = 0; n < 2; ++n) { \
        if constexpr (F8) { typedef int i32x8 __attribute__((ext_vector_type(8))); \
            asm volatile("v_mfma_scale_f32_16x16x128_f8f6f4 %0, %1, %2, %0, %3, %3 op_sel_hi:[0,0,0]" : "+v"(acc[ai][bj][m][n]) : "v"(__builtin_bit_cast(i32x8, Bt[n])), "v"(__builtin_bit_cast(i32x8, At[m])), "v"(f8scale)); } \
        else { acc[ai][bj][m][n] = __builtin_amdgcn_mfma_f32_16x16x32_bf16(Bt[n].lo, At[m].lo, acc[ai][bj][m][n], 0, 0, 0); \
               acc[ai][bj][m][n] = __builtin_amdgcn_mfma_f32_16x16x32_bf16(Bt[n].hi, At[m].hi, acc[ai][bj][m][n], 0, 0, 0); } } \
        __builtin_amdgcn_s_setprio(0); } while (0)
#define PG8_WAIT_V(n) asm volatile("s_waitcnt vmcnt(" #n ")" ::: "memory")
#define PG8_WAIT_L(n) asm volatile("s_waitcnt lgkmcnt(" #n ")" ::: "memory")
#define PG8_BAR __builtin_amdgcn_s_barrier()
#define PG8_SCHED __builtin_amdgcn_sched_barrier(0)
    Unit cur, nxt; int ui = 0;
    if (!S.next(0, cur)) return;
    f32x4 acc[2][2][4][2];
#pragma unroll
    for (int a = 0; a < 2; ++a)
#pragma unroll
        for (int b = 0; b < 2; ++b)
#pragma unroll
            for (int m = 0; m < 4; ++m)
#pragma unroll
                for (int n = 0; n < 2; ++n) acc[a][b][m][n] = (f32x4){0.f, 0.f, 0.f, 0.f};
    const int f8scale = 0x7f7f7f7f;
    typedef short bf16x16 __attribute__((ext_vector_type(16)));
    bf16x16 At[4], B0[2], B1[2];
    const char* cA = (const char*)g.A + (size_t)cur.pm * tstep; const char* cB = (const char*)g.Bt + (size_t)cur.pn * tstep;
    S.a_ready(cur);
    if constexpr (SP2) {
        PG8_STAGE(PG8_SB(0, 0), cB, voffB); PG8_STAGE(PG8_SB(0, 1), cB + hstep, voffB); PG8_STAGE(PG8_SA(0, 0), cA, voffA); PG8_STAGE(PG8_SA(0, 1), cA + hstep, voffA);
        if (wr == 1) PG8_BAR;
        PG8_WAIT_V(2); PG8_BAR;
        PG8_STAGE(PG8_SB(1, 0), cB + kstep, voffB); PG8_STAGE(PG8_SA(1, 0), cA + kstep, voffA); PG8_STAGE(PG8_SB(1, 1), cB + hstep + kstep, voffB);
        PG8_WAIT_V(6); PG8_BAR;
    } else {
        PG8_STAGE(PG8_SB(0, 0), cB, voffB); PG8_STAGE(PG8_SA(0, 0), cA, voffA); PG8_STAGE(PG8_SB(0, 1), cB + hstep, voffB); PG8_STAGE(PG8_SA(0, 1), cA + hstep, voffA);
        if (wr == 1) PG8_BAR;
        PG8_WAIT_V(4); PG8_BAR;
        PG8_STAGE(PG8_SB(1, 0), cB + kstep, voffB); PG8_STAGE(PG8_SA(1, 0), cA + kstep, voffA); PG8_STAGE(PG8_SB(1, 1), cB + hstep + kstep, voffB);
        PG8_WAIT_V(6); PG8_BAR;
    }
    for (;;) {
        const bool has_next = S.next(ui + 1, nxt);
        const char* nA = has_next ? (const char*)g.A + (size_t)nxt.pm * tstep : cA; const char* nB = has_next ? (const char*)g.Bt + (size_t)nxt.pn * tstep : cB;
#pragma nounroll
        for (int t = 0; t < nt; t += 2) {
            const bool last = (t == nt - 2);
            const char* a1 = cA + (size_t)(t + 1) * kstep;
            const char* a2 = last ? nA : cA + (size_t)(t + 2) * kstep; const char* b2 = last ? nB : cB + (size_t)(t + 2) * kstep;
            const char* a3 = a2 + kstep; const char* b3 = b2 + kstep;
            if (last && has_next) S.a_ready(nxt);
            if constexpr (Epi::MIDK) { if (t == Epi::KT1 || t == Epi::KT2) E.mid(acc, cur, t, wr, wc, fr, fq); }
            if constexpr (SP2) {
            PG8_LDB(B0, 0, 0); PG8_LDB(B1, 0, 1); PG8_SCHED; PG8_LDA(At, 0, 0); PG8_STAGE(PG8_SA(1, 1), a1 + hstep, voffA);
            PG8_WAIT_V(8); PG8_WAIT_L(0); PG8_BAR; PG8_MMA(0, 0, At, B0); PG8_MMA(0, 1, At, B1); PG8_BAR; PG8_SCHED;
            PG8_LDA(At, 0, 1); PG8_STAGE(PG8_SB(0, 0), b2, voffB); PG8_STAGE(PG8_SB(0, 1), b2 + hstep, voffB); PG8_STAGE(PG8_SA(0, 0), a2, voffA);
            PG8_WAIT_V(8); PG8_WAIT_L(0); PG8_BAR; PG8_MMA(1, 0, At, B0); PG8_MMA(1, 1, At, B1); PG8_BAR; PG8_SCHED;
            PG8_LDB(B0, 1, 0); PG8_LDB(B1, 1, 1); PG8_SCHED; PG8_LDA(At, 1, 0); PG8_STAGE(PG8_SA(0, 1), a2 + hstep, voffA);
            PG8_WAIT_V(8); PG8_WAIT_L(0); PG8_BAR; PG8_MMA(0, 0, At, B0); PG8_MMA(0, 1, At, B1); PG8_BAR; PG8_SCHED;
            PG8_LDA(At, 1, 1); PG8_STAGE(PG8_SB(1, 0), b3, voffB); PG8_STAGE(PG8_SB(1, 1), b3 + hstep, voffB); PG8_STAGE(PG8_SA(1, 0), a3, voffA);
            PG8_WAIT_V(8); PG8_WAIT_L(0); PG8_BAR; PG8_MMA(1, 0, At, B0); PG8_MMA(1, 1, At, B1); PG8_BAR; PG8_SCHED;
            } else {
            PG8_LDB(B0, 0, 0); PG8_SCHED; PG8_LDA(At, 0, 0); PG8_STAGE(PG8_SA(1, 1), a1 + hstep, voffA);
            PG8_WAIT_L(8); PG8_BAR; PG8_WAIT_L(0); PG8_MMA(0, 0, At, B0); PG8_BAR; PG8_SCHED;
            PG8_LDB(B1, 0, 1); PG8_STAGE(PG8_SB(0, 0), b2, voffB);
            PG8_BAR; PG8_WAIT_L(0); PG8_MMA(0, 1, At, B1); PG8_BAR;
            PG8_LDA(At, 0, 1); PG8_STAGE(PG8_SA(0, 0), a2, voffA);
            PG8_BAR; PG8_WAIT_L(0); PG8_MMA(1, 0, At, B0); PG8_BAR; PG8_SCHED;
            PG8_STAGE(PG8_SB(0, 1), b2 + hstep, voffB);
            PG8_WAIT_V(6); PG8_BAR; PG8_MMA(1, 1, At, B1); PG8_BAR;
            PG8_LDB(B0, 1, 0); PG8_SCHED; PG8_LDA(At, 1, 0); PG8_STAGE(PG8_SA(0, 1), a2 + hstep, voffA);
            PG8_WAIT_L(8); PG8_BAR; PG8_WAIT_L(0); PG8_MMA(0, 0, At, B0); PG8_BAR; PG8_SCHED;
            PG8_LDB(B1, 1, 1); PG8_STAGE(PG8_SB(1, 0), b3, voffB);
            PG8_BAR; PG8_WAIT_L(0); PG8_MMA(0, 1, At, B1); PG8_BAR;
            PG8_LDA(At, 1, 1); PG8_STAGE(PG8_SA(1, 0), a3, voffA);
            PG8_BAR; PG8_WAIT_L(0); PG8_MMA(1, 0, At, B0); PG8_BAR; PG8_SCHED;
            PG8_STAGE(PG8_SB(1, 1), b3 + hstep, voffB);
            PG8_WAIT_V(6); PG8_BAR; PG8_MMA(1, 1, At, B1); PG8_BAR;
            }
        }
        if constexpr (ALIGN_EPI) { if (wr == 0) PG8_BAR; }
        if constexpr (F8) asm volatile("s_nop 15\n\ts_nop 15\n\ts_nop 15\n\ts_nop 15\n\ts_nop 15" ::: "memory");
        if constexpr (!Epi::AFTER_DRAIN) { E(acc, cur, wr, wc, fr, fq); S.done(cur); }
        if (!has_next) break;
#pragma unroll
        for (int a = 0; a < 2; ++a)
#pragma unroll
            for (int b = 0; b < 2; ++b)
#pragma unroll
                for (int m = 0; m < 4; ++m)
#pragma unroll
                    for (int n = 0; n < 2; ++n) acc[a][b][m][n] = (f32x4){0.f, 0.f, 0.f, 0.f};
        cur = nxt; cA = nA; cB = nB; ++ui;
        if constexpr (ALIGN_EPI) { if (wr == 1) PG8_BAR; }
    }
    PG8_WAIT_V(0);
    if constexpr (!ALIGN_EPI) { if (wr == 0) PG8_BAR; }
    PG8_BAR;
    if constexpr (Epi::AFTER_DRAIN) { E.fused(acc, cur, wr, wc, fr, fq, lds, wid, lane); S.done(cur); }
#undef PG8_SA
#undef PG8_SB
#undef PG8_STAGE
#undef PG8_LDA
#undef PG8_LDB
#undef PG8_MMA
#undef PG8_WAIT_V
#undef PG8_WAIT_L
#undef PG8_BAR
#undef PG8_SCHED
}
}

namespace pg8 {
struct EpiInProj {
    static constexpr bool PERM = true, AFTER_DRAIN = false, MIDK = false;
    bf16_t *Q, *G; const float *gains; float* kmean;
    __device__ __forceinline__ void operator()(const f32x4 (&acc)[2][2][4][2], const Unit& u, int wr, int wc, int, int) const {
        unsigned z_ = 0u; asm volatile("" : "+v"(z_)); const int ln_ = __builtin_amdgcn_mbcnt_hi(~0u, __builtin_amdgcn_mbcnt_lo(~0u, z_)); const int fr = ln_ & 15, fq = ln_ >> 4;
        const int row0 = u.pm * BM + wr * 64 + fr;
        if (u.pn < 18) {
            const int sec = u.pn / 6, head = (u.pn % 6) * 4 + wc;
            const int bb = (u.pm * BM) / SEQ; const int l2k = kv_l2d(head);
            const size_t doff = (size_t)sec * ((size_t)M * QW) + ((sec == 1) ? ((size_t)bb * 23 * SEQ + (size_t)head * SEQ) * 64 : (size_t)(head * 64));
            bf16_t* dst = Q + doff + fq * 8;
            f32x4 gn[2][2];
#pragma unroll
            for (int bj = 0; bj < 2; ++bj)
#pragma unroll
                for (int n = 0; n < 2; ++n) {
                    if (sec < 2) gn[bj][n] = *(const f32x4*)(gains + sec * QW + head * 64 + bj * 32 + fq * 8 + 4 * n);
                    else gn[bj][n] = (f32x4){1.f, 1.f, 1.f, 1.f};
                }
            const bool km_on = (sec == 1 && head >= 6 && head < 12);
            float cs[16];
#pragma unroll
            for (int i = 0; i < 16; ++i) cs[i] = 0.f;
#pragma unroll
            for (int ai = 0; ai < 2; ++ai)
#pragma unroll
                for (int m = 0; m < 4; ++m) {
                    float rs = 1.f;
                    if (sec < 2) {
                        float ss = 0.f;
#pragma unroll
                        for (int bj = 0; bj < 2; ++bj)
#pragma unroll
                            for (int n = 0; n < 2; ++n) { const f32x4 x = acc[ai][bj][m][n]; ss += (x[0] * x[0] + x[1] * x[1]) + (x[2] * x[2] + x[3] * x[3]); }
                        ss += shfl_l(ss, ln_ ^ 16); ss += shfl_l(ss, ln_ ^ 32);
                        rs = __builtin_amdgcn_rsqf(ss * (1.0f / 64.0f) + RMS_EPS);
                    }
                    const int rr_ = row0 + ai * HALF + m * 16;
                    bf16_t* rowp = dst + ((sec == 1) ? (size_t)(bb * SEQ + kv_row(rr_ - bb * SEQ, l2k)) * 64 : (size_t)rr_ * QW);
#pragma unroll
                    for (int bj = 0; bj < 2; ++bj) {
                        const f32x4 v0 = acc[ai][bj][m][0] * rs * gn[bj][0], v1 = acc[ai][bj][m][1] * rs * gn[bj][1];
                        if (km_on) {
#pragma unroll
                            for (int i = 0; i < 4; ++i) { cs[bj * 8 + i] += v0[i]; cs[bj * 8 + 4 + i] += v1[i]; } }
                        u32x4 w; w.x = pk2(v0[0], v0[1]); w.y = pk2(v0[2], v0[3]); w.z = pk2(v1[0], v1[1]); w.w = pk2(v1[2], v1[3]);
                        *(u32x4*)(rowp + bj * 32) = w;
                    }
                    asm volatile("" ::: "memory");
                }
            if (km_on) {
#pragma unroll
                for (int i = 0; i < 16; ++i) { float s = cs[i]; s += shfl_l(s, ln_ ^ 1); s += shfl_l(s, ln_ ^ 2); s += shfl_l(s, ln_ ^ 4); s += shfl_l(s, ln_ ^ 8); cs[i] = s; }
                if (fr == 0) { float* kp = kmean + (((size_t)(u.pm >> 3) * 6 + (head - 6)) * 8 + (u.pm & 7)) * 64 + fq * 8;
#pragma unroll
                    for (int bj = 0; bj < 2; ++bj)
#pragma unroll
                        for (int i = 0; i < 8; ++i) __hip_atomic_fetch_add(kp + bj * 32 + i, cs[bj * 8 + i] * (1.0f / 256.0f), __ATOMIC_RELAXED, __HIP_MEMORY_SCOPE_AGENT); }
            }
        }
    }
};
struct EpiGates8 {
    static constexpr bool PERM = true, AFTER_DRAIN = false, MIDK = false;
    bf16_t* G; bf16_t* V;
    __device__ __forceinline__ void operator()(const f32x4 (&acc)[2][2][4][2], const Unit& u, int wr, int wc, int, int) const {
        unsigned z_ = 0u; asm volatile("" : "+v"(z_)); const int ln_ = __builtin_amdgcn_mbcnt_hi(~0u, __builtin_amdgcn_mbcnt_lo(~0u, z_)); const int fr = ln_ & 15, fq = ln_ >> 4;
        const int row0 = u.pm * BM + wr * 64 + fr, col0 = u.pn * BM + wc * 32 + fq * 8;
        if (u.pn >= 12) {
            const int bb = (u.pm * BM) / SEQ, hv = (u.pn - 12) * 4 + wc, l2v = kv_l2d(hv); bf16_t* dst = V + ((size_t)bb * 24 + hv) * SEQ * 64 + fq * 8;
#pragma unroll
            for (int ai = 0; ai < 2; ++ai)
#pragma unroll
                for (int m = 0; m < 4; ++m) {
                    bf16_t* rowp = dst + (size_t)kv_row(row0 + ai * HALF + m * 16 - bb * SEQ, l2v) * 64;
#pragma unroll
                    for (int bj = 0; bj < 2; ++bj) { const f32x4 v0 = acc[ai][bj][m][0] * (1.0f / F8_WS), v1 = acc[ai][bj][m][1] * (1.0f / F8_WS);
                        u32x4 w; w.x = pk2(v0[0], v0[1]); w.y = pk2(v0[2], v0[3]); w.z = pk2(v1[0], v1[1]); w.w = pk2(v1[2], v1[3]);
                        *(u32x4*)(rowp + bj * 32) = w; }
                    asm volatile("" ::: "memory");
                }
            return;
        }
        unsigned char* gp = (unsigned char*)G + ((size_t)(((u.pn >> 2) * 64 + u.pm) * 4 + (u.pn & 3)) << 16) + (wr * 4 + wc) * 8192 + ln_ * 16;
#pragma unroll
        for (int ai = 0; ai < 2; ++ai)
#pragma unroll
            for (int m = 0; m < 4; ++m) {
                unsigned w4[4] = {0u, 0u, 0u, 0u};
#pragma unroll
                for (int bj = 0; bj < 2; ++bj)
#pragma unroll
                    for (int i = 0; i < 4; ++i) {
                        w4[2 * bj] = __builtin_amdgcn_cvt_pk_u8_f32(fmaxf(255.0f * __builtin_amdgcn_rcpf(1.0f + __builtin_amdgcn_exp2f((-LOG2E / F8_WS) * acc[ai][bj][m][0][i])), 1.0f), i, w4[2 * bj]);
                        w4[2 * bj + 1] = __builtin_amdgcn_cvt_pk_u8_f32(fmaxf(255.0f * __builtin_amdgcn_rcpf(1.0f + __builtin_amdgcn_exp2f((-LOG2E / F8_WS) * acc[ai][bj][m][1][i])), 1.0f), i, w4[2 * bj + 1]); }
                *(u32x4*)(gp + (ai * 4 + m) * 1024) = (u32x4){w4[0], w4[1], w4[2], w4[3]};
                asm volatile("" ::: "memory");
            }
    }
};
struct GateOrder {
    int G, c;
    __device__ __forceinline__ bool next(int i, Unit& u) const {
        int L;
        if (G == 256) { if (c >= 128) { if (i >= 4) return false; L = (c - 128) + 128 * i; } else { if (i >= 2) return false; L = 512 + c + 128 * i; } }
        else { L = i * G + c; if (L >= 768) return false; }
        u.pm = L / 12; u.pn = L % 12; return true;
    }
    __device__ __forceinline__ void a_ready(const Unit&) const {}
    __device__ __forceinline__ void done(const Unit&) const {}
};
struct EpiBranch {
    static constexpr bool PERM = true, AFTER_DRAIN = false, MIDK = true; static constexpr int KT1 = 6, KT2 = 12;
    bf16_t* YB; const bf16_t* G;
    static __device__ __forceinline__ const unsigned char* gblock(const bf16_t* G, int g, int pm, int pn, int wave, int lane) { return (const unsigned char*)G + ((size_t)((g * 64 + pm) * 4 + pn) << 16) + wave * 8192 + lane * 16; }
    __device__ __forceinline__ void mid(f32x4 (&acc)[2][2][4][2], const Unit& u, int t, int wr, int wc, int, int) const {
        unsigned z_ = 0u; asm volatile("" : "+v"(z_)); const int ln_ = __builtin_amdgcn_mbcnt_hi(~0u, __builtin_amdgcn_mbcnt_lo(~0u, z_));
        const int g0 = (t == KT1) ? 0 : 1;
        const unsigned char* pa = gblock(G, g0, u.pm, u.pn, wr * 4 + wc, ln_); const unsigned char* pb = gblock(G, g0 + 1, u.pm, u.pn, wr * 4 + wc, ln_);
#pragma unroll
        for (int ai = 0; ai < 2; ++ai)
#pragma unroll
            for (int m = 0; m < 4; ++m) {
                const u32x4 ga = *(const u32x4*)(pa + (ai * 4 + m) * 1024), gb = *(const u32x4*)(pb + (ai * 4 + m) * 1024);
#pragma unroll
                for (int bj = 0; bj < 2; ++bj) { const unsigned ax = bj ? ga.z : ga.x, ay = bj ? ga.w : ga.y, bx = bj ? gb.z : gb.x, by = bj ? gb.w : gb.y;
                    f32x4 r0 = {ub8(ax, 0) * __builtin_amdgcn_rcpf(ub8(bx, 0)), ub8(ax, 1) * __builtin_amdgcn_rcpf(ub8(bx, 1)), ub8(ax, 2) * __builtin_amdgcn_rcpf(ub8(bx, 2)), ub8(ax, 3) * __builtin_amdgcn_rcpf(ub8(bx, 3))};
                    f32x4 r1 = {ub8(ay, 0) * __builtin_amdgcn_rcpf(ub8(by, 0)), ub8(ay, 1) * __builtin_amdgcn_rcpf(ub8(by, 1)), ub8(ay, 2) * __builtin_amdgcn_rcpf(ub8(by, 2)), ub8(ay, 3) * __builtin_amdgcn_rcpf(ub8(by, 3))};
                    acc[ai][bj][m][0] = acc[ai][bj][m][0] * r0; acc[ai][bj][m][1] = acc[ai][bj][m][1] * r1;
                }
            }
    }
    __device__ __forceinline__ void operator()(const f32x4 (&acc)[2][2][4][2], const Unit& u, int wr, int wc, int, int) const {
        unsigned z_ = 0u; asm volatile("" : "+v"(z_)); const int ln_ = __builtin_amdgcn_mbcnt_hi(~0u, __builtin_amdgcn_mbcnt_lo(~0u, z_)); const int fr = ln_ & 15, fq = ln_ >> 4;
        const int row0 = u.pm * BM + wr * 64 + fr, col0 = u.pn * BM + wc * 32 + fq * 8;
        const unsigned char* pg = gblock(G, 2, u.pm, u.pn, wr * 4 + wc, ln_);
        u32x4 gw[2][4];
#pragma unroll
        for (int ai = 0; ai < 2; ++ai)
#pragma unroll
            for (int m = 0; m < 4; ++m) gw[ai][m] = *(const u32x4*)(pg + (ai * 4 + m) * 1024);
        constexpr float k8 = 1.0f / 255.0f;
#pragma unroll
        for (int ai = 0; ai < 2; ++ai)
#pragma unroll
            for (int m = 0; m < 4; ++m) {
                const size_t row = (size_t)(row0 + ai * HALF + m * 16);
#pragma unroll
                for (int bj = 0; bj < 2; ++bj) {
                    const int col = col0 + bj * HALF; const unsigned gx = bj ? gw[ai][m].z : gw[ai][m].x, gy = bj ? gw[ai][m].w : gw[ai][m].y;
                    const f32x4 g0 = {ub8(gx, 0) * k8, ub8(gx, 1) * k8, ub8(gx, 2) * k8, ub8(gx, 3) * k8}, g1 = {ub8(gy, 0) * k8, ub8(gy, 1) * k8, ub8(gy, 2) * k8, ub8(gy, 3) * k8};
                    const f32x4 v0 = acc[ai][bj][m][0] * g0, v1 = acc[ai][bj][m][1] * g1;
                    u32x4 w; w.x = pk2(v0[0], v0[1]); w.y = pk2(v0[2], v0[3]); w.z = pk2(v1[0], v1[1]); w.w = pk2(v1[2], v1[3]); *(u32x4*)(YB + row * DM + col) = w;
                }
            }
    }
};

template <bool XBF> struct EpiResid {
    static constexpr bool PERM = true, AFTER_DRAIN = false, MIDK = false;
    const void* xin; bf16_t* xb; const float* gate; float rs;
    __device__ __forceinline__ void operator()(const f32x4 (&acc)[2][2][4][2], const Unit& u, int wr, int wc, int, int) const {
        unsigned z_ = 0u; asm volatile("" : "+v"(z_)); const int ln_ = __builtin_amdgcn_mbcnt_hi(~0u, __builtin_amdgcn_mbcnt_lo(~0u, z_)); const int fr = ln_ & 15, fq = ln_ >> 4;
        const int row0 = u.pm * BM + wr * 64 + fr, col0 = u.pn * BM + wc * 32 + fq * 8;
        const float* gp = gate + (size_t)((u.pm * BM) / SEQ) * 6144;
#pragma unroll
        for (int bj = 0; bj < 2; ++bj) {
            const int col = col0 + bj * HALF;
            const f32x4 g0 = *(const f32x4*)(gp + col) * rs, g1 = *(const f32x4*)(gp + col + 4) * rs;
            f32x4 xa[2][4], xc[2][4]; u32x4 xw[2][4];
#pragma unroll
            for (int ai = 0; ai < 2; ++ai)
#pragma unroll
                for (int m = 0; m < 4; ++m) {
                    const size_t off = (size_t)(row0 + ai * HALF + m * 16) * DM + col;
                    if (XBF) xw[ai][m] = *(const u32x4*)((const bf16_t*)xin + off);
                    else { xa[ai][m] = *(const f32x4*)((const float*)xin + off); xc[ai][m] = *(const f32x4*)((const float*)xin + off + 4); }
                }
#pragma unroll
            for (int ai = 0; ai < 2; ++ai)
#pragma unroll
                for (int m = 0; m < 4; ++m) {
                    const size_t off = (size_t)(row0 + ai * HALF + m * 16) * DM + col;
                    f32x4 x0, x1;
                    if (XBF) { const u32x4 q = xw[ai][m]; x0 = (f32x4){bflo(q.x), bfhi(q.x), bflo(q.y), bfhi(q.y)}; x1 = (f32x4){bflo(q.z), bfhi(q.z), bflo(q.w), bfhi(q.w)}; }
                    else { x0 = xa[ai][m]; x1 = xc[ai][m]; }
                    x0 = x0 + g0 * acc[ai][bj][m][0]; x1 = x1 + g1 * acc[ai][bj][m][1];
                    u32x4 w; w.x = pk2(x0[0], x0[1]); w.y = pk2(x0[2], x0[3]); w.z = pk2(x1[0], x1[1]); w.w = pk2(x1[2], x1[3]);
                    *(u32x4*)(xb + off) = w;
                }
            asm volatile("" ::: "memory");
        }
    }
};
struct EpiSwiglu {
    static constexpr bool PERM = true, AFTER_DRAIN = false, MIDK = false;
    bf16_t* ACT; int npn; float qs;
    __device__ __forceinline__ void operator()(const f32x4 (&acc)[2][2][4][2], const Unit& u, int wr, int wc, int, int) const {
        unsigned z_ = 0u; asm volatile("" : "+v"(z_)); const int ln_ = __builtin_amdgcn_mbcnt_hi(~0u, __builtin_amdgcn_mbcnt_lo(~0u, z_)); const int fr = ln_ & 15, fq = ln_ >> 4;
        const int row0 = u.pm * BM + wr * 64 + fr, col0 = (u.pn % npn) * HALF + wc * 32 + fq * 8;
#pragma unroll
        for (int ai = 0; ai < 2; ++ai)
#pragma unroll
            for (int m = 0; m < 4; ++m) {
                float s[8];
#pragma unroll
                for (int n = 0; n < 2; ++n)
#pragma unroll
                    for (int i = 0; i < 4; ++i) { const float g = acc[ai][0][m][n][i], up = acc[ai][1][m][n][i]; s[4 * n + i] = g * __builtin_amdgcn_rcpf(1.0f + __builtin_amdgcn_exp2f(-LOG2E * g)) * up; if (PROBE_FP8 && qs != 0.f) s[4 * n + i] = q8(s[4 * n + i], qs); }
                u32x4 w; w.x = pk2(s[0], s[1]); w.y = pk2(s[2], s[3]); w.z = pk2(s[4], s[5]); w.w = pk2(s[6], s[7]);
                *(u32x4*)(ACT + (size_t)(row0 + ai * HALF + m * 16) * DFF + col0) = w;
                asm volatile("" ::: "memory");
            }
    }
};
struct EpiSwiglu8 {
    static constexpr bool PERM = true, AFTER_DRAIN = false, MIDK = false;
    unsigned char* ACT; int npn; float sg, su;
    __device__ __forceinline__ void operator()(const f32x4 (&acc)[2][2][4][2], const Unit& u, int wr, int wc, int, int) const {
        unsigned z_ = 0u; asm volatile("" : "+v"(z_)); const int ln_ = __builtin_amdgcn_mbcnt_hi(~0u, __builtin_amdgcn_mbcnt_lo(~0u, z_)); const int fr = ln_ & 15, fq = ln_ >> 4;
        const int row0 = u.pm * BM + wr * 64 + fr, col0 = (u.pn % npn) * HALF + wc * 32 + fq * 8;
#pragma unroll
        for (int ai = 0; ai < 2; ++ai)
#pragma unroll
            for (int m = 0; m < 4; ++m) {
                float s[8];
#pragma unroll
                for (int n = 0; n < 2; ++n)
#pragma unroll
                    for (int i = 0; i < 4; ++i) { const float g = acc[ai][0][m][n][i] * sg, up = acc[ai][1][m][n][i] * su; s[4 * n + i] = g * __builtin_amdgcn_rcpf(1.0f + __builtin_amdgcn_exp2f(-LOG2E * g)) * up; }
                unsigned long long w = (unsigned long long)pk4_fp8(s[0], s[1], s[2], s[3]) | ((unsigned long long)pk4_fp8(s[4], s[5], s[6], s[7]) << 32);
                *(unsigned long long*)(ACT + (size_t)(row0 + ai * HALF + m * 16) * DFF + col0) = w;
                asm volatile("" ::: "memory");
            }
    }
};
struct EpiMoeY {
    static constexpr bool PERM = true, AFTER_DRAIN = false, MIDK = false;
    bf16_t* Y; const float* gate; const int* tok; const float* wrow; float sc;
    __device__ __forceinline__ void operator()(const f32x4 (&acc)[2][2][4][2], const Unit& u, int wr, int wc, int, int) const {
        unsigned z_ = 0u; asm volatile("" : "+v"(z_)); const int ln_ = __builtin_amdgcn_mbcnt_hi(~0u, __builtin_amdgcn_mbcnt_lo(~0u, z_)); const int fr = ln_ & 15, fq = ln_ >> 4;
        const int row0 = u.pm * BM + wr * 64 + fr, col0 = (u.pn & 3) * BM + wc * 32 + fq * 8;
        int ids[2][4]; float wsc[2][4];
#pragma unroll
        for (int ai = 0; ai < 2; ++ai)
#pragma unroll
            for (int m = 0; m < 4; ++m) { const int r = row0 + ai * HALF + m * 16; ids[ai][m] = tok[r]; wsc[ai][m] = wrow[r] * sc; }
#pragma unroll
        for (int ai = 0; ai < 2; ++ai) {
            f32x4 gq[4][2][2];
#pragma unroll
            for (int m = 0; m < 4; ++m) { const int id = ids[ai][m]; const float* gp = gate + (size_t)(((id >= 0) ? (id >> 1) : 0) / SEQ) * 6144;
#pragma unroll
                for (int bj = 0; bj < 2; ++bj) { gq[m][bj][0] = *(const f32x4*)(gp + col0 + bj * HALF); gq[m][bj][1] = *(const f32x4*)(gp + col0 + bj * HALF + 4); } }
#pragma unroll
            for (int m = 0; m < 4; ++m) { const int id = ids[ai][m];
                if (id >= 0) { const float w = wsc[ai][m];
#pragma unroll
                    for (int bj = 0; bj < 2; ++bj) {
                        const int col = col0 + bj * HALF; const f32x4 g0 = gq[m][bj][0] * w, g1 = gq[m][bj][1] * w;
                        const f32x4 v0 = acc[ai][bj][m][0] * g0, v1 = acc[ai][bj][m][1] * g1;
                        u32x4 o; o.x = pk2(v0[0], v0[1]); o.y = pk2(v0[2], v0[3]); o.z = pk2(v1[0], v1[1]); o.w = pk2(v1[2], v1[3]);
                        *(u32x4*)(Y + (size_t)id * DM + col) = o;
                    }
                }
            }
            asm volatile("" ::: "memory");
        }
    }
};
struct MoeOrder {
    StaticOrder so; const int* tmap; int npn;
    __device__ __forceinline__ bool next(int i, Unit& u) const { if (!so.next(i, u)) return false; u.pn += tmap[u.pm] * npn; return true; }
    __device__ __forceinline__ void a_ready(const Unit&) const {}
    __device__ __forceinline__ void done(const Unit&) const {}
};
}
#define XB_TMO      128
#define XB_XCNT(j)  (256  + 64 * (j))
#define XB_XSUB(j)  (1280 + 64 * (j))
#define XB_XGEN(j)  (2304 + 64 * (j))
#define XB_TOP      3328
#define XB_TOPGEN   3392
#define XCD_BAR_WORDS 3456
#define XB_SPIN_CAP (1u << 18)

__device__ __forceinline__ unsigned xb_ld(unsigned* p)              { return __hip_atomic_load(p, __ATOMIC_RELAXED, __HIP_MEMORY_SCOPE_AGENT); }
__device__ __forceinline__ unsigned xb_add(unsigned* p, unsigned v) { return __hip_atomic_fetch_add(p, v, __ATOMIC_RELAXED, __HIP_MEMORY_SCOPE_AGENT); }
__device__ __forceinline__ unsigned xb_xcc_id() { return (unsigned)__builtin_amdgcn_s_getreg((3 << 11) | 20) & 0xFu; }
#define XB_SPIN(cond, bar) do { unsigned _sp = 0; while (cond) { __builtin_amdgcn_s_sleep(1); \
    if ((++_sp & 255u) == 0u) { if (xb_ld(&(bar)[XB_TMO])) break; if (_sp > XB_SPIN_CAP) { atomicAdd(&(bar)[XB_TMO], 1u); break; } } } } while (0)

struct XcdBarrier {
    unsigned* bar; unsigned x;
    volatile LAS unsigned* st;
};

__device__ __forceinline__ XcdBarrier xcd_barrier_post(unsigned* bar, volatile LAS unsigned* st, bool t0) {
    XcdBarrier b; b.bar = bar; b.x = xb_xcc_id(); b.st = st;
    if (t0) (void)xb_add(&bar[XB_XCNT(b.x)], 1u);
    return b;
}
__device__ __forceinline__ void xcd_barrier_complete(unsigned* bar, unsigned x, unsigned& nloc, unsigned& nx) {
    const unsigned G = gridDim.x * gridDim.y * gridDim.z;
    unsigned sum, cnt, mine, sp = 0u;
    for (;;) {
        sum = 0u; cnt = 0u; mine = 0u;
#pragma unroll
        for (unsigned j = 0; j < 16; ++j) { const unsigned c = xb_ld(&bar[XB_XCNT(j)]); sum += c; cnt += (c > 0u) ? 1u : 0u; mine = (j == x) ? c : mine; }
        if (sum == G) break;
        __builtin_amdgcn_s_sleep(1);
        if ((++sp & 255u) == 0u) { if (xb_ld(&bar[XB_TMO])) break; if (sp > XB_SPIN_CAP) { atomicAdd(&bar[XB_TMO], 1u); break; } }
    }
    nloc = mine > 0u ? mine : 1u; nx = cnt > 0u ? cnt : 1u;
}

__device__ __forceinline__ void xcd_barrier(const XcdBarrier& b, int wave_k) {
    asm volatile("s_waitcnt vmcnt(0)" ::: "memory");
    __syncthreads();
    if (wave_k == 0 && lane_opq() == 0) {
        unsigned* bar = b.bar;
        __builtin_amdgcn_s_waitcnt(0);
        unsigned nloc = b.st[0], nx = b.st[1];
        if (nloc == 0u) { xcd_barrier_complete(bar, b.x, nloc, nx); b.st[0] = nloc; b.st[1] = nx; }
        const unsigned old = xb_add(&bar[XB_XSUB(b.x)], 1u);
        const unsigned gen = old / nloc;
        if (old + 1u == (gen + 1u) * nloc) {
            __builtin_amdgcn_fence(__ATOMIC_RELEASE, "agent");
            asm volatile("s_waitcnt vmcnt(0)" ::: "memory");
            const unsigned og = xb_add(&bar[XB_TOP], 1u);
            const unsigned tg = og / nx;
            if (og + 1u == (tg + 1u) * nx) xb_add(&bar[XB_TOPGEN], 1u);
            else XB_SPIN(xb_ld(&bar[XB_TOPGEN]) == tg, bar);
            __builtin_amdgcn_fence(__ATOMIC_ACQUIRE, "agent");
            xb_add(&bar[XB_XGEN(b.x)], 1u);
            asm volatile("s_waitcnt vmcnt(0)" ::: "memory");
        } else {
            XB_SPIN(xb_ld(&bar[XB_XGEN(b.x)]) == gen, bar);
            __builtin_amdgcn_fence(__ATOMIC_ACQUIRE, "agent");
            asm volatile("s_waitcnt vmcnt(0)" ::: "memory");
        }
    }
    __syncthreads();
}

struct ConvItem { const float* src; size_t ldw; unsigned char* dst; int ldk; int fp8; };
__device__ __forceinline__ void conv_load(const ConvItem& d, float (&v)[32], int lane) {
#pragma unroll
    for (int i = 0; i < 32; ++i) v[i] = d.src[(size_t)(2 * i + (lane >> 5)) * d.ldw + (lane & 31)];
}
__device__ __forceinline__ void conv_store(const ConvItem& d, const float (&v)[32], LAS float* scr, int lane) {
    const float qs = d.fp8 ? F8_WS : 1.0f;
#pragma unroll
    for (int i = 0; i < 32; ++i) scr[(2 * i + (lane >> 5)) * 33 + (lane & 31)] = v[i] * qs;
    LDS_WAIT(); asm volatile("" ::: "memory");
    if (d.fp8) { const int c = lane & 3;
#pragma unroll
        for (int j = 0; j < 2; ++j) { const int n = (lane >> 2) + 16 * j; const LAS float* s = scr + (16 * c) * 33 + n;
            v4u o; o.x = pk4_fp8(s[0 * 33], s[1 * 33], s[2 * 33], s[3 * 33]); o.y = pk4_fp8(s[4 * 33], s[5 * 33], s[6 * 33], s[7 * 33]);
            o.z = pk4_fp8(s[8 * 33], s[9 * 33], s[10 * 33], s[11 * 33]); o.w = pk4_fp8(s[12 * 33], s[13 * 33], s[14 * 33], s[15 * 33]);
            *(GAS v4u*)(d.dst + (size_t)n * d.ldk + 16 * c) = o; } }
    else { const int c = lane & 7;
#pragma unroll
        for (int j = 0; j < 4; ++j) { const int n = (lane >> 3) + 8 * j; const LAS float* s = scr + (8 * c) * 33 + n;
            v4u o; o.x = pk2(s[0 * 33], s[1 * 33]); o.y = pk2(s[2 * 33], s[3 * 33]); o.z = pk2(s[4 * 33], s[5 * 33]); o.w = pk2(s[6 * 33], s[7 * 33]);
            *(GAS v4u*)(d.dst + (size_t)n * d.ldk + 16 * c) = o; } }
    LDS_WAIT(); asm volatile("" ::: "memory");
}
__device__ __forceinline__ int map_qkv(int c0) { const int sec = c0 / QW, cs = c0 % QW, head = cs >> 6, bj = (cs >> 5) & 1; return sec * QW + (head >> 2) * 256 + bj * 128 + (head & 3) * 32; }
__device__ __forceinline__ int map_gu(int c0, int up) { return (c0 >> 7) * 256 + up * 128 + (c0 & 96); }

struct KArgs { const float* in[22]; float* out; unsigned char* ws; int ph_lo, ph_hi; };
__device__ __forceinline__ const float* karg_ptr(int i) { int j = i; asm volatile("" : "+s"(j));
    const __attribute__((address_space(4))) unsigned long long* kp = (const __attribute__((address_space(4))) unsigned long long*)__builtin_amdgcn_kernarg_segment_ptr(); return (const float*)(const GAS float*)kp[j]; }
#define AIN(k) karg_ptr(k)
#define AOUT ((float*)karg_ptr(22))

constexpr int CONV_PER_LAYER = 2304 + 1536 + 192 + 192 + 128 + 512, CONV_NITEMS = 2 * CONV_PER_LAYER + 9 * 4224;
__device__ __forceinline__ void conv_decode(int it, GAS unsigned char* ws, ConvItem& d) {
    d.fp8 = 0;
    if (it < 2 * CONV_PER_LAYER) {
        const int l = it / CONV_PER_LAYER; int r = it % CONV_PER_LAYER;
        const float* win = AIN(6) + (size_t)l * DM * IN_COLS;
        if (r < 2304) { const int kb = r / 144, nb = r % 144; d.src = win + (size_t)(64 * kb) * IN_COLS + 32 * nb; d.ldw = IN_COLS;
            if (V_FP8 && nb >= 96) { d.ldk = DM; d.fp8 = 1;
                d.dst = (unsigned char*)(ws + WS_WIN) + (size_t)l * 15 * MiB + WS_WG8_OFF + (size_t)map_qkv(32 * nb) * DM + 64 * kb; return; }
            d.ldk = DM * 2; d.dst = (unsigned char*)(ws + WS_WIN) + (size_t)l * 15 * MiB + (size_t)map_qkv(32 * nb) * DM * 2 + 64 * kb * 2; return; } r -= 2304;
        if (r < 1536) { const int kb = r / 96, nb = r % 96; d.src = win + (size_t)(64 * kb) * IN_COLS + 4614 + 32 * nb; d.ldw = IN_COLS; d.ldk = DM; d.fp8 = 1;
            d.dst = (unsigned char*)(ws + WS_WIN) + (size_t)l * 15 * MiB + WS_WG8_OFF + (size_t)(32 * nb) * DM + 64 * kb; return; } r -= 1536;
        unsigned char* wbr = (unsigned char*)(ws + WS_WBR) + (size_t)l * DM * DM * 2;
        if (r < 192) { const int kb = r / 32, nb = r % 32; d.src = AIN(10) + (size_t)l * FOXW * DM + (size_t)(64 * kb) * DM + 32 * nb; d.ldw = DM; d.ldk = DM * 2; d.dst = wbr + (size_t)(32 * nb) * DM * 2 + (64 * kb) * 2; return; } r -= 192;
        if (r < 192) { const int kb = r / 32, nb = r % 32; d.src = AIN(11) + (size_t)l * MOBW * DM + (size_t)(64 * kb) * DM + 32 * nb; d.ldw = DM; d.ldk = DM * 2; d.dst = wbr + (size_t)(32 * nb) * DM * 2 + (384 + 64 * kb) * 2; return; } r -= 192;
        if (r < 128) { const int kb = r / 32, nb = r % 32; d.src = AIN(12) + (size_t)l * DILW * DM + (size_t)(64 * kb) * DM + 32 * nb; d.ldw = DM; d.ldk = DM * 2; d.dst = wbr + (size_t)(32 * nb) * DM * 2 + (768 + 64 * kb) * 2; return; } r -= 128;
        { const int kb = r / 32, nb = r % 32; d.src = AIN(13) + (size_t)l * DM * DM + (size_t)(64 * kb) * DM + 32 * nb; d.ldw = DM; d.ldk = DM * 2;
          d.dst = (unsigned char*)(ws + WS_WOUT) + (size_t)l * DM * DM * 2 + (size_t)(32 * nb) * DM * 2 + (64 * kb) * 2; return; }
    }
    const int q = it - 2 * CONV_PER_LAYER, ex = q / 4224; int r = q % 4224;
    const int f8 = ((ex > 0 && MOE_FP8) || (ex == 0 && DENSE2_FP8 && r >= 2816)) ? 1 : 0, eb = f8 ? 1 : 2;
    const size_t e = ex > 0 ? ex - 1 : 0;
    const float* wg = ex == 0 ? AIN(14) : AIN(19) + e * DM * DFF; const float* wu = ex == 0 ? AIN(15) : AIN(20) + e * DM * DFF; const float* wd = ex == 0 ? AIN(16) : AIN(21) + e * DFF * DM;
    unsigned char* w1t = ex == 0 ? (unsigned char*)(ws + WS_WF1) : (unsigned char*)(ws + WS_WE1) + e * 5632 * DM * eb;
    unsigned char* w2t = ex == 0 ? (unsigned char*)(ws + WS_WF2) : (unsigned char*)(ws + WS_WE2) + e * DM * DFF * eb;
    d.fp8 = f8;
    if (r < 2816) { const int up = r >= 1408; r -= up * 1408; const int kb = r / 88, nb = r % 88; d.src = (up ? wu : wg) + (size_t)(64 * kb) * DFF + 32 * nb; d.ldw = DFF; d.ldk = DM * eb;
        d.dst = w1t + ((size_t)map_gu(32 * nb, up) * DM + 64 * kb) * eb; return; } r -= 2816;
    { const int kb = r / 32, nb = r % 32; d.src = wd + (size_t)(64 * kb) * DM + 32 * nb; d.ldw = DM; d.ldk = DFF * eb; d.dst = w2t + ((size_t)(32 * nb) * DFF + 64 * kb) * eb; }
}
__device__ __forceinline__ void phase_mods(GAS unsigned char* ws, LAS unsigned char* lds, int tid, int lane, int wave) {
    __syncthreads();
    {
        LAS float* cond = (LAS float*)lds;
        LAS float* part = (LAS float*)(lds + 32768);
        const float* c = AIN(1);
        { float cv[NB * DM / NTHR];
#pragma unroll
          for (int i = 0; i < NB * DM / NTHR; ++i) cv[i] = c[tid + NTHR * i];
#pragma unroll
          for (int i = 0; i < NB * DM / NTHR; ++i) cond[tid + NTHR * i] = cv[i] / (1.0f + __expf(-cv[i])); }
        __syncthreads();
        float* mods = (float*)(ws + WS_MODS);
        for (int u = blockIdx.x; u < 2 * 96; u += gridDim.x) {
            const int l = u / 96, cg = u % 96, col = tid & 63, ks = tid >> 6;
            const float* w = AIN(2) + (size_t)l * DM * 6144 + cg * 64 + col;
            float acc[8];
#pragma unroll
            for (int b = 0; b < 8; ++b) acc[b] = 0.f;
            for (int k0 = ks * 128; k0 < ks * 128 + 128; k0 += 32) {
                float wv[32];
#pragma unroll
                for (int kk = 0; kk < 32; ++kk) wv[kk] = w[(size_t)(k0 + kk) * 6144];
#pragma unroll
                for (int kk = 0; kk < 32; ++kk) {
#pragma unroll
                    for (int b = 0; b < 8; ++b) acc[b] += cond[b * DM + k0 + kk] * wv[kk]; }
            }
#pragma unroll
            for (int b = 0; b < 8; ++b) part[(ks * 8 + b) * 64 + col] = acc[b];
            __syncthreads();
            { const int b = tid >> 6; float s = 0.f;
#pragma unroll
              for (int k2 = 0; k2 < 8; ++k2) s += part[(k2 * 8 + b) * 64 + col];
              mods[((size_t)l * NB + b) * 6144 + cg * 64 + col] = s + AIN(3)[(size_t)l * 6144 + cg * 64 + col]; }
            __syncthreads();
        }
        __syncthreads();
    }
    if (blockIdx.x == 0) { float* gains = (float*)(ws + WS_GAINS);
        for (int i = tid; i < 2 * 2 * QW; i += NTHR) { const int l = i / (2 * QW), r = i % (2 * QW); gains[i] = (r < QW) ? AIN(8)[l * QW + r] * C2 : AIN(9)[l * QW + r - QW]; } }
}
__device__ __forceinline__ void conv_run(GAS unsigned char* ws, LAS unsigned char* lds, int lane, int wave, int first, int stride, int end) {
    LAS float* scr = (LAS float*)(lds + wave * 16384);
    ConvItem cur, nxt; float va[32], vb[32];
    int it = first;
    if (it < end) { conv_decode(it, ws, cur); conv_load(cur, va, lane); }
    for (; it < end; it += 2 * stride) {
        const bool h1 = it + stride < end, h2 = it + 2 * stride < end;
        if (h1) { conv_decode(it + stride, ws, nxt); conv_load(nxt, vb, lane); }
        conv_store(cur, va, scr, lane);
        if (h2) { conv_decode(it + 2 * stride, ws, cur); conv_load(cur, va, lane); }
        if (h1) conv_store(nxt, vb, scr, lane);
    }
}
__device__ __forceinline__ void conv_run4(GAS unsigned char* ws, LAS unsigned char* lds, int lane, int wave, int first, int stride, int end) {
    LAS float* scr = (LAS float*)(lds + wave * 16384);
    ConvItem c0, c1, c2, c3; float v0[32], v1[32], v2[32], v3[32];
    const bool h0 = first < end, h1 = first + stride < end, h2 = first + 2 * stride < end, h3 = first + 3 * stride < end;
    if (h0) { conv_decode(first, ws, c0); conv_load(c0, v0, lane); }
    if (h1) { conv_decode(first + stride, ws, c1); conv_load(c1, v1, lane); }
    if (h2) { conv_decode(first + 2 * stride, ws, c2); conv_load(c2, v2, lane); }
    if (h3) { conv_decode(first + 3 * stride, ws, c3); conv_load(c3, v3, lane); }
    if (h0) conv_store(c0, v0, scr, lane);
    if (h1) conv_store(c1, v1, scr, lane);
    if (h2) conv_store(c2, v2, scr, lane);
    if (h3) conv_store(c3, v3, scr, lane);
}
constexpr int CONV_FIRST = 2304 + 1536, CONV_SPLIT = 2 * CONV_PER_LAYER + 5 * 4224, CONV_UNIT = 32;
__device__ __forceinline__ void phase_convert(GAS unsigned char* ws, LAS unsigned char* lds, int tid, int lane, int wave) {
    __syncthreads();
    conv_run(ws, lds, lane, wave, blockIdx.x * NWAVES + wave, gridDim.x * NWAVES, CONV_FIRST);
}

template <int MODE, bool XBF>
__device__ __forceinline__ void phase_norm(const void* xs, const float* gain, const float* mods  , int shift_off, int scale_off,
                                           bf16* hout, unsigned char* h8out, const float* win, const float* bfg, float* flog, const float* wr, const float* br, int* sel, float* wt, int* rcnt, int* tok, float* wrow, int* tile_e,
                                           LAS unsigned char* lds, int tid, int lane, int wave) {
    LAS float* wf = (LAS float*)lds;
    if (MODE == 0) { for (int i = tid; i < 6 * DM; i += NTHR) { const int hh = i / DM, k = i % DM; wf[i] = win[(size_t)k * IN_COLS + 4608 + hh]; } __syncthreads(); }
    if (MODE == 2) { for (int i = tid; i < 8 * DM; i += NTHR) { const int e = i / DM, k = i % DM; wf[i] = wr[(size_t)k * NE + e]; } __syncthreads(); }
    const int gw = blockIdx.x * NWAVES + wave, NGW = gridDim.x * NWAVES;
    const int tpw = (M + NGW - 1) / NGW;
    int cntv = 0;
    if (MODE == 3) {
        LAS int* part = (LAS int*)lds;
        LAS int* tab = (LAS int*)(lds + 2048);
        const int cpp = (NGW + 63) / 64, g0 = blockIdx.x * NWAVES;
        { const int e = tid & 7, p = tid >> 3; int s = 0; for (int gi = p * cpp; gi < (p + 1) * cpp && gi < NGW; ++gi) s += rcnt[gi * 8 + e]; part[p * 8 + e] = s; }
        __syncthreads();
        if (tid < 8) { int T = 0, S = 0; const int pf = g0 / cpp; for (int p = 0; p < 64; ++p) { const int x = part[p * 8 + tid]; T += x; if (p < pf) S += x; }
            for (int gi = pf * cpp; gi < g0; ++gi) S += rcnt[gi * 8 + tid]; tab[tid] = T; tab[8 + tid] = S; }
        __syncthreads();
        if (tid == 0) { int bse = 0; for (int e = 0; e < 8; ++e) { tab[16 + e] = bse; bse += (tab[e] + 255) & ~255; } tab[24] = bse; }
        __syncthreads();
        if (lane < 8) { int v = tab[16 + lane] + tab[8 + lane]; for (int w = 0; w < wave; ++w) v += rcnt[(g0 + w) * 8 + lane]; cntv = v; }
        if (blockIdx.x == 0) {
            for (int e = 0; e < 8; ++e) { const int lo_ = tab[16 + e] + tab[e], hi_ = tab[16 + e + 1]; for (int p = lo_ + tid; p < hi_; p += NTHR) { tok[p] = -1; wrow[p] = 0.f; }
                for (int i = tab[16 + e] / 256 + tid; i < hi_ / 256; i += NTHR) tile_e[i] = e; }
            if (tid == 0) tile_e[255] = tab[24] / 256;
        }
    }
    f32x4 g[4], sc[4], sh[4]; int curb = -1;
#pragma unroll
    for (int j = 0; j < 4; ++j) g[j] = *(const f32x4*)(gain + 4 * lane + 256 * j);
#define NRM_LOAD(RF, RH, mm) do { _Pragma("unroll") for (int j_ = 0; j_ < 4; ++j_) { \
        if (XBF) RH[j_] = *((const GAS unsigned long long*)((const bf16*)xs + (size_t)(mm) * DM + 256 * j_) + lane); \
        else RF[j_] = *(const f32x4*)((const float*)xs + (size_t)(mm) * DM + 4 * lane + 256 * j_); } } while (0)
    const int m0 = gw * tpw, m1 = ((gw + 1) * tpw < M) ? (gw + 1) * tpw : M;
    int selv = 0; float wtv = 0.f;
    const bool pre3 = (MODE == 3) && tpw <= 32;
    if (pre3) { if (2 * m0 + lane < 2 * m1) { selv = sel[2 * m0 + lane]; wtv = wt[2 * m0 + lane]; } }
    f32x4 curf[4], nxtf[4]; unsigned long long curh[4], nxth[4];
#pragma unroll
    for (int j = 0; j < 4; ++j) { curf[j] = (f32x4){0.f, 0.f, 0.f, 0.f}; nxtf[j] = curf[j]; curh[j] = 0ull; nxth[j] = 0ull; }
    if (m0 < m1) NRM_LOAD(curf, curh, m0);
    for (int m = m0; m < m1; ++m) {
        if (m + 1 < m1) NRM_LOAD(nxtf, nxth, m + 1);
        const int b = m / SEQ;
        if (b != curb) { curb = b;
#pragma unroll
            for (int j = 0; j < 4; ++j) { sc[j] = *(const f32x4*)(mods + (size_t)b * 6144 + scale_off + 4 * lane + 256 * j); sh[j] = *(const f32x4*)(mods + (size_t)b * 6144 + shift_off + 4 * lane + 256 * j); } }
        f32x4 v[4]; float ss = 0.f;
#pragma unroll
        for (int j = 0; j < 4; ++j) {
            if (XBF) { const unsigned lo_ = (unsigned)curh[j], hi_ = (unsigned)(curh[j] >> 32); v[j] = (f32x4){bflo(lo_), bfhi(lo_), bflo(hi_), bfhi(hi_)}; }
            else v[j] = curf[j];
            ss += (v[j].x * v[j].x + v[j].y * v[j].y) + (v[j].z * v[j].z + v[j].w * v[j].w); }
#pragma unroll
        for (int j = 0; j < 4; ++j) { curf[j] = nxtf[j]; curh[j] = nxth[j]; }
        const float rstd = 1.0f / sqrtf(wave_sum(ss) * (1.0f / DM) + RMS_EPS);
#pragma unroll
        for (int j = 0; j < 4; ++j) v[j] = v[j] * rstd * g[j] * (sc[j] + 1.0f) + sh[j];
        if (MODE == 1 && PROBE_FP8 == 2) {
#pragma unroll
            for (int j = 0; j < 4; ++j) { v[j].x = q8(v[j].x, 1.f); v[j].y = q8(v[j].y, 1.f); v[j].z = q8(v[j].z, 1.f); v[j].w = q8(v[j].w, 1.f); } }
        if (MODE == 0 || MODE == 1) {
            GAS unsigned long long* o8 = (GAS unsigned long long*)(hout + (size_t)m * DM) + lane;
#pragma unroll
            for (int j = 0; j < 4; ++j) o8[64 * j] = (unsigned long long)pk2(v[j].x, v[j].y) | ((unsigned long long)pk2(v[j].z, v[j].w) << 32);
        }
        if (MODE == 0) { GAS unsigned* o4 = (GAS unsigned*)(h8out + (size_t)m * DM) + lane;
#pragma unroll
            for (int j = 0; j < 4; ++j) o4[64 * j] = pk4_fp8(v[j].x, v[j].y, v[j].z, v[j].w); }
        if (MODE == 3) {
            if (PROBE_FP8) {
#pragma unroll
                for (int j = 0; j < 4; ++j) { v[j].x = q8(v[j].x, 1.f); v[j].y = q8(v[j].y, 1.f); v[j].z = q8(v[j].z, 1.f); v[j].w = q8(v[j].w, 1.f); } }
#pragma unroll
            for (int k2 = 0; k2 < 2; ++k2) { const int ex = pre3 ? shfl_li(selv, 2 * (m - m0) + k2) : sel[2 * m + k2]; const float wk = pre3 ? shfl_l(wtv, 2 * (m - m0) + k2) : wt[2 * m + k2]; const int p = shfl_li(cntv, ex); if (lane == ex) ++cntv;
                if (lane == 0) { tok[p] = 2 * m + k2; wrow[p] = wk; }
                if (MOE_FP8) { GAS unsigned* o4 = (GAS unsigned*)((unsigned char*)hout + (size_t)p * DM) + lane;
#pragma unroll
                    for (int j = 0; j < 4; ++j) o4[64 * j] = pk4_fp8(v[j].x, v[j].y, v[j].z, v[j].w); }
                else { GAS unsigned long long* o8 = (GAS unsigned long long*)(hout + (size_t)p * DM) + lane;
#pragma unroll
                    for (int j = 0; j < 4; ++j) o8[64 * j] = (unsigned long long)pk2(v[j].x, v[j].y) | ((unsigned long long)pk2(v[j].z, v[j].w) << 32); } }
        }
        if (MODE == 0) {
            const int t = m % SEQ;
#pragma unroll
            for (int hh = 0; hh < 6; ++hh) { float d = 0.f;
#pragma unroll
                for (int j = 0; j < 4; ++j) { const f32x4 w = *(const LAS f32x4*)(wf + hh * DM + 4 * lane + 256 * j); d += (v[j].x * w.x + v[j].y * w.y) + (v[j].z * w.z + v[j].w * w.w); }
                d = wave_sum(d) + bfg[hh]; if (lane == 0) flog[((size_t)b * 6 + hh) * SEQ + t] = (fminf(d, 0.f) - log1pf(expf(-fabsf(d)))) * LOG2E; }
        }
        if (MODE == 2) {
            float lg[8];
#pragma unroll
            for (int e = 0; e < 8; ++e) { float d = 0.f;
#pragma unroll
                for (int j = 0; j < 4; ++j) { const f32x4 w = *(const LAS f32x4*)(wf + e * DM + 4 * lane + 256 * j); d += (v[j].x * w.x + v[j].y * w.y) + (v[j].z * w.z + v[j].w * w.w); }
                lg[e] = wave_sum(d) + br[e]; }
            int i0 = 0; float v0 = lg[0];
#pragma unroll
            for (int e = 1; e < 8; ++e) if (lg[e] > v0) { v0 = lg[e]; i0 = e; }
            int i1 = -1; float v1 = -3.0e38f;
#pragma unroll
            for (int e = 0; e < 8; ++e) if (e != i0 && lg[e] > v1) { v1 = lg[e]; i1 = e; }
            const float e1 = __expf(v1 - v0), w0 = 1.0f / (1.0f + e1), w1 = e1 / (1.0f + e1);
            if (lane == 0) { sel[2 * m] = i0; sel[2 * m + 1] = i1; wt[2 * m] = w0; wt[2 * m + 1] = w1; }
            if (lane == i0 || lane == i1) ++cntv;
        }
    }
    if (MODE == 2) { if (lane < 8) rcnt[gw * 8 + lane] = cntv; }
}

__device__ __forceinline__ void phase_scan(const float* flog, float* fcum, const bf16* K, float* kmean, LAS unsigned char* lds, int tid, int lane, int wave) {
    LAS float* wtot = (LAS float*)lds;
    for (int u = blockIdx.x; u < NB * 6; u += gridDim.x) {
        const f32x4 f = *(const f32x4*)(flog + (size_t)u * SEQ + 4 * tid);
        float a[4];
#pragma unroll
        for (int i = 0; i < 4; ++i) { const float x = f[i]; a[i] = (fminf(x, 0.f) - log1pf(expf(-fabsf(x)))) * LOG2E; }
        a[1] += a[0]; a[2] += a[1]; a[3] += a[2];
        float incl = a[3];
#pragma unroll
        for (int o = 1; o < 64; o <<= 1) { const float t = shfl_l(incl, (lane - o) & 63); if (lane >= o) incl += t; }
        if (lane == 63) wtot[wave] = incl;
        __syncthreads();
        float base = incl - a[3];
        for (int w = 0; w < wave; ++w) base += wtot[w];
        f32x4 o = {a[0] + base, a[1] + base, a[2] + base, a[3] + base};
        *(f32x4*)(fcum + (size_t)u * SEQ + 4 * tid) = o;
        __syncthreads();
    }
    const int gw = blockIdx.x * NWAVES + wave, NGW = gridDim.x * NWAVES;
    for (int it = gw; it < NB * 6 * 8; it += NGW) {
        const int b = it / 48, hm = (it / 8) % 6, blk = it % 8;
        const bf16* kp = K + ((size_t)b * SEQ + blk * 256) * QW + (6 + hm) * 64 + lane;
        float s = 0.f;
        for (int i = 0; i < 256; ++i) s += bflo((unsigned)kp[(size_t)i * QW]);
        kmean[(size_t)it * 64 + lane] = s * (1.0f / 256.0f);
    }
}

__device__ __forceinline__ void phase_moe_combine(float* out, const bf16* XB, const bf16* Y, int tid) {
    const int stride = gridDim.x * NTHR, NIT = M * (DM / 8);
    for (int it0 = blockIdx.x * NTHR + tid; it0 < NIT; it0 += 4 * stride) {
        v4u a[4], bq[4], x[4];
#pragma unroll
        for (int q = 0; q < 4; ++q) { const int it = it0 + q * stride; if (it < NIT) { const int t = it >> 7, ch = it & 127;
            a[q] = *(const v4u*)(Y + (size_t)(2 * t) * DM + ch * 8); bq[q] = *(const v4u*)(Y + (size_t)(2 * t + 1) * DM + ch * 8); x[q] = *(const v4u*)(XB + (size_t)t * DM + ch * 8); } }
#pragma unroll
        for (int q = 0; q < 4; ++q) { const int it = it0 + q * stride; if (it < NIT) { const int t = it >> 7, ch = it & 127;
            float* op = out + (size_t)t * DM + ch * 8;
            f32x4 x0, x1;
            x0.x = bflo(x[q].x) + (bflo(a[q].x) + bflo(bq[q].x)); x0.y = bfhi(x[q].x) + (bfhi(a[q].x) + bfhi(bq[q].x)); x0.z = bflo(x[q].y) + (bflo(a[q].y) + bflo(bq[q].y)); x0.w = bfhi(x[q].y) + (bfhi(a[q].y) + bfhi(bq[q].y));
            x1.x = bflo(x[q].z) + (bflo(a[q].z) + bflo(bq[q].z)); x1.y = bfhi(x[q].z) + (bfhi(a[q].z) + bfhi(bq[q].z)); x1.z = bflo(x[q].w) + (bflo(a[q].w) + bflo(bq[q].w)); x1.w = bfhi(x[q].w) + (bfhi(a[q].w) + bfhi(bq[q].w));
            *(f32x4*)op = x0; *(f32x4*)(op + 4) = x1; } }
    }
}

#define NA_LOADQ(qptr) do { const uint4* q4_ = (const uint4*)(qptr); _Pragma("unroll") for (int c_ = 0; c_ < 8; ++c_) { const uint4 w_ = q4_[c_]; \
    q[8*c_+0] = bflo(w_.x); q[8*c_+1] = bfhi(w_.x); q[8*c_+2] = bflo(w_.y); q[8*c_+3] = bfhi(w_.y); q[8*c_+4] = bflo(w_.z); q[8*c_+5] = bfhi(w_.z); q[8*c_+6] = bflo(w_.w); q[8*c_+7] = bfhi(w_.w); } } while (0)
#define NA_DOT(x, kptr) do { const uint4* k4_ = (const uint4*)(kptr); float s0_ = 0.f, s1_ = 0.f; _Pragma("unroll") for (int c_ = 0; c_ < 8; ++c_) { const uint4 w_ = k4_[c_]; \
    s0_ += q[8*c_+0] * bflo(w_.x) + q[8*c_+2] * bflo(w_.y) + q[8*c_+4] * bflo(w_.z) + q[8*c_+6] * bflo(w_.w); \
    s1_ += q[8*c_+1] * bfhi(w_.x) + q[8*c_+3] * bfhi(w_.y) + q[8*c_+5] * bfhi(w_.z) + q[8*c_+7] * bfhi(w_.w); } x = s0_ + s1_; } while (0)
#define NA_UPD(x, vptr) do { if ((x) > mx) { const float f_ = exp2f(mx - (x)); l *= f_; _Pragma("unroll") for (int d_ = 0; d_ < 64; ++d_) o[d_] *= f_; mx = (x); } \
    const float p_ = exp2f((x) - mx); l += p_; const uint4* v4_ = (const uint4*)(vptr); _Pragma("unroll") for (int c_ = 0; c_ < 8; ++c_) { const uint4 w_ = v4_[c_]; \
    o[8*c_+0] += p_ * bflo(w_.x); o[8*c_+1] += p_ * bfhi(w_.x); o[8*c_+2] += p_ * bflo(w_.y); o[8*c_+3] += p_ * bfhi(w_.y); o[8*c_+4] += p_ * bflo(w_.z); o[8*c_+5] += p_ * bfhi(w_.z); o[8*c_+6] += p_ * bflo(w_.w); o[8*c_+7] += p_ * bfhi(w_.w); } } while (0)
#define NA_STORE(optr) do { const float il_ = 1.0f / l; uint4* o4_ = (uint4*)(optr); _Pragma("unroll") for (int c_ = 0; c_ < 8; ++c_) { uint4 w_; \
    w_.x = pk2(o[8*c_+0] * il_, o[8*c_+1] * il_); w_.y = pk2(o[8*c_+2] * il_, o[8*c_+3] * il_); w_.z = pk2(o[8*c_+4] * il_, o[8*c_+5] * il_); w_.w = pk2(o[8*c_+6] * il_, o[8*c_+7] * il_); o4_[c_] = w_; } } while (0)

__device__ __forceinline__ void phase_attn_naive(const bf16* Q, const bf16* K, const bf16* V, const float* fcum, const float* kmean, bf16* O, int tid, int wave) {
    for (int u = blockIdx.x; u < NB * 12 * 4; u += gridDim.x) {
        const int b = u / 48, h = (u / 4) % 12, ch = u % 4, t = ch * 512 + tid; const size_t m = (size_t)b * SEQ + t;
        float q[64], o[64], mx = -1e30f, l = 0.f;
#pragma unroll
        for (int d = 0; d < 64; ++d) o[d] = 0.f;
        NA_LOADQ(Q + m * QW + h * 64);
        const int smax = ch * 512 + wave * 64 + 63;
        const bf16* kb = K + (size_t)b * SEQ * QW + h * 64; const bf16* vb = V + (size_t)b * SEQ * QW + h * 64;
        if (h < 6) {
            const float* fc = fcum + ((size_t)b * 6 + h) * SEQ; const float fct = fc[t];
            for (int s = 0; s <= smax; ++s) {
                float x; NA_DOT(x, kb + (size_t)s * QW); x += fct - fc[s];
                if (s <= t) NA_UPD(x, vb + (size_t)s * QW);
            }
            NA_STORE(O + m * DM + h * 64);
        } else {
            const int hm = h - 6, qblk = t >> 8; const float slope = alibi_slope(8 + hm) * LOG2E;
            float gt[8];
#pragma unroll
            for (int j = 0; j < 8; ++j) { const float* km = kmean + (((size_t)b * 6 + hm) * 8 + j) * 64; float d = 0.f;
#pragma unroll
                for (int e = 0; e < 64; ++e) d += q[e] * km[e];
                gt[j] = d; }
            unsigned allowed = 1u << qblk;
#pragma unroll
            for (int j = 0; j < 8; ++j) { int rank = 0;
#pragma unroll
                for (int i = 0; i < 8; ++i) if (i < qblk && i != j && (gt[i] > gt[j] || (gt[i] == gt[j] && i < j))) ++rank;
                if (j < qblk && rank < 3) allowed |= 1u << j; }
            for (int s = 0; s <= smax; ++s) {
                float x; NA_DOT(x, kb + (size_t)s * QW); x -= slope * (float)(t - s);
                if (s <= t && ((allowed >> (s >> 8)) & 1u)) NA_UPD(x, vb + (size_t)s * QW);
            }
            NA_STORE(O + m * DM + 384 + hm * 64);
        }
    }
    for (int u = blockIdx.x; u < NB * 4 * 4; u += gridDim.x) {
        const int b = u / 16, slot = (u / 4) % 4, ch = u % 4, t = ch * 512 + tid; const size_t m = (size_t)b * SEQ + t;
        float q[64], o[64], mx = -1e30f, l = 0.f;
#pragma unroll
        for (int d = 0; d < 64; ++d) o[d] = 0.f;
#pragma unroll
        for (int g = 0; g < 3; ++g) {
            const int dil = (g == 0) ? 1 : (g == 1 ? 4 : 16), so = (g == 0) ? 0 : (g == 1 ? 4 : 14), head = 12 + 4 * g + slot;
            const float slope = alibi_slope(so + slot) * LOG2E;
            NA_LOADQ(Q + m * QW + head * 64);
            for (int j = 0; j <= 128; ++j) {
                const int s = t - j * dil;
                if (s >= 0) { const size_t kr = ((size_t)b * SEQ + s) * QW + head * 64; float x; NA_DOT(x, K + kr); x -= slope * (float)(j * dil); NA_UPD(x, V + kr); }
            }
        }
        NA_STORE(O + m * DM + 768 + slot * 64);
    }
}


namespace att {
typedef short bf16x8 __attribute__((ext_vector_type(8)));
typedef short s16x4 __attribute__((ext_vector_type(4)));
typedef float f32x16 __attribute__((ext_vector_type(16)));
typedef unsigned u32x4 __attribute__((ext_vector_type(4)));
typedef float f32x2_t __attribute__((ext_vector_type(2))); typedef __bf16 bf16x2_t __attribute__((ext_vector_type(2)));
constexpr int A_K = 0, A_V = 32768, A_BT = 57344, A_WSF = 65536, A_OST = 67584, A_KB = A_OST, A_Z = 100352, A_BYTES = 100368, SLOT = 8192;
constexpr float THRL = 8.0f;
__device__ __forceinline__ int crow(int r, int hi) { return (r & 3) + 8 * (r >> 2) + 4 * hi; }
__device__ __forceinline__ void glds16(const void* gsrc, unsigned lds_dst) { unsigned keep;
    asm volatile("s_mov_b32 %0, m0\n\ts_mov_b32 m0, %2\n\ts_nop 0\n\tglobal_load_lds_dwordx4 %1, off\n\ts_mov_b32 m0, %0" : "=&s"(keep) : "v"(gsrc), "s"(lds_dst) : "memory"); }
__device__ __forceinline__ void glds16s(const void* sbase, unsigned voff, unsigned lds_dst) { unsigned keep;
    asm volatile("s_mov_b32 %0, m0\n\ts_mov_b32 m0, %3\n\ts_nop 0\n\tglobal_load_lds_dwordx4 %1, %2\n\ts_mov_b32 m0, %0" : "=&s"(keep) : "v"(voff), "s"(sbase), "s"(lds_dst) : "memory"); }
__device__ __forceinline__ unsigned cvtpk(float lo, float hi) { f32x2_t v = {lo, hi}; bf16x2_t b = __builtin_convertvector(v, bf16x2_t); return __builtin_bit_cast(unsigned, b); }
__device__ __forceinline__ void qkt(f32x16& p0, f32x16& p1, const LAS char* Kslot, const bf16x8* qr, const f32x16& negm, int r32, int hi) {
    const LAS char* kb = Kslot + hi * 1024 + r32 * 16;
#pragma unroll
    for (int d0 = 0; d0 < 4; ++d0) {
        const bf16x8 b0 = *(const LAS bf16x8*)(kb + d0 * 2048);
        const bf16x8 b1 = *(const LAS bf16x8*)(kb + d0 * 2048 + 512);
        if (d0 == 0) { p0 = __builtin_amdgcn_mfma_f32_32x32x16_bf16(b0, qr[0], negm, 0, 0, 0); p1 = __builtin_amdgcn_mfma_f32_32x32x16_bf16(b1, qr[0], negm, 0, 0, 0); }
        else { p0 = __builtin_amdgcn_mfma_f32_32x32x16_bf16(b0, qr[d0], p0, 0, 0, 0); p1 = __builtin_amdgcn_mfma_f32_32x32x16_bf16(b1, qr[d0], p1, 0, 0, 0); }
    }
}
__device__ __forceinline__ void qkt0(f32x16& p0, f32x16& p1, const LAS char* Kslot, const bf16x8* qr, int r32, int hi) {
    const LAS char* kb = Kslot + hi * 1024 + r32 * 16; const f32x16 z = f32x16{};
#pragma unroll
    for (int d0 = 0; d0 < 4; ++d0) {
        const bf16x8 b0 = *(const LAS bf16x8*)(kb + d0 * 2048);
        const bf16x8 b1 = *(const LAS bf16x8*)(kb + d0 * 2048 + 512);
        if (d0 == 0) { p0 = __builtin_amdgcn_mfma_f32_32x32x16_bf16(b0, qr[0], z, 0, 0, 0); p1 = __builtin_amdgcn_mfma_f32_32x32x16_bf16(b1, qr[0], z, 0, 0, 0); }
        else { p0 = __builtin_amdgcn_mfma_f32_32x32x16_bf16(b0, qr[d0], p0, 0, 0, 0); p1 = __builtin_amdgcn_mfma_f32_32x32x16_bf16(b1, qr[d0], p1, 0, 0, 0); }
    }
}
__device__ __forceinline__ void pv(f32x16* o, int vb, bf16x8 pa0, bf16x8 pa1, bf16x8 pa2, bf16x8 pa3) {
#pragma unroll
    for (int d0 = 0; d0 < 2; ++d0) { s16x4 lo[4], hi[4];
#pragma unroll
        for (int ks = 0; ks < 4; ++ks) {
            asm volatile("ds_read_b64_tr_b16 %0,%1 offset:%c2" : "=&v"(lo[ks]) : "v"(vb), "i"(d0 * 4096 + ks * 1024) : "memory");
            asm volatile("ds_read_b64_tr_b16 %0,%1 offset:%c2" : "=&v"(hi[ks]) : "v"(vb), "i"(d0 * 4096 + ks * 1024 + 512) : "memory"); }
        asm volatile("s_waitcnt lgkmcnt(0)" ::: "memory"); __builtin_amdgcn_sched_barrier(0);
#define ATT_PK(k) (bf16x8){lo[k][0], lo[k][1], lo[k][2], lo[k][3], hi[k][0], hi[k][1], hi[k][2], hi[k][3]}
        o[d0] = __builtin_amdgcn_mfma_f32_32x32x16_bf16(pa0, ATT_PK(0), o[d0], 0, 0, 0);
        o[d0] = __builtin_amdgcn_mfma_f32_32x32x16_bf16(pa1, ATT_PK(1), o[d0], 0, 0, 0);
        o[d0] = __builtin_amdgcn_mfma_f32_32x32x16_bf16(pa2, ATT_PK(2), o[d0], 0, 0, 0);
        o[d0] = __builtin_amdgcn_mfma_f32_32x32x16_bf16(pa3, ATT_PK(3), o[d0], 0, 0, 0);
#undef ATT_PK
    }
}
#define ATT_SHFL(v, src) __builtin_bit_cast(float, __builtin_amdgcn_ds_bpermute((src) << 2, __builtin_bit_cast(int, (float)(v))))
#define ATT_BAR() asm volatile("s_waitcnt lgkmcnt(0)\n\ts_barrier" ::: "memory")
#define ATT_WAIT_BAR(N) asm volatile("s_waitcnt vmcnt(" #N ") lgkmcnt(0)\n\ts_barrier" ::: "memory")

template <int MODE, int SKEL = 0>
__device__ __forceinline__ void attn_unit(const bf16* Q, const bf16* K, const bf16* V, int b, int head, int d, int res, int n0, int kt0, int jlo, int jhi,
                                          const float* fc  , float slope2, const float* km  , int qb,
                                          bf16* O, int opitch, int ocol, float* lse_out  , LAS unsigned char* lds, int wid) {
    if (MODE != 2) { d = 1; res = 0; kt0 = 0; jlo = 0; }
    unsigned z_ = 0u; asm volatile("" : "+v"(z_));
    const int lane = __builtin_amdgcn_mbcnt_hi(~0u, __builtin_amdgcn_mbcnt_lo(~0u, z_)), r32 = lane & 31, hi = lane >> 5; const int tid_o = wid * 64 + lane;
    const int L = SEQ / d;
    const size_t tokbase = (size_t)b * SEQ;
    const unsigned lds0 = (unsigned)(size_t)lds;
    LAS float* BT = (LAS float*)(lds + A_BT);
    LAS float* wsf = (LAS float*)(lds + A_WSF) + wid * 64;
#define ATT_UNI64(p) ((const bf16*)(((unsigned long long)(unsigned)__builtin_amdgcn_readfirstlane((int)((unsigned long long)(p) >> 32)) << 32) | (unsigned long long)(unsigned)__builtin_amdgcn_readfirstlane((int)(unsigned)(unsigned long long)(p))))
    const bf16* Kh = ATT_UNI64(K + ((size_t)b * 24 + head) * SEQ * 64); const bf16* Vh = ATT_UNI64(V + ((size_t)b * 24 + head) * SEQ * 64);
#undef ATT_UNI64
    const unsigned kdst = lds0 + A_K + wid * 1024, vdst = lds0 + A_V + wid * 1024;
#define ATT_DMA_K(j, slot) glds16s(Kh, (unsigned)(lane * 128 + wid * 16) + (unsigned)(kt0 + 64 * (j)) * 128u, (unsigned)__builtin_amdgcn_readfirstlane(kdst + (slot) * SLOT))
#define ATT_DMA_V(j, slot) do { int lq_ = lane; asm volatile("" : "+v"(lq_));     \
        glds16s(Vh, (unsigned)(((16 * (wid & 3) + (lq_ >> 2)) * 64 + (wid >> 2) * 32 + (lq_ & 3) * 8) * 2) + (unsigned)(kt0 + 64 * (j)) * 128u, (unsigned)__builtin_amdgcn_readfirstlane(vdst + (slot) * SLOT)); } while (0)
    ATT_DMA_K(jlo, 0); if (jlo + 1 < jhi) ATT_DMA_K(jlo + 1, 1); ATT_DMA_V(jlo, 0);
    const int nq = n0 + wid * 32 + r32;
    const bool wactive = (n0 + wid * 32) < L;
    bf16x8 qr[4];
    { const bf16* qp = Q + (tokbase + (size_t)(wactive ? nq : n0) * d + res) * QW + head * 64 + hi * 8;
#pragma unroll
      for (int d0 = 0; d0 < 4; ++d0) qr[d0] = *(const bf16x8*)(qp + d0 * 16); }
    f32x4 fca = {0.f, 0.f, 0.f, 0.f}; float kmv = 0.f;
    { const int kmax_ = (n0 + 256 < L) ? n0 + 256 : L;
      if (MODE == 0) { if (4 * tid_o < kmax_) fca = *(const f32x4*)(fc + 4 * tid_o); }
      if (MODE == 1) kmv = km[tid_o]; }
    { const int kmax = (n0 + 256 < L) ? n0 + 256 : L;
      if (MODE == 0) {
          LAS float* wtot = (LAS float*)(lds + A_WSF);
          f32x4 a = fca;
          a.y += a.x; a.z += a.y; a.w += a.z;
          float incl = a.w;
#pragma unroll
          for (int o_ = 1; o_ < 64; o_ <<= 1) { const float t_ = ATT_SHFL(incl, (lane - o_) & 63); if (lane >= o_) incl += t_; }
          if (lane == 63) wtot[wid] = incl;
          ATT_BAR();
          float base = incl - a.w;
          for (int w_ = 0; w_ < wid; ++w_) base += wtot[w_];
          if (4 * tid_o < kmax) *(LAS f32x4*)(BT + 4 * tid_o) = (f32x4){-(a.x + base), -(a.y + base), -(a.z + base), -(a.w + base)};
      } else { for (int k = tid_o; k < kmax; k += NTHR) BT[k] = slope2 * (float)(k * d); } }
    unsigned allowed = 0xffu;
    if (MODE == 1) {
        LAS float* kml = (LAS float*)(lds + A_WSF);
        kml[tid_o] = kmv;
        ATT_BAR();
        float gt[8];
#pragma unroll
        for (int j = 0; j < 8; ++j) { float s = 0.f;
#pragma unroll
            for (int d0 = 0; d0 < 4; ++d0) { const f32x4 k0 = *(const LAS f32x4*)(kml + j * 64 + d0 * 16 + hi * 8), k1 = *(const LAS f32x4*)(kml + j * 64 + d0 * 16 + hi * 8 + 4);
                const u32x4 qw = __builtin_bit_cast(u32x4, qr[d0]);
                s += bflo(qw.x) * k0.x + bfhi(qw.x) * k0.y + bflo(qw.y) * k0.z + bfhi(qw.y) * k0.w + bflo(qw.z) * k1.x + bfhi(qw.z) * k1.y + bflo(qw.w) * k1.z + bfhi(qw.w) * k1.w; }
            s += ATT_SHFL(s, lane ^ 32); gt[j] = s; }
        allowed = 1u << qb;
#pragma unroll
        for (int j = 0; j < 8; ++j) { int rank = 0;
#pragma unroll
            for (int i = 0; i < 8; ++i) if (i < qb && i != j && (gt[i] > gt[j] || (gt[i] == gt[j] && i < j))) ++rank;
            if (j < qb && rank < 3) allowed |= 1u << j; }
    }
    { ATT_BAR();
      const int kmax = (n0 + 256 < L) ? n0 + 256 : L;
      for (int k = tid_o; k < kmax; k += NTHR) { const float bv = BT[k]; const unsigned h16 = f2bf(bv); const unsigned l16 = f2bf(bv - __builtin_bit_cast(float, h16 << 16));
          unsigned one2_ = 0x3F803F80u, z1_ = 0u; asm volatile("" : "+v"(one2_), "+v"(z1_)); *(LAS u32x4*)(lds + A_KB + k * 16) = (u32x4){h16 | (l16 << 16), one2_, z1_, z1_}; }
      if (tid_o == 0) { unsigned z0_ = 0u; asm volatile("" : "+v"(z0_)); *(LAS u32x4*)(lds + A_Z) = (u32x4){z0_, z0_, z0_, z0_}; } }
#define ATT_QX() do { const bool inf_ = !(msub < 3.0e38f); const unsigned mh_ = f2bf(inf_ ? 0.f : msub), ml_ = f2bf(inf_ ? 0.f : msub - __builtin_bit_cast(float, mh_ << 16)); \
        const unsigned w1_ = inf_ ? 0x0000FF80u : (((mh_ ^ 0x8000u) & 0xFFFFu) | ((ml_ ^ 0x8000u) << 16));     \
        unsigned zq_ = 0u; asm volatile("" : "+v"(zq_)); const u32x4 qv_ = {(hi == 0) ? 0x3F803F80u : zq_, (hi == 0) ? w1_ : zq_, zq_, zq_}; qx = __builtin_bit_cast(bf16x8, qv_); } while (0)
    float msub = 0.f, l_reg = 0.f; f32x16 o[2]; o[0] = f32x16{}; o[1] = f32x16{};
    const LAS char* vp0 = (const LAS char*)(lds + A_V) + ((lane >> 4) & 1) * 32 + (lane & 3) * 8 + (4 * hi + ((lane & 15) >> 2)) * 64;
    const int nmin = n0 + wid * 32, nmax = nmin + 31;
    int ja = jlo, jb = jhi - 1;
    { const int jd = (nmax - kt0) >> 6; if (jd < jb) jb = jd;
      if (MODE == 2) { const int jf = (nmin - 128 - kt0) >> 6; if (jf > ja) ja = jf; }
      if (!wactive) { ja = jhi; jb = jlo - 1; } }
#define ATT_BIAS(C0, C1, KB) do { \
        _Pragma("unroll") for (int i_ = 0; i_ < 4; ++i_) { const f32x4 b0_ = *(const LAS f32x4*)(BT + (KB) + 4 * hi + 8 * i_), b1_ = *(const LAS f32x4*)(BT + (KB) + 32 + 4 * hi + 8 * i_); \
            _Pragma("unroll") for (int e_ = 0; e_ < 4; ++e_) { C0[4 * i_ + e_] += b0_[e_] - msub; C1[4 * i_ + e_] += b1_[e_] - msub; } } } while (0)
#define ATT_MASK(C0, C1, KB) do { \
        _Pragma("unroll") for (int r_ = 0; r_ < 16; ++r_) { const int kv_ = (KB) + crow(r_, hi); if (kv_ > nq) C0[r_] = -INFINITY; if (kv_ + 32 > nq) C1[r_] = -INFINITY; } \
        if (MODE == 2) { _Pragma("unroll") for (int r_ = 0; r_ < 16; ++r_) { const int kv_ = (KB) + crow(r_, hi); if (nq - kv_ > 128) C0[r_] = -INFINITY; if (nq - kv_ - 32 > 128) C1[r_] = -INFINITY; } } } while (0)
#define ATT_ROWMAX(RM, C0, C1) do { float a_ = fmaxf(fmaxf(C0[0], C0[1]), C1[0]), b_ = fmaxf(fmaxf(C0[2], C0[3]), C1[1]); a_ = fmaxf(fmaxf(a_, C1[2]), C1[3]); \
        _Pragma("unroll") for (int r_ = 4; r_ < 16; r_ += 4) { a_ = fmaxf(fmaxf(a_, C0[r_]), C0[r_ + 1]); b_ = fmaxf(fmaxf(b_, C0[r_ + 2]), C0[r_ + 3]); a_ = fmaxf(fmaxf(a_, C1[r_]), C1[r_ + 1]); b_ = fmaxf(fmaxf(b_, C1[r_ + 2]), C1[r_ + 3]); } \
        RM = fmaxf(a_, b_); { auto rr_ = __builtin_amdgcn_permlane32_swap(__float_as_uint(RM), __float_as_uint(RM), false, false); RM = fmaxf(__uint_as_float(rr_[0]), __uint_as_float(rr_[1])); } } while (0)
#define ATT_RESC(RM, C0, C1) do { if (__any((RM) > THRL)) { const float dl_ = fmaxf((RM), 0.f); msub += dl_; \
        _Pragma("unroll") for (int r_ = 0; r_ < 16; ++r_) { C0[r_] -= dl_; C1[r_] -= dl_; } \
        const float f_ = __builtin_amdgcn_exp2f(-dl_); l_reg *= f_; if (hi == 0) wsf[r32] = f_; \
        asm volatile("s_waitcnt lgkmcnt(0)" ::: "memory"); \
        _Pragma("unroll") for (int r_ = 0; r_ < 16; ++r_) { const float fr_ = wsf[crow(r_, hi)]; o[0][r_] *= fr_; o[1][r_] *= fr_; } } } while (0)
#define ATT_VTR(p) __builtin_bit_cast(s16x4, __builtin_amdgcn_ds_read_tr16_b64_v4i16((LAS v4i16_t*)(p)))
    typedef short v4i16_t __attribute__((ext_vector_type(4)));
    f32x16 c0 = f32x16{}, c1 = f32x16{};
    bool blk_ok = true;
#define ATT_EXP_PACK() \
            float sacc = 0.f; \
            _Pragma("unroll") for (int r = 0; r < 16; ++r) { c0[r] = __builtin_amdgcn_exp2f(c0[r]); c1[r] = __builtin_amdgcn_exp2f(c1[r]); sacc += c0[r] + c1[r]; } \
            l_reg += sacc; \
            const u32x4 pw0 = {cvtpk(c0[0], c0[1]), cvtpk(c0[2], c0[3]), cvtpk(c0[4], c0[5]), cvtpk(c0[6], c0[7])}; \
            const u32x4 pw1 = {cvtpk(c0[8], c0[9]), cvtpk(c0[10], c0[11]), cvtpk(c0[12], c0[13]), cvtpk(c0[14], c0[15])}; \
            const u32x4 pw2 = {cvtpk(c1[0], c1[1]), cvtpk(c1[2], c1[3]), cvtpk(c1[4], c1[5]), cvtpk(c1[6], c1[7])}; \
            const u32x4 pw3 = {cvtpk(c1[8], c1[9]), cvtpk(c1[10], c1[11]), cvtpk(c1[12], c1[13]), cvtpk(c1[14], c1[15])};
#define ATT_KFP(KN_, g) (*(const LAS bf16x8*)((KN_) + hi * 1024 + r32 * 16 + ((g) >> 1) * 2048 + ((g) & 1) * 512))
#define ATT_CEP(A0, A1, idx) (((idx) < 16) ? A0[(idx) & 15] : A1[(idx) & 15])
#define ATT_FUSED_P(MASKED, C0, C1, N0, N1, KN_, VP_, KBN_) do { \
            u32x4 pw[4]; \
            bf16x8 kf[8]; kf[0] = ATT_KFP(KN_, 0); kf[1] = ATT_KFP(KN_, 1); \
            _Pragma("unroll") for (int g = 0; g < 8; ++g) { \
                if (g + 2 < 8) kf[g + 2] = ATT_KFP(KN_, g + 2); \
                float e0_ = ATT_CEP(C0, C1, 4 * g), e1_ = ATT_CEP(C0, C1, 4 * g + 1), e2_ = ATT_CEP(C0, C1, 4 * g + 2), e3_ = ATT_CEP(C0, C1, 4 * g + 3); \
                if (SKEL != 2) { e0_ = __builtin_amdgcn_exp2f(e0_); e1_ = __builtin_amdgcn_exp2f(e1_); e2_ = __builtin_amdgcn_exp2f(e2_); e3_ = __builtin_amdgcn_exp2f(e3_); }     \
                if (SKEL == 4) { if (g == 0) N0 = C0; if (g == 1) N1 = C1; } else \
                if (g == 0) N0 = __builtin_amdgcn_mfma_f32_32x32x16_bf16(kf[g], qr[0], f32x16{}, 0, 0, 0); else if (g == 1) N1 = __builtin_amdgcn_mfma_f32_32x32x16_bf16(kf[g], qr[0], f32x16{}, 0, 0, 0); \
                else if (g & 1) N1 = __builtin_amdgcn_mfma_f32_32x32x16_bf16(kf[g], qr[g >> 1], N1, 0, 0, 0); else N0 = __builtin_amdgcn_mfma_f32_32x32x16_bf16(kf[g], qr[g >> 1], N0, 0, 0, 0); \
                asm volatile("" : "+v"(e0_), "+v"(e1_), "+v"(e2_), "+v"(e3_));     \
                l_reg += (e0_ + e1_) + (e2_ + e3_);     \
                pw[g >> 1][2 * (g & 1)] = cvtpk(e0_, e1_); pw[g >> 1][2 * (g & 1) + 1] = cvtpk(e2_, e3_); \
                asm volatile("" : "+v"(l_reg)); \
                __builtin_amdgcn_sched_barrier(0); } \
            { bf16x8 qx; ATT_QX(); const LAS char* kx_ = hi ? (const LAS char*)(lds + A_Z) : (const LAS char*)(lds + A_KB) + ((KBN_) + r32) * 16; const bf16x8 kx0_ = *(const LAS bf16x8*)kx_, kx1_ = *(const LAS bf16x8*)(kx_ + (hi ? 0 : 512)); \
              N0 = __builtin_amdgcn_mfma_f32_32x32x16_bf16(kx0_, qx, N0, 0, 0, 0); N1 = __builtin_amdgcn_mfma_f32_32x32x16_bf16(kx1_, qx, N1, 0, 0, 0); }     \
            s16x4 vl[8], vh[8]; vl[0] = ATT_VTR(VP_); vh[0] = ATT_VTR(VP_ + 512); vl[1] = ATT_VTR(VP_ + 4096); vh[1] = ATT_VTR(VP_ + 4096 + 512); \
            _Pragma("unroll") for (int g = 0; g < 8; ++g) { \
                if (g + 2 < 8) { vl[g + 2] = ATT_VTR(VP_ + ((g + 2) & 1) * 4096 + ((g + 2) >> 1) * 1024); vh[g + 2] = ATT_VTR(VP_ + ((g + 2) & 1) * 4096 + ((g + 2) >> 1) * 1024 + 512); } \
                if (SKEL != 3) o[g & 1] = __builtin_amdgcn_mfma_f32_32x32x16_bf16(__builtin_bit_cast(bf16x8, pw[g >> 1]), (bf16x8){vl[g][0], vl[g][1], vl[g][2], vl[g][3], vh[g][0], vh[g][1], vh[g][2], vh[g][3]}, o[g & 1], 0, 0, 0);     \
                if (MASKED) _Pragma("unroll") for (int e = 0; e < 4; ++e) { const int ix = 4 * g + e; float x = (ix < 16) ? N0[ix & 15] : N1[ix & 15]; \
                    { const int kv_ = KBN_ + ((g >= 4) ? 32 : 0) + crow(ix & 15, hi); if (kv_ > nq) x = -INFINITY; if (MODE == 2) { if (nq - kv_ > 128) x = -INFINITY; } } \
                    if (ix < 16) N0[ix & 15] = x; else N1[ix & 15] = x; \
                    } \
                if (MASKED) { if (g < 3) asm volatile("" : "+v"(o[g & 1]), "+v"(N0[(4 * g + 4) & 15]), "+v"(N0[(4 * g + 5) & 15]), "+v"(N0[(4 * g + 6) & 15]), "+v"(N0[(4 * g + 7) & 15])); \
                              else if (g < 7) asm volatile("" : "+v"(o[g & 1]), "+v"(N1[(4 * g + 4) & 15]), "+v"(N1[(4 * g + 5) & 15]), "+v"(N1[(4 * g + 6) & 15]), "+v"(N1[(4 * g + 7) & 15])); }     \
                __builtin_amdgcn_sched_barrier(0); } \
            float rm = -1.0f; asm volatile("" : "+v"(rm));     \
            ATT_RESC(rm, N0, N1); \
            } while (0)
    bool ref_set = false;
    f32x16 d0_ = f32x16{}, d1_ = f32x16{};
#define ATT_SYNC(j) do { const int fly_ = ((j) >= jlo) ? (((j) + 2 < jhi) ? 1 : 0) + (((j) + 1 < jhi) ? 1 : 0) : ((jlo + 1 < jhi) ? 2 : 1); \
        if (fly_ == 2) { ATT_WAIT_BAR(2); } else if (fly_ == 1) { ATT_WAIT_BAR(1); } else { ATT_WAIT_BAR(0); } \
        if ((j) + 3 < jhi) ATT_DMA_K((j) + 3, ((j) + 3 - jlo) & 3); \
        if ((j) + 2 < jhi) ATT_DMA_V((j) + 2, ((j) + 2 - jlo) % 3); \
        if (!ref_set) { ref_set = true; if (wactive) msub = BT[nq]; } \
        if (MODE == 1) { const int kb_ = kt0 + 64 * ((j) + 1); if (((j) + 1 >= ja) && ((j) + 1 <= jb) && (kb_ & 255) == 0) { blk_ok = (allowed >> (kb_ >> 8)) & 1u; msub = blk_ok ? BT[nq] : INFINITY; } } } while (0)
#define ATT_KN(j) ((const LAS char*)(lds + A_K + (((j) + 1 - jlo) & 3) * SLOT))
#define ATT_VP(j) (vp0 + (((j) - jlo + 3) % 3) * SLOT)
#define ATT_MASKED(j) (((kt0 + 64 * ((j) + 1) + 63) > nmin) || (MODE == 2 && (kt0 + 64 * ((j) + 1)) < nmax - 128))
#define ATT_DOA(j) (((j) + 1 >= ja) && ((j) + 1 <= jb))
#define ATT_DOP(j) (((j) >= ja) && ((j) <= jb))
    asm volatile("" : "+v"(qr[0]), "+v"(qr[1]), "+v"(qr[2]), "+v"(qr[3]));
    int j = jlo - 1;
#pragma nounroll
    while (j < jhi) {
        ATT_SYNC(j);
        const bool doA = ATT_DOA(j), doP = ATT_DOP(j), masked = ATT_MASKED(j);
        const int kbn = kt0 + 64 * (j + 1);
        const LAS char* Kn = ATT_KN(j);
        const LAS char* vp = ATT_VP(j);
        if (SKEL == 1) { ++j; }
        else if (doP && doA && !masked && (j + 1 < jhi) && ATT_DOA(j + 1) && !ATT_MASKED(j + 1)) {
            ATT_FUSED_P(false, c0, c1, d0_, d1_, Kn, vp, kbn);
            ATT_SYNC(j + 1);
            ATT_FUSED_P(false, d0_, d1_, c0, c1, ATT_KN(j + 1), ATT_VP(j + 1), (kbn + 64));
            j += 2;
        } else {
            if (doP && doA) { if (masked) { ATT_FUSED_P(true, c0, c1, d0_, d1_, Kn, vp, kbn); } else { ATT_FUSED_P(false, c0, c1, d0_, d1_, Kn, vp, kbn); } c0 = d0_; c1 = d1_; }
            else if (doA) {
                f32x16 n0_, n1_; qkt0(n0_, n1_, Kn, qr, r32, hi);
                ATT_BIAS(n0_, n1_, kbn); if (masked) ATT_MASK(n0_, n1_, kbn);
                c0 = n0_; c1 = n1_;
            } else if (doP) {
                ATT_EXP_PACK()
                pv(o, (int)(lds0 + A_V) + ((lane >> 4) & 1) * 32 + (lane & 3) * 8 + (4 * hi + ((lane & 15) >> 2)) * 64 + ((j - jlo + 3) % 3) * SLOT,
                   __builtin_bit_cast(bf16x8, pw0), __builtin_bit_cast(bf16x8, pw1), __builtin_bit_cast(bf16x8, pw2), __builtin_bit_cast(bf16x8, pw3));
            }
            ++j;
        }
    }
#undef ATT_SYNC
#undef ATT_QX
#undef ATT_KN
#undef ATT_VP
#undef ATT_MASKED
#undef ATT_DOA
#undef ATT_DOP
#undef ATT_FUSED_P
#undef ATT_KFP
#undef ATT_CEP
#undef ATT_EXP_PACK
#undef ATT_BIAS
#undef ATT_MASK
    ATT_BAR();
#undef ATT_ROWMAX
#undef ATT_RESC
#undef ATT_VTR
    if (wactive && SKEL == 0) {
        unsigned z2_ = 0u; asm volatile("" : "+v"(z2_));
        const int lane2 = __builtin_amdgcn_mbcnt_hi(~0u, __builtin_amdgcn_mbcnt_lo(~0u, z2_)), r2 = lane2 & 31, h2 = lane2 >> 5;
        l_reg += ATT_SHFL(l_reg, lane2 ^ 32);
        LAS float* wsf2 = (LAS float*)(lds + A_WSF) + wid * 64;
        int b2_ = b; asm volatile("" : "+s"(b2_)); const size_t tb2_ = (size_t)b2_ * SEQ;
        if (h2 == 0) wsf2[32 + r2] = l_reg;
        if (MODE == 2) { if (h2 == 0) lse_out[(tokbase + (size_t)nq * d + res) * 4] = __builtin_amdgcn_logf(l_reg); }
        asm volatile("s_waitcnt lgkmcnt(0)" ::: "memory");
        LAS unsigned short* stl = (LAS unsigned short*)(lds + A_OST) + wid * 2048;
#pragma unroll
        for (int r = 0; r < 16; ++r) { const int orow = crow(r, h2); const float rl = __builtin_amdgcn_rcpf(wsf2[32 + orow]);
#pragma unroll
            for (int d0 = 0; d0 < 2; ++d0) stl[orow * 64 + d0 * 32 + r2] = (unsigned short)f2bf(o[d0][r] * rl); }
        asm volatile("s_waitcnt lgkmcnt(0)" ::: "memory");
#pragma unroll
        for (int i = 0; i < 4; ++i) { const int row = i * 8 + (lane2 >> 3), ch = lane2 & 7; const u32x4 v = *(const LAS u32x4*)(stl + row * 64 + ch * 8);
            *(u32x4*)(O + (tb2_ + (size_t)(n0 + wid * 32 + row) * d + res) * opitch + ocol + ch * 8) = v; }
    }
#undef ATT_DMA_K
#undef ATT_DMA_V
}

__device__ __forceinline__ void dil_merge_tokens(bf16* O, const bf16* OG1, const bf16* OG2, const float* lse, int tid, int m_lo) {
#pragma unroll
    for (int trip = 0; trip < 2; ++trip) {
        v4u a[2], bq[2], c[2]; float l0[2], l1[2], l2[2];
#pragma unroll
        for (int q = 0; q < 2; ++q) { const int it = tid + NTHR * (2 * trip + q); const int m = m_lo + (it >> 5), ch = it & 31, slot = ch >> 3;
            l0[q] = lse[(size_t)m * 4 + slot]; l1[q] = lse[(size_t)(M + m) * 4 + slot]; l2[q] = lse[(size_t)(2 * M + m) * 4 + slot];
            a[q] = *(const v4u*)(O + (size_t)m * DM + 768 + ch * 8); bq[q] = *(const v4u*)(OG1 + (size_t)m * DILW + ch * 8); c[q] = *(const v4u*)(OG2 + (size_t)m * DILW + ch * 8); }
#pragma unroll
        for (int q = 0; q < 2; ++q) { const int it = tid + NTHR * (2 * trip + q); const int m = m_lo + (it >> 5), ch = it & 31;
            const float mx = fmaxf(l0[q], fmaxf(l1[q], l2[q])); float w0 = exp2f(l0[q] - mx), w1 = exp2f(l1[q] - mx), w2 = exp2f(l2[q] - mx); const float inv = 1.0f / (w0 + w1 + w2); w0 *= inv; w1 *= inv; w2 *= inv;
            v4u o;
            o.x = pk2(w0 * bflo(a[q].x) + w1 * bflo(bq[q].x) + w2 * bflo(c[q].x), w0 * bfhi(a[q].x) + w1 * bfhi(bq[q].x) + w2 * bfhi(c[q].x));
            o.y = pk2(w0 * bflo(a[q].y) + w1 * bflo(bq[q].y) + w2 * bflo(c[q].y), w0 * bfhi(a[q].y) + w1 * bfhi(bq[q].y) + w2 * bfhi(c[q].y));
            o.z = pk2(w0 * bflo(a[q].z) + w1 * bflo(bq[q].z) + w2 * bflo(c[q].z), w0 * bfhi(a[q].z) + w1 * bfhi(bq[q].z) + w2 * bfhi(c[q].z));
            o.w = pk2(w0 * bflo(a[q].w) + w1 * bflo(bq[q].w) + w2 * bflo(c[q].w), w0 * bfhi(a[q].w) + w1 * bfhi(bq[q].w) + w2 * bfhi(c[q].w));
            *(v4u*)(O + (size_t)m * DM + 768 + ch * 8) = o; }
    }
}
__device__ __forceinline__ void wdil_unit(GAS unsigned char* ws, LAS unsigned char* lds, int wid, int w) {
    unsigned z_ = 0u; asm volatile("" : "+v"(z_));
    const int lane = __builtin_amdgcn_mbcnt_hi(~0u, __builtin_amdgcn_mbcnt_lo(~0u, z_)), r32 = lane & 31, hi = lane >> 5;
    const int g = w >> 11, v = w & 2047;
    int b, slot, res, rb, d, head, si, opitch, ocol; bf16* O; float* lse_out;
    if (g == 0) { b = v >> 8; slot = (v >> 6) & 3; res = 0; rb = v & 63; d = 1; head = 12 + slot; si = slot; O = (bf16*)(ws + WS_O); opitch = DM; ocol = 768 + slot * 64; lse_out = (float*)(ws + WS_LSE) + slot; }
    else if (g == 1) { b = v >> 8; slot = (v >> 6) & 3; res = (v >> 4) & 3; rb = v & 15; d = 4; head = 16 + slot; si = 4 + slot; O = (bf16*)(ws + WS_OG1); opitch = DILW; ocol = slot * 64; lse_out = (float*)(ws + WS_LSE) + (size_t)M * 4 + slot; }
    else { b = v >> 8; slot = (v >> 6) & 3; res = (v >> 2) & 15; rb = v & 3; d = 16; head = 20 + slot; si = 14 + slot; O = (bf16*)(ws + WS_OG2); opitch = DILW; ocol = slot * 64; lse_out = (float*)(ws + WS_LSE) + (size_t)2 * M * 4 + slot; }
    const float slope2 = alibi_slope(si) * LOG2E * (float)d;
    const size_t tokbase = (size_t)b * SEQ;
    const bf16* Q = (const bf16*)(ws + WS_Q);
    const char* Kb = (const char*)((const bf16*)(ws + WS_K) + (((size_t)b * 24 + head) * SEQ + (size_t)res * (SEQ / d)) * 64);
    const char* Vb = (const char*)((const bf16*)(ws + WS_V) + (((size_t)b * 24 + head) * SEQ + (size_t)res * (SEQ / d)) * 64);
    const unsigned rstride = 64 * 2;
    const int nq = 32 * rb + r32;
    const int k0 = (32 * rb - 128 > 0) ? 32 * rb - 128 : 0, nt = (32 * rb + 32 - k0 + 63) >> 6;
    LAS unsigned char* mine = lds + wid * 16384;
    const unsigned vdst = (unsigned)(size_t)mine;
    bf16x8 qr[4];
    { const bf16* qp = Q + (tokbase + (size_t)nq * d + res) * QW + head * 64 + hi * 8;
#pragma unroll
      for (int d0 = 0; d0 < 4; ++d0) qr[d0] = *(const bf16x8*)(qp + d0 * 16); }
    const unsigned koff0 = (unsigned)(k0 + r32) * rstride + hi * 16;
    const unsigned voff0 = (unsigned)(k0 + (lane >> 2)) * rstride + (lane & 3) * 16;
#define WD_H2(kb) ((kb) + 32 <= 32 * rb + 31)
#define WD_LDK(t_, h2_) do { const unsigned ko_ = koff0 + (unsigned)(t_) * 64u * rstride; \
        _Pragma("unroll") for (int g_ = 0; g_ < 8; g_ += 2) kf[g_] = *(const bf16x8*)(Kb + (size_t)(ko_ + (g_ >> 1) * 32)); \
        if (h2_) { const unsigned k2_ = ko_ + 32u * rstride; _Pragma("unroll") for (int g_ = 1; g_ < 8; g_ += 2) kf[g_] = *(const bf16x8*)(Kb + (size_t)(k2_ + (g_ >> 1) * 32)); } } while (0)
#define WD_DMAV(t_, sl, h2_) do { const unsigned vo_ = voff0 + (unsigned)(t_) * 64u * rstride; \
        _Pragma("unroll") for (int p_ = 0; p_ < 8; ++p_) if ((p_ & 2) == 0 || (h2_)) \
            glds16s(Vb, vo_ + (unsigned)(16 * (p_ & 3)) * rstride + (p_ >> 2) * 64, (unsigned)__builtin_amdgcn_readfirstlane(vdst + (sl) * 8192 + p_ * 1024)); } while (0)
    bf16x8 kf[8];
#pragma unroll
    for (int g_ = 0; g_ < 8; ++g_) kf[g_] = qr[0];
    { const bool h2 = WD_H2(k0); WD_DMAV(0, 0, h2); WD_LDK(0, h2); }
    float l_reg = 0.f; f32x16 o[2]; o[0] = f32x16{}; o[1] = f32x16{};
    const int vlane = ((lane >> 4) & 1) * 32 + (lane & 3) * 8 + (4 * hi + ((lane & 15) >> 2)) * 64;
    const float s32 = slope2 * 32.0f;
#pragma nounroll
    for (int t = 0; t < nt; ++t) {
        const int kb = k0 + 64 * t; const bool h2 = WD_H2(kb);
        f32x16 c0, c1 = f32x16{};
        c0 = __builtin_amdgcn_mfma_f32_32x32x16_bf16(kf[0], qr[0], f32x16{}, 0, 0, 0);
#pragma unroll
        for (int d0 = 1; d0 < 4; ++d0) c0 = __builtin_amdgcn_mfma_f32_32x32x16_bf16(kf[2 * d0], qr[d0], c0, 0, 0, 0);
        if (h2) {
#pragma unroll
            for (int d0 = 0; d0 < 4; ++d0) c1 = __builtin_amdgcn_mfma_f32_32x32x16_bf16(kf[2 * d0 + 1], qr[d0], c1, 0, 0, 0); }
        if (t + 1 < nt) { asm volatile("" : "+v"(c0), "+v"(c1)); const bool n2 = WD_H2(kb + 64); WD_DMAV(t + 1, (t + 1) & 1, n2); WD_LDK(t + 1, n2); }
        const int dk = kb - nq + 4 * hi; const float fdk = slope2 * (float)dk;
        const bool mcaus = (kb + (h2 ? 63 : 31)) > 32 * rb, mwin = kb < 32 * rb + 31 - 128;
        if (mcaus || mwin) {
#pragma unroll
            for (int r = 0; r < 16; ++r) { const int cr = (r & 3) + 8 * (r >> 2); const float tb = fdk + slope2 * (float)cr;
                float x0 = c0[r] + tb, x1 = c1[r] + (tb + s32);
                const int q0 = dk + cr, q1 = q0 + 32;
                if (q0 > 0 || q0 < -128) x0 = -INFINITY; if (q1 > 0 || q1 < -128) x1 = -INFINITY;
                c0[r] = x0; c1[r] = x1; }
        } else {
#pragma unroll
            for (int r = 0; r < 16; ++r) { const int cr = (r & 3) + 8 * (r >> 2); const float tb = fdk + slope2 * (float)cr; c0[r] += tb; c1[r] += tb + s32; }
        }
        const int vb = (int)vdst + (t & 1) * 8192 + vlane;
        if (h2) {
            float sacc = 0.f;
#pragma unroll
            for (int r = 0; r < 16; ++r) { c0[r] = __builtin_amdgcn_exp2f(c0[r]); c1[r] = __builtin_amdgcn_exp2f(c1[r]); sacc += c0[r] + c1[r]; }
            l_reg += sacc;
            const u32x4 pw0 = {cvtpk(c0[0], c0[1]), cvtpk(c0[2], c0[3]), cvtpk(c0[4], c0[5]), cvtpk(c0[6], c0[7])};
            const u32x4 pw1 = {cvtpk(c0[8], c0[9]), cvtpk(c0[10], c0[11]), cvtpk(c0[12], c0[13]), cvtpk(c0[14], c0[15])};
            const u32x4 pw2 = {cvtpk(c1[0], c1[1]), cvtpk(c1[2], c1[3]), cvtpk(c1[4], c1[5]), cvtpk(c1[6], c1[7])};
            const u32x4 pw3 = {cvtpk(c1[8], c1[9]), cvtpk(c1[10], c1[11]), cvtpk(c1[12], c1[13]), cvtpk(c1[14], c1[15])};
            pv(o, vb, __builtin_bit_cast(bf16x8, pw0), __builtin_bit_cast(bf16x8, pw1), __builtin_bit_cast(bf16x8, pw2), __builtin_bit_cast(bf16x8, pw3));
        } else {
            float sacc = 0.f;
#pragma unroll
            for (int r = 0; r < 16; ++r) { c0[r] = __builtin_amdgcn_exp2f(c0[r]); sacc += c0[r]; }
            l_reg += sacc;
            const u32x4 pw0 = {cvtpk(c0[0], c0[1]), cvtpk(c0[2], c0[3]), cvtpk(c0[4], c0[5]), cvtpk(c0[6], c0[7])};
            const u32x4 pw1 = {cvtpk(c0[8], c0[9]), cvtpk(c0[10], c0[11]), cvtpk(c0[12], c0[13]), cvtpk(c0[14], c0[15])};
#pragma unroll
            for (int d0 = 0; d0 < 2; ++d0) { s16x4 lo[2], hh[2];
#pragma unroll
                for (int ks = 0; ks < 2; ++ks) {
                    asm volatile("ds_read_b64_tr_b16 %0,%1 offset:%c2" : "=&v"(lo[ks]) : "v"(vb), "i"(d0 * 4096 + ks * 1024) : "memory");
                    asm volatile("ds_read_b64_tr_b16 %0,%1 offset:%c2" : "=&v"(hh[ks]) : "v"(vb), "i"(d0 * 4096 + ks * 1024 + 512) : "memory"); }
                asm volatile("s_waitcnt lgkmcnt(0)" ::: "memory"); __builtin_amdgcn_sched_barrier(0);
                o[d0] = __builtin_amdgcn_mfma_f32_32x32x16_bf16(__builtin_bit_cast(bf16x8, pw0), (bf16x8){lo[0][0], lo[0][1], lo[0][2], lo[0][3], hh[0][0], hh[0][1], hh[0][2], hh[0][3]}, o[d0], 0, 0, 0);
                o[d0] = __builtin_amdgcn_mfma_f32_32x32x16_bf16(__builtin_bit_cast(bf16x8, pw1), (bf16x8){lo[1][0], lo[1][1], lo[1][2], lo[1][3], hh[1][0], hh[1][1], hh[1][2], hh[1][3]}, o[d0], 0, 0, 0);
            }
        }
    }
#undef WD_H2
#undef WD_LDK
#undef WD_DMAV
    asm volatile("s_waitcnt vmcnt(0) lgkmcnt(0)" ::: "memory");
    l_reg += ATT_SHFL(l_reg, lane ^ 32);
    LAS float* wsf2 = (LAS float*)(mine + 8192);
    if (hi == 0) { wsf2[r32] = l_reg; const float lg_ = __builtin_amdgcn_logf(l_reg); asm volatile("global_store_dword %0, %1, off sc1" :: "v"(lse_out + (tokbase + (size_t)nq * d + res) * 4), "v"(lg_) : "memory"); }
    asm volatile("s_waitcnt lgkmcnt(0)" ::: "memory");
    LAS unsigned short* stl = (LAS unsigned short*)mine;
#pragma unroll
    for (int r = 0; r < 16; ++r) { const int orow = crow(r, hi); const float rl = __builtin_amdgcn_rcpf(wsf2[orow]);
#pragma unroll
        for (int d0 = 0; d0 < 2; ++d0) stl[orow * 64 + d0 * 32 + r32] = (unsigned short)f2bf(o[d0][r] * rl); }
    asm volatile("s_waitcnt lgkmcnt(0)" ::: "memory");
#pragma unroll
    for (int i = 0; i < 4; ++i) { const int row = i * 8 + (lane >> 3), ch = lane & 7; const u32x4 vv = *(const LAS u32x4*)(stl + row * 64 + ch * 8);
        asm volatile("global_store_dwordx4 %0, %1, off sc1\n\ts_nop 1" :: "v"(O + (tokbase + (size_t)(32 * rb + row) * d + res) * opitch + ocol + ch * 8), "v"(vv) : "memory"); }
    asm volatile("s_waitcnt lgkmcnt(0)" ::: "memory");
}

template <int SKEL = 0>
__device__ __forceinline__ void attn_phase(GAS unsigned char* ws0, int l, volatile LAS unsigned*  , LAS unsigned char* lds0, int tid, int ulo = 0, int uhi = 768, int qoff = 0) {
    const int wv0 = __builtin_amdgcn_readfirstlane(tid >> 6);
    if (SKEL == 0 && (qoff == 0 || !MERGE_IN_QUEUE)) {
        for (int rp_ = 0; rp_ < 1 + ((qoff == 0) ? PROBE_WDIL2 : 0); ++rp_)
        for (int w = blockIdx.x * NWAVES + wv0; w < 3 * 2048; w += gridDim.x * NWAVES) {
            GAS unsigned char* ws = ws0; asm volatile("" : "+s"(ws));
            LAS unsigned char* lds = lds0; asm volatile("" : "+s"(lds));
            int wv = wv0; asm volatile("" : "+s"(wv));
            wdil_unit(ws, lds, wv, w);
        }
        asm volatile("s_waitcnt vmcnt(0)" ::: "memory");
        if (MERGE_IN_QUEUE && qoff == 0 && lane_opq() == 0) (void)xb_add((unsigned*)(ws0 + WS_CTL) + CW_Q + 64 * l + 32, 1u);
        __syncthreads();
    }
    const int c_lo = (l == 0) ? CONV_FIRST : CONV_SPLIT, c_hi = (l == 0) ? CONV_SPLIT : CONV_NITEMS;
    const int NC = (qoff == 0 || PROBE_CONVQ) ? (c_hi - c_lo + CONV_UNIT - 1) / CONV_UNIT : 0;
    const int NA = uhi - ulo, NP = (NA < NC) ? NA : NC;
    const int NM = (MERGE_IN_QUEUE && qoff == 0) ? M / 64 : 0;
    const int NU = NA + NC + NM;
    for (;;) {
        GAS unsigned char* ws = ws0; asm volatile("" : "+s"(ws));
        LAS unsigned char* lds = lds0; asm volatile("" : "+s"(lds));
        int wv = wv0; asm volatile("" : "+s"(wv));
        volatile LAS unsigned* misc = (volatile LAS unsigned*)(lds + MISC_OFF);
        { GAS unsigned* qctr = (GAS unsigned*)(ws + WS_CTL) + CW_Q + 64 * l + qoff;
          const bool t1 = (wv == 0) && (lane_opq() == 0);
          if (t1) misc[0] = __hip_atomic_fetch_add(qctr, 1u, __ATOMIC_RELAXED, __HIP_MEMORY_SCOPE_AGENT); }
        __syncthreads();
        const int uq = __builtin_amdgcn_readfirstlane((int)misc[0]);
        __syncthreads();
        if (uq >= NU) break;
        if (uq >= NA + NC) {
            if (misc[2] != (unsigned)(l + 1)) {
                if (wv == 0 && lane_opq() == 0) { unsigned* dctr = (unsigned*)(ws + WS_CTL) + CW_Q + 64 * l + 32; unsigned sp_ = 0u;
                    while (xb_ld(dctr) < gridDim.x * NWAVES) { __builtin_amdgcn_s_sleep(2); if (++sp_ > (1u << 24)) break; }
                    __builtin_amdgcn_fence(__ATOMIC_ACQUIRE, "agent"); asm volatile("s_waitcnt vmcnt(0)" ::: "memory"); }
                __syncthreads();
                if (wv == 0 && lane_opq() == 0) misc[2] = (unsigned)(l + 1);
                __syncthreads();
            }
            dil_merge_tokens((bf16*)(ws + WS_O), (const bf16*)(ws + WS_OG1), (const bf16*)(ws + WS_OG2), (const float*)(ws + WS_LSE), wv * 64 + lane_opq(), 64 * (uq - NA - NC));
            continue;
        }
        const bool isc = (uq < 2 * NP) ? ((uq & 1) != 0) : (NC > NA);
        if (isc) {
            const int cu = (uq < 2 * NP) ? (uq >> 1) : uq - NA;
            const int base = c_lo + CONV_UNIT * cu, end = (base + CONV_UNIT < c_hi) ? base + CONV_UNIT : c_hi;
            conv_run4(ws, lds, lane_opq(), wv, base + wv, NWAVES, end);
            VM_WAIT();
            continue;
        }
        const int ua = (uq < 2 * NP) ? (uq >> 1) : uq - NC;
        const bf16* Q = (const bf16*)(ws + WS_Q); const bf16* K = (const bf16*)(ws + WS_K); const bf16* V = (const bf16*)(ws + WS_V);
        bf16* O = (bf16*)(ws + WS_O);
        const float* fcum = (const float*)(ws + WS_FLOG); const float* kmean = (const float*)(ws + WS_KM) + (size_t)l * 8 * 6 * 8 * 64;
        const int u = ua + ulo;
        const int qb = 7 - u / 96, r = u % 96, type = r / 48, bh = r % 48, b = bh / 6, h = bh % 6;
        if (type == 0) attn_unit<0, SKEL>(Q, K, V, b, h, 1, 0, 256 * qb, 0, 0, 4 * (qb + 1), fcum + (size_t)bh * SEQ, 0.f, nullptr, qb, O, DM, h * 64, nullptr, lds, wv);
        else attn_unit<1, SKEL>(Q, K, V, b, 6 + h, 1, 0, 256 * qb, 0, 0, 4 * (qb + 1), nullptr, alibi_slope(8 + h) * LOG2E, kmean + (size_t)bh * 512, qb, O, DM, 384 + h * 64, nullptr, lds, wv);
    }
}
__device__ __forceinline__ void phase_dil_merge(bf16* O, const bf16* OG1, const bf16* OG2, const float* lse, int tid) {
    const int stride = gridDim.x * NTHR;
    for (int it0 = blockIdx.x * NTHR + tid; it0 < M * 32; it0 += 2 * stride) {
        v4u a[2], bq[2], c[2]; float l0[2], l1[2], l2[2];
#pragma unroll
        for (int q = 0; q < 2; ++q) { const int it = it0 + q * stride; if (it < M * 32) { const int m = it >> 5, ch = it & 31, slot = ch >> 3;
            l0[q] = lse[(size_t)m * 4 + slot]; l1[q] = lse[(size_t)(M + m) * 4 + slot]; l2[q] = lse[(size_t)(2 * M + m) * 4 + slot];
            a[q] = *(const v4u*)(O + (size_t)m * DM + 768 + ch * 8); bq[q] = *(const v4u*)(OG1 + (size_t)m * DILW + ch * 8); c[q] = *(const v4u*)(OG2 + (size_t)m * DILW + ch * 8); } }
#pragma unroll
        for (int q = 0; q < 2; ++q) { const int it = it0 + q * stride; if (it < M * 32) { const int m = it >> 5, ch = it & 31;
            const float mx = fmaxf(l0[q], fmaxf(l1[q], l2[q])); float w0 = exp2f(l0[q] - mx), w1 = exp2f(l1[q] - mx), w2 = exp2f(l2[q] - mx); const float inv = 1.0f / (w0 + w1 + w2); w0 *= inv; w1 *= inv; w2 *= inv;
            v4u o;
            o.x = pk2(w0 * bflo(a[q].x) + w1 * bflo(bq[q].x) + w2 * bflo(c[q].x), w0 * bfhi(a[q].x) + w1 * bfhi(bq[q].x) + w2 * bfhi(c[q].x));
            o.y = pk2(w0 * bflo(a[q].y) + w1 * bflo(bq[q].y) + w2 * bflo(c[q].y), w0 * bfhi(a[q].y) + w1 * bfhi(bq[q].y) + w2 * bfhi(c[q].y));
            o.z = pk2(w0 * bflo(a[q].z) + w1 * bflo(bq[q].z) + w2 * bflo(c[q].z), w0 * bfhi(a[q].z) + w1 * bfhi(bq[q].z) + w2 * bfhi(c[q].z));
            o.w = pk2(w0 * bflo(a[q].w) + w1 * bflo(bq[q].w) + w2 * bflo(c[q].w), w0 * bfhi(a[q].w) + w1 * bfhi(bq[q].w) + w2 * bfhi(c[q].w));
            *(v4u*)(O + (size_t)m * DM + 768 + ch * 8) = o; } }
    }
}
#undef ATT_BAR
#undef ATT_WAIT_BAR
#undef ATT_SHFL
}

#ifndef ONE_LAUNCH
#define ONE_LAUNCH 1
#endif
#ifndef REP_PHASE
#define REP_PHASE -1
#endif
#ifndef REP_N
#define REP_N 2
#endif
#define REPN(pid) ((REP_PHASE == (pid)) ? REP_N : 1)
#ifndef PROBE_ATTN2
#define PROBE_ATTN2 0
#endif
#ifndef PROBE_BAR2
#define PROBE_BAR2 0
#endif
#ifndef PROBE_DUP
#define PROBE_DUP 0
#endif
#ifndef PROBE_CONV2
#define PROBE_CONV2 0
#endif
#ifndef PROBE_ATTN2_L
#define PROBE_ATTN2_L 0
#endif
#ifndef PROBE_SKEL
#define PROBE_SKEL 0
#endif
#ifndef PROBE_ULO
#define PROBE_ULO 0
#define PROBE_UHI 768
#endif
#ifndef NAIVE_ATTN
#define NAIVE_ATTN 0
#endif
static_assert(WS_K - WS_Q == (size_t)M * QW * 2 && WS_V - WS_K == (size_t)M * QW * 2, "q|k|v stride");
constexpr int NPL = 12, NPH = 1 + 2 * NPL + 1;
#if NAIVE_ATTN
__global__ void __launch_bounds__(NTHR, 2) k_attn_naive(KArgs a) {
    unsigned char* ws = a.ws; const int tid = threadIdx.x, wave = tid >> 6;
    phase_attn_naive((const bf16*)(ws + WS_Q), (const bf16*)(ws + WS_K), (const bf16*)(ws + WS_V), (const float*)(ws + WS_FCUM), (const float*)(ws + WS_KMEAN), (bf16*)(ws + WS_O), tid, wave);
}
#endif
__device__ __forceinline__ bool opq(GAS unsigned char*& w, GAS unsigned char* w0, int& tid, int& lane, int& wave, int wave_k) { w = w0; asm volatile("" : "+s"(w)); unsigned z = 0u; asm volatile("" : "+v"(z)); asm volatile("" : "+s"(wave_k)); lane = (int)__builtin_amdgcn_mbcnt_hi(~0u, __builtin_amdgcn_mbcnt_lo(~0u, z)); wave = wave_k; tid = wave_k * 64 + lane; return true; }
#define PH(k) (lo <= (k) && (k) < hi && opq(ws, ws0, tid, lane, wave, wave_k))
#define SEAM(k) do { if (PH(k) && PH((k) + 1)) { XcdBarrier b_ = bar; asm volatile("" : "+s"(b_.bar)); xcd_barrier(b_, wave_k); if (PROBE_BAR2) { XcdBarrier c_ = bar; asm volatile("" : "+s"(c_.bar)); xcd_barrier(c_, wave_k); } } } while (0)
#define mods ((float*)(ws + WS_MODS))
#define flog ((float*)(ws + WS_FLOG))
#define fcum ((float*)(ws + WS_FCUM))
#define kmean ((float*)(ws + WS_KM) + (size_t)l * 8 * 6 * 8 * 64)
#define sel ((int*)(ws + WS_SEL))
#define wt ((float*)(ws + WS_WT))
#define rcnt ((int*)(ws + WS_CNT))
#define tok ((int*)(ws + WS_TOK))
#define wrow ((float*)(ws + WS_WROW))
#define tile_e ((int*)(ws + WS_TILEE))
#define Hb ((bf16*)(ws + WS_H))
#define Qb ((bf16*)(ws + WS_Q))
#define Kb ((bf16*)(ws + WS_K))
#define Vb ((bf16*)(ws + WS_V))
#define Gb ((bf16*)(ws + WS_G))
#define Ob ((bf16*)(ws + WS_O))
#define YB ((bf16*)(ws + WS_YB))
template <int L> __device__ __forceinline__ void layer_body(GAS unsigned char* const ws0, const int lo, const int hi, const XcdBarrier bar, LAS unsigned char* lds, const int wave_k) {
    constexpr int l = L; GAS unsigned char* ws = ws0; int tid = 0, lane = 0, wave = wave_k;
    const int G = (int)gridDim.x, bx = (int)blockIdx.x;
        const int p0 = 1 + NPL * l;
#define XBp ((bf16*)(ws + WS_XB))
#define mods_l (mods + (size_t)l * NB * 6144)
#define win_l (AIN(6) + (size_t)l * DM * IN_COLS)
#define wint_l ((const bf16*)(ws + WS_WIN) + (size_t)l * NIN * DM)
        if constexpr (l == 0) { if (PH(p0 + 0)) { for (int rc_ = 0; rc_ < 1 + PROBE_CONV2; ++rc_) phase_convert(ws, lds, tid, lane, wave); __syncthreads(); } }
        if (PH(p0 + 0)) for (int rep_ = 0; rep_ < REPN(p0 + 0); ++rep_) phase_norm<0, (l != 0)>((l == 0) ? (const void*)AIN(0) : (const void*)XBp, AIN(4) + l * DM, mods_l, 0, 1024, Hb, (unsigned char*)(ws + WS_H8), win_l, AIN(7) + 6 * l, flog, nullptr, nullptr, nullptr, nullptr, nullptr, nullptr, nullptr, nullptr, lds, tid, lane, wave);
        SEAM(p0 + 0);
        if (PH(p0 + 1)) for (int rep_ = 0; rep_ < REPN(p0 + 1); ++rep_) {
#if V_FP8
            { pg8::Gemm g{Hb, wint_l, M, 2 * QW, DM}; pg8::StaticOrder S; S.init(M, 2 * QW, G, bx);
              pg8::EpiInProj E{Qb, Gb, (const float*)(ws + WS_GAINS) + l * 2 * QW, kmean};
              pg8::gemm_phase<pg8::EpiInProj, pg8::StaticOrder, true, true>(lds, g, S, E, wave); }
            { pg8::Gemm g{(const bf16*)(ws + WS_H8), (const bf16*)(ws + WS_WIN + (size_t)l * 15 * MiB + WS_WG8_OFF), M, 3072 + QW, DM / 2};
              pg8::StaticOrder S; S.init(M, 3072 + QW, G, bx); pg8::EpiGates8 E{Gb, Vb};
              pg8::gemm_phase<pg8::EpiGates8, pg8::StaticOrder, true, true, true>(lds, g, S, E, wave); }
#else
            { pg8::Gemm g{Hb, wint_l, M, 3 * QW, DM}; pg8::StaticOrder S; S.init(M, 3 * QW, G, bx);
              pg8::EpiInProj E{Qb, Gb, (const float*)(ws + WS_GAINS) + l * 2 * QW, kmean};
              pg8::gemm_phase<pg8::EpiInProj, pg8::StaticOrder, true, true>(lds, g, S, E, wave); }
            { pg8::Gemm g{(const bf16*)(ws + WS_H8), (const bf16*)(ws + WS_WIN + (size_t)l * 15 * MiB + WS_WG8_OFF), M, 3072, DM / 2};
              pg8::GateOrder S{G, bx}; pg8::EpiGates8 E{Gb, Vb};
              pg8::gemm_phase<pg8::EpiGates8, pg8::GateOrder, true, true, true>(lds, g, S, E, wave); }
#endif
        }
        SEAM(p0 + 1);
#if PROBE_ATTN2
        if (l == PROBE_ATTN2_L && PH(p0 + 3)) att::attn_phase<PROBE_SKEL>(ws, l, (volatile LAS unsigned*)(lds + MISC_OFF), lds, tid, PROBE_ULO, PROBE_UHI, 16);
#endif
        if (PH(p0 + 3)) att::attn_phase(ws, l, (volatile LAS unsigned*)(lds + MISC_OFF), lds, tid);
        SEAM(p0 + 3);
        if (!MERGE_IN_QUEUE) { if (PH(p0 + 4)) att::phase_dil_merge(Ob, (const bf16*)(ws + WS_OG1), (const bf16*)(ws + WS_OG2), (const float*)(ws + WS_LSE), tid);
                               SEAM(p0 + 4); }
        if (PH(p0 + 5)) for (int rep_ = 0; rep_ < REPN(p0 + 5); ++rep_) {
            pg8::Gemm g{Ob, (const bf16*)(ws + WS_WBR) + (size_t)l * DM * DM, M, DM, DM}; pg8::StaticOrder S; S.init(M, DM, G, bx);
            pg8::EpiBranch E{YB, Gb}; pg8::gemm_phase<pg8::EpiBranch, pg8::StaticOrder, false, true>(lds, g, S, E, wave);
        }
        SEAM(p0 + 5);
        if (PH(p0 + 6)) for (int rep_ = 0; rep_ < REPN(p0 + 6); ++rep_) {
            pg8::Gemm g{YB, (const bf16*)(ws + WS_WOUT) + (size_t)l * DM * DM, M, DM, DM}; pg8::StaticOrder S; S.init(M, DM, G, bx);
            if constexpr (l == 0) { pg8::EpiResid<false> E{(const void*)AIN(0), XBp, mods_l + 2048, 1.f}; pg8::gemm_phase<pg8::EpiResid<false>, pg8::StaticOrder, false, true>(lds, g, S, E, wave); }
            else { pg8::EpiResid<true> E{(const void*)XBp, XBp, mods_l + 2048, (rep_ == 0) ? 1.f : 0.f}; pg8::gemm_phase<pg8::EpiResid<true>, pg8::StaticOrder, false, true>(lds, g, S, E, wave); }
        }
        SEAM(p0 + 6);
        if constexpr (l == 0) {
            if (PH(p0 + 7)) for (int rep_ = 0; rep_ < REPN(p0 + 7); ++rep_) phase_norm<1, true>((const void*)XBp, AIN(5) + l * DM, mods_l, 3072, 4096, Hb, nullptr, nullptr, nullptr, nullptr, nullptr, nullptr, nullptr, nullptr, nullptr, nullptr, nullptr, nullptr, lds, tid, lane, wave);
            SEAM(p0 + 7);
            if (PH(p0 + 10)) for (int rep_ = 0; rep_ < REPN(p0 + 10); ++rep_) {
                pg8::Gemm g{Hb, (const bf16*)(ws + WS_WF1), M, 2 * DFF, DM}; pg8::StaticOrder S; S.init(M, 2 * DFF, G, bx);
#if DENSE2_FP8
                pg8::EpiSwiglu8 E{(unsigned char*)(ws + WS_ACT), 22, 1.0f, F8_AS}; pg8::gemm_phase<pg8::EpiSwiglu8, pg8::StaticOrder, true, true>(lds, g, S, E, wave);
#else
                pg8::EpiSwiglu E{(bf16*)(ws + WS_ACT), 22, (PROBE_FP8 == 2) ? 8.f : 0.f}; pg8::gemm_phase<pg8::EpiSwiglu, pg8::StaticOrder, true, true>(lds, g, S, E, wave);
#endif
            }
            SEAM(p0 + 10);
            if (PH(p0 + 11)) for (int rep_ = 0; rep_ < REPN(p0 + 11); ++rep_) {
#if DENSE2_FP8
                pg8::Gemm g{(const bf16*)(ws + WS_ACT), (const bf16*)(ws + WS_WF2), M, DM, DFF / 2}; pg8::StaticOrder S; S.init(M, DM, G, bx);
                pg8::EpiResid<true> E{(const void*)XBp, XBp, mods_l + 5120, (rep_ == 0) ? 1.0f / (F8_WS * F8_AS) : 0.f}; pg8::gemm_phase<pg8::EpiResid<true>, pg8::StaticOrder, false, true, true>(lds, g, S, E, wave);
#else
                pg8::Gemm g{(const bf16*)(ws + WS_ACT), (const bf16*)(ws + WS_WF2), M, DM, DFF}; pg8::StaticOrder S; S.init(M, DM, G, bx);
                pg8::EpiResid<true> E{(const void*)XBp, XBp, mods_l + 5120, (rep_ == 0) ? 1.f : 0.f}; pg8::gemm_phase<pg8::EpiResid<true>, pg8::StaticOrder, false, true>(lds, g, S, E, wave);
#endif
            }
            SEAM(p0 + 11);
        } else {
            if (PH(p0 + 7)) for (int rep_ = 0; rep_ < REPN(p0 + 7); ++rep_) phase_norm<2, true>((const void*)XBp, AIN(5) + l * DM, mods_l, 3072, 4096, nullptr, nullptr, nullptr, nullptr, nullptr, AIN(17), AIN(18), sel, wt, rcnt, nullptr, nullptr, nullptr, lds, tid, lane, wave);
            SEAM(p0 + 7);
            if (PH(p0 + 9)) for (int rep_ = 0; rep_ < REPN(p0 + 9); ++rep_) phase_norm<3, true>((const void*)XBp, AIN(5) + l * DM, mods_l, 3072, 4096, (bf16*)(ws + WS_HP), nullptr, nullptr, nullptr, nullptr, nullptr, nullptr, sel, wt, rcnt, tok, wrow, tile_e, lds, tid, lane, wave);
            SEAM(p0 + 9);
            if (PH(p0 + 10)) for (int rep_ = 0; rep_ < REPN(p0 + 10); ++rep_) {
                const int nt = __builtin_amdgcn_readfirstlane(tile_e[255]);
                pg8::MoeOrder S; S.so.init(nt * 256, 2 * DFF, G, bx); S.tmap = tile_e; S.npn = 22;
#if MOE_FP8
                pg8::Gemm g{(const bf16*)(ws + WS_HP), (const bf16*)(ws + WS_WE1), nt * 256, 2 * DFF, DM / 2};
                pg8::EpiSwiglu8 E{(unsigned char*)(ws + WS_ACTE), 22, 1.0f / F8_WS, F8_AS / F8_WS}; pg8::gemm_phase<pg8::EpiSwiglu8, pg8::MoeOrder, true, true, true>(lds, g, S, E, wave);
#if PROBE_DUP == 3
                pg8::gemm_phase<pg8::EpiSwiglu8, pg8::MoeOrder, true, true, true>(lds, g, S, E, wave);
#endif
#else
                pg8::Gemm g{(const bf16*)(ws + WS_HP), (const bf16*)(ws + WS_WE1), nt * 256, 2 * DFF, DM};
                pg8::EpiSwiglu E{(bf16*)(ws + WS_ACTE), 22, 8.f}; pg8::gemm_phase<pg8::EpiSwiglu, pg8::MoeOrder, true, true>(lds, g, S, E, wave);
#endif
            }
            SEAM(p0 + 10);
            if (PH(p0 + 11)) for (int rep_ = 0; rep_ < REPN(p0 + 11); ++rep_) {
                const int nt = __builtin_amdgcn_readfirstlane(tile_e[255]);
                pg8::MoeOrder S; S.so.init(nt * 256, DM, G, bx); S.tmap = tile_e; S.npn = 4;
#if MOE_FP8
                pg8::Gemm g{(const bf16*)(ws + WS_ACTE), (const bf16*)(ws + WS_WE2), nt * 256, DM, DFF / 2};
                pg8::EpiMoeY E{(bf16*)(ws + WS_YE), mods_l + 5120, tok, wrow, 1.0f / (F8_WS * F8_AS)}; pg8::gemm_phase<pg8::EpiMoeY, pg8::MoeOrder, true, true, true>(lds, g, S, E, wave);
#if PROBE_DUP == 4
                pg8::gemm_phase<pg8::EpiMoeY, pg8::MoeOrder, true, true, true>(lds, g, S, E, wave);
#endif
#else
                pg8::Gemm g{(const bf16*)(ws + WS_ACTE), (const bf16*)(ws + WS_WE2), nt * 256, DM, DFF};
                pg8::EpiMoeY E{(bf16*)(ws + WS_YE), mods_l + 5120, tok, wrow, 1.0f}; pg8::gemm_phase<pg8::EpiMoeY, pg8::MoeOrder, false, true>(lds, g, S, E, wave);
#endif
            }
            SEAM(p0 + 11);
            if (PH(p0 + 12)) phase_moe_combine(AOUT, XBp, (const bf16*)(ws + WS_YE), tid);
        }
}
__global__ void __launch_bounds__(NTHR, 2) mk_fwd(KArgs a) {
    extern __shared__ __attribute__((aligned(16))) unsigned char lds_raw[];
    LAS unsigned char* lds = (LAS unsigned char*)lds_raw;
    const int wave_k = __builtin_amdgcn_readfirstlane((int)threadIdx.x >> 6);
    int lane = lane_opq(), tid = wave_k * 64 + lane, wave = wave_k;
    volatile LAS unsigned* MISC = (volatile LAS unsigned*)(lds + MISC_OFF);
    for (int u = tid; u < (LDS_BYTES - RING_BYTES) / 4; u += NTHR) ((LAS unsigned*)(lds + RING_BYTES))[u] = 0u;
    __syncthreads();
    GAS unsigned char* const ws0 = (GAS unsigned char*)a.ws;
    GAS unsigned char* ws = ws0;
    unsigned* ctl = (unsigned*)(ws + WS_CTL);
    const int lo = a.ph_lo, hi = a.ph_hi;
    XcdBarrier bar; bar.bar = ctl + CW_BAR; bar.x = 0; bar.st = nullptr;
    if (hi - lo > 1) bar = xcd_barrier_post(ctl + CW_BAR, MISC + 8, tid == 0);
    const int G = (int)gridDim.x, bx = (int)blockIdx.x;

    if (PH(0)) { for (int rep_ = 0; rep_ < REPN(0); ++rep_) phase_mods(ws, lds, tid, lane, wave);
                 }
    SEAM(0);
    layer_body<0>(ws0, lo, hi, bar, lds, wave_k);
    layer_body<1>(ws0, lo, hi, bar, lds, wave_k);
#undef PH
#undef SEAM
}

extern "C" void kernel_launch(void* const* d_in, const int* in_sizes, int n_in, void* d_out, int out_size, void* d_ws, size_t ws_size, hipStream_t stream) {
    static int grid = 0;
    if (grid == 0) {
        if (n_in != 22 || out_size != M * DM || ws_size < WS_END) { fprintf(stderr, "kernel_launch: unexpected sizes n_in %d out %d ws %zu (need %zu)\n", n_in, out_size, ws_size, (size_t)WS_END); grid = -1; return; }
        int dev = 0, cus = 0, per_cu = 0;
        if (hipGetDevice(&dev) != hipSuccess || hipDeviceGetAttribute(&cus, hipDeviceAttributeMultiprocessorCount, dev) != hipSuccess) { grid = -1; return; }
        if (hipFuncSetAttribute((const void*)mk_fwd, hipFuncAttributeMaxDynamicSharedMemorySize, LDS_BYTES) != hipSuccess) { fprintf(stderr, "kernel_launch: hipFuncSetAttribute failed\n"); grid = -1; return; }
        if (hipOccupancyMaxActiveBlocksPerMultiprocessor(&per_cu, (const void*)mk_fwd, NTHR, LDS_BYTES) != hipSuccess || per_cu < 1) fprintf(stderr, "kernel_launch: occupancy query says %d\n", per_cu);
        (void)hipGetLastError();
        grid = cus;
    }
    if (grid < 0) return;
    (void)hipMemsetAsync((char*)d_ws + WS_CTL, 0, CTL_ZERO_BYTES, stream);
    KArgs a{};
    for (int i = 0; i < 22; ++i) a.in[i] = (const float*)d_in[i];
    a.out = (float*)d_out; a.ws = (unsigned char*)d_ws;
#if ONE_LAUNCH
    a.ph_lo = 0; a.ph_hi = NPH;
    hipLaunchKernelGGL(mk_fwd, dim3(grid), dim3(NTHR), LDS_BYTES, stream, a);
#else
    for (int p = 0; p < NPH; ++p) {
        if (p == 1 + 8 || p == 1 + 9) continue;
        if (NAIVE_ATTN && (p == 1 + 4 || p == 1 + NPL + 4)) continue;
        a.ph_lo = p; a.ph_hi = p + 1;
#if NAIVE_ATTN
        if (p == 1 + 3 || p == 1 + NPL + 3) { hipLaunchKernelGGL(k_attn_naive, dim3(grid), dim3(NTHR), 0, stream, a); continue; }
#endif
        hipLaunchKernelGGL(mk_fwd, dim3(grid), dim3(NTHR), LDS_BYTES, stream, a);
    }
#endif
}
```

```cpp
#include <hip/hip_runtime.h>
#include <cstdio>
#include <cstdint>

constexpr int NB = 8, SEQ = 2048, DM = 1024, M = NB * SEQ, NH = 24, HD = 64, QW = 1536;
constexpr int IN_COLS = 7686, NIN = 7680, DFF = 2816, NE = 8;
constexpr int FOXW = 384, MOBW = 384, DILW = 256;
constexpr float RMS_EPS = 1e-6f, LOG2E = 1.4426950408889634f, C2 = 0.125f * 1.4426950408889634f;
constexpr int PMAX = 2 * M + NE * 256;
constexpr int NWAVES = 8, NTHR = 512;

constexpr size_t MiB = 1u << 20, KiB = 1024;
constexpr size_t WS_CTL = 0, CTL_ZERO_BYTES = 1 * MiB;
constexpr size_t WS_MODS = 1 * MiB;
constexpr size_t WS_FLOG = WS_MODS + 384 * KiB;
constexpr size_t WS_FCUM = WS_FLOG + 384 * KiB;
constexpr size_t WS_KMEAN = WS_FCUM + 384 * KiB;
constexpr size_t WS_SEL = WS_KMEAN + 96 * KiB;
constexpr size_t WS_WT = WS_SEL + 128 * KiB;
constexpr size_t WS_CNT = WS_WT + 128 * KiB;
constexpr size_t WS_TOK = WS_CNT + 128 * KiB;
constexpr size_t WS_WROW = WS_TOK + 136 * KiB;
constexpr size_t WS_TILEE = WS_WROW + 136 * KiB;
constexpr size_t WS_GAINS = WS_TILEE + 1024;
static_assert(WS_GAINS + 2 * 2 * 1536 * 4 <= 5 * MiB, "small buffers");
constexpr size_t WS_WIN = 5 * MiB;
constexpr size_t WS_WBR = 35 * MiB;
constexpr size_t WS_WOUT = 39 * MiB;
constexpr size_t WS_WF1 = 43 * MiB;
constexpr size_t WS_WF2 = 54 * MiB;
constexpr size_t WS_WE1 = WS_WF2 + 5632 * KiB;
constexpr size_t WS_WE2 = WS_WE1 + 88 * MiB;
constexpr size_t WS_H = WS_WE2 + 44 * MiB;
constexpr size_t WS_O = WS_H;
constexpr size_t WS_Q = WS_H + 32 * MiB, WS_K = WS_Q + 48 * MiB, WS_V = WS_K + 48 * MiB;
constexpr size_t WS_G = WS_V + 48 * MiB;
constexpr size_t WS_OG1 = WS_G + 96 * MiB;
constexpr size_t WS_OG2 = WS_OG1 + 8 * MiB;
constexpr size_t WS_LSE = WS_OG2 + 8 * MiB;
constexpr size_t WS_END = WS_LSE + 768 * KiB;
constexpr size_t WS_XB = WS_WE1 + 44 * MiB;
constexpr size_t WS_H8 = WS_OG1;
constexpr size_t WS_WG8_OFF = 9 * MiB;
constexpr size_t WS_YB = WS_V;
constexpr size_t WS_ACT = WS_Q;
constexpr size_t WS_HP = WS_H;
constexpr size_t WS_YE = WS_H;
constexpr size_t WS_ACTE = WS_H + 68 * MiB;
static_assert(WS_ACTE + (size_t)PMAX * DFF * 2 <= WS_END, "moe act fits");
static_assert(WS_ACT + (size_t)M * DFF * 2 <= WS_V, "dense act fits under y");

constexpr size_t WS_KM = 256 * KiB;
constexpr int CW_BAR = 4096, CW_Q = 8192;
constexpr int RING_BYTES = 131072, MISC_OFF = RING_BYTES + 320, LDS_BYTES = 147456;

#define GAS __attribute__((address_space(1)))
#define LAS __attribute__((address_space(3)))
typedef unsigned short bf16;
typedef unsigned v4u __attribute__((ext_vector_type(4)));
typedef float f32x4 __attribute__((ext_vector_type(4)));
#define LDS_WAIT() asm volatile("s_waitcnt lgkmcnt(0)" ::: "memory")
#define VM_WAIT() asm volatile("s_waitcnt vmcnt(0)" ::: "memory")
__device__ __forceinline__ unsigned f2bf(float f) { unsigned u = __builtin_bit_cast(unsigned, f); return (u + 0x7fffu + ((u >> 16) & 1u)) >> 16; }
typedef float f32x2_t_ __attribute__((ext_vector_type(2))); typedef __bf16 bf16x2_t_ __attribute__((ext_vector_type(2)));
__device__ __forceinline__ unsigned pk2(float lo, float hi) { f32x2_t_ v = {lo, hi}; bf16x2_t_ b = __builtin_convertvector(v, bf16x2_t_); return __builtin_bit_cast(unsigned, b); }
typedef unsigned u32x2 __attribute__((ext_vector_type(2)));
__device__ __forceinline__ float ub8(unsigned w, int i) { return (float)((w >> (8 * i)) & 0xffu); }
__device__ __forceinline__ float bflo(unsigned w) { return __builtin_bit_cast(float, w << 16); }
__device__ __forceinline__ float bfhi(unsigned w) { return __builtin_bit_cast(float, w & 0xffff0000u); }
__device__ __forceinline__ int lane_opq() { unsigned z = 0u; asm volatile("" : "+v"(z)); return (int)__builtin_amdgcn_mbcnt_hi(~0u, __builtin_amdgcn_mbcnt_lo(~0u, z)); }
__device__ __forceinline__ float shfl_l(float v, int src_lane) { return __builtin_bit_cast(float, __builtin_amdgcn_ds_bpermute(src_lane << 2, __builtin_bit_cast(int, v))); }
__device__ __forceinline__ int shfl_li(int v, int src_lane) { return __builtin_amdgcn_ds_bpermute(src_lane << 2, v); }
#define WS_DPP(v, ctrl) __builtin_bit_cast(float, __builtin_amdgcn_update_dpp(0, __builtin_bit_cast(int, (float)(v)), (ctrl), 0xf, 0xf, false))
__device__ __forceinline__ float wave_sum(float v) {
    const int l_ = lane_opq();
    v += WS_DPP(v, 0xB1);
    v += WS_DPP(v, 0x4E);
    v += WS_DPP(v, 0x141);
    v += WS_DPP(v, 0x140);
    { float c = v; asm volatile("" : "+v"(c)); const auto r = __builtin_amdgcn_permlane16_swap(__builtin_bit_cast(unsigned, v), __builtin_bit_cast(unsigned, c), false, false);
      v += __builtin_bit_cast(float, (l_ & 16) ? r[0] : r[1]); }
    { float c = v; asm volatile("" : "+v"(c)); const auto r = __builtin_amdgcn_permlane32_swap(__builtin_bit_cast(unsigned, v), __builtin_bit_cast(unsigned, c), false, false);
      v += __builtin_bit_cast(float, (l_ & 32) ? r[0] : r[1]); }
    return v;
}
__device__ __forceinline__ int kv_l2d(int head) { return head < 16 ? 0 : (head < 20 ? 2 : 4); }
__device__ __forceinline__ int kv_row(int t, int l2) { return ((t & ((1 << l2) - 1)) << (11 - l2)) + (t >> l2); }
__device__ __forceinline__ float wave_reduce8(const float (&a)[8], int lane) {
    float b[4], c[2];
#pragma unroll
    for (int k = 0; k < 4; ++k) { const float keep = (lane & 1) ? a[2 * k + 1] : a[2 * k], send = (lane & 1) ? a[2 * k] : a[2 * k + 1]; b[k] = keep + shfl_l(send, lane ^ 1); }
#pragma unroll
    for (int j = 0; j < 2; ++j) { const float keep = (lane & 2) ? b[2 * j + 1] : b[2 * j], send = (lane & 2) ? b[2 * j] : b[2 * j + 1]; c[j] = keep + shfl_l(send, lane ^ 2); }
    float d = ((lane & 4) ? c[1] : c[0]) + shfl_l((lane & 4) ? c[0] : c[1], lane ^ 4);
    d += shfl_l(d, lane ^ 8); d += shfl_l(d, lane ^ 16); d += shfl_l(d, lane ^ 32);
    return d;
}
__device__ __forceinline__ float alibi_slope(int i) { return exp2f(-8.0f * (float)(i + 1) / 18.0f); }

#ifndef MOE_FP8
#define MOE_FP8 1
#endif
static_assert(MOE_FP8 == 1, "WS_XB sits in the half of the expert up-projection slot that only the fp8 build leaves free");
constexpr float F8_WS = 32.f, F8_AS = 8.f;
__device__ __forceinline__ unsigned pk4_fp8(float a, float b, float c, float d) { int p = __builtin_amdgcn_cvt_pk_fp8_f32(a, b, 0, false); p = __builtin_amdgcn_cvt_pk_fp8_f32(c, d, p, true); return (unsigned)p; }
#ifndef V_FP8
#define V_FP8 1
#endif
#ifndef PROBE_CONVQ
#define PROBE_CONVQ 0
#endif
#ifndef PROBE_WDIL2
#define PROBE_WDIL2 0
#endif
#ifndef DENSE2_FP8
#define DENSE2_FP8 1
#endif
#ifndef MERGE_IN_QUEUE
#define MERGE_IN_QUEUE 1
#endif
#ifndef PROBE_FP8
#define PROBE_FP8 0
#endif
__device__ __forceinline__ float q8(float x, float s) { const int p = __builtin_amdgcn_cvt_pk_fp8_f32(x * s, x * s, 0, false); return __builtin_amdgcn_cvt_f32_fp8(p, 0) * (1.0f / s); }
namespace pg8 {
#define PG8_LAS __attribute__((address_space(3)))
typedef unsigned short bf16_t;
typedef short bf16x8 __attribute__((ext_vector_type(8)));
typedef float f32x4 __attribute__((ext_vector_type(4)));
typedef unsigned u32x4 __attribute__((ext_vector_type(4)));
constexpr int BM = 256, BK = 64, HALF = 128, HTB = HALF * BK * 2  , STAGE_BYTES = 8 * HTB, NXCD = 8, WGM = 8;

__host__ __device__ __forceinline__ int lds_byte(int r, int c) { const int st = (r >> 4) * 2 + (c >> 5), rr = r & 15, cc = c & 31, ob = rr * 64 + cc * 2; return st * 1024 + (ob ^ (((ob >> 9) & 1) << 5)); }
__host__ __device__ __forceinline__ void stage_rc(int b, int& R, int& C) { const int st = b / 1024, sb = b % 1024, swz = sb ^ (((sb >> 9) & 1) << 5); R = (st >> 1) * 16 + swz / 64; C = (st & 1) * 32 + (swz % 64) / 2; }
__host__ __device__ __forceinline__ int perm32(int rho) { const int n = rho >> 4, i = rho & 15; return 8 * (i >> 2) + 4 * n + (i & 3); }

struct Unit { int pm, pn; };
struct Gemm { const bf16_t* A; const bf16_t* Bt; int M, N, K; };

struct StaticOrder {
    int nM, nN, nwg, G, c;
    __host__ __device__ void init(int M, int N, int G_, int c_) { nM = M / BM; nN = N / BM; nwg = nM * nN; G = G_; c = c_; }
    __host__ __device__ bool next(int i, Unit& u) const {
        const long L = (long)i * G + c; if (L >= nwg) return false;
        int wgid = (int)L; { const int q = nwg / NXCD, r = nwg % NXCD, xcd = wgid % NXCD, off = wgid / NXCD; wgid = (xcd < r ? xcd * (q + 1) : r * (q + 1) + (xcd - r) * q) + off; }
        const int nig = WGM * nN, gid = wgid / nig, fm = gid * WGM, gsz = (nM - fm) < WGM ? (nM - fm) : WGM;
        u.pm = fm + ((wgid % nig) % gsz); u.pn = (wgid % nig) / gsz; return true;
    }
    __device__ __forceinline__ void a_ready(const Unit&) const {}
    __device__ __forceinline__ void done(const Unit&) const {}
};
template <class Epi, class Sched, bool ALIGN_EPI = false, bool SP2 = false, bool F8 = false>
__device__ __forceinline__ void gemm_phase(PG8_LAS unsigned char* lds, const Gemm g, const Sched& S, const Epi& E, int wave_k) {
    unsigned zt_ = 0u; asm volatile("" : "+v"(zt_)); asm volatile("" : "+s"(wave_k)); int tid_o = wave_k * 64 + (int)__builtin_amdgcn_mbcnt_hi(~0u, __builtin_amdgcn_mbcnt_lo(~0u, zt_));
    const int tid = tid_o, wid = __builtin_amdgcn_readfirstlane(tid >> 6), lane = tid & 63, wr = wid >> 2, wc = wid & 3, fr = lane & 15, fq = lane >> 4;
    const int K = g.K, nt = K / BK;
    unsigned voffA[2], voffB[2];
#pragma unroll
    for (int i = 0; i < 2; ++i) { int R, C; stage_rc(tid * 16 + i * 8192, R, C); const int Rb = Epi::PERM ? ((R & ~31) + perm32(R & 31)) : R;
        voffA[i] = (unsigned)(R * K + C) * 2u; voffB[i] = (unsigned)(Rb * K + C) * 2u; }
    const size_t kstep = (size_t)(BK * 2);
    const size_t hstep = (size_t)HALF * K * 2;
    const size_t tstep = 2 * hstep;
    const unsigned ldsw = (unsigned)wid * 1024u;
    const int aoff = lds_byte(wr * 64 + fr, fq * 8), boff = lds_byte(wc * 32 + fr, fq * 8);
#define PG8_SA(b, h) (((b) * 2 + (h)) * HTB)
#define PG8_SB(b, h) ((4 + (b) * 2 + (h)) * HTB)
#define PG8_STAGE(bufoff, gbase, voff) do { _Pragma("unroll") for (int _i = 0; _i < 2; ++_i) \
        __builtin_amdgcn_global_load_lds((const unsigned*)((const char*)(gbase) + (voff)[_i]), (PG8_LAS unsigned*)(lds + (bufoff) + ldsw + _i * 8192), 16, 0, 0); } while (0)
#define PG8_LDA(dst, b, h) do { _Pragma("unroll") for (int m = 0; m < 4; ++m) { dst[m].lo = *(const PG8_LAS bf16x8*)(lds + PG8_SA(b, h) + aoff + m * 2048); dst[m].hi = *(const PG8_LAS bf16x8*)(lds + PG8_SA(b, h) + aoff + m * 2048 + 1024); } } while (0)
#define PG8_LDB(dst, b, h) do { _Pragma("unroll") for (int n = 0; n < 2; ++n) { dst[n].lo = *(const PG8_LAS bf16x8*)(lds + PG8_SB(b, h) + boff + n * 2048); dst[n].hi = *(const PG8_LAS bf16x8*)(lds + PG8_SB(b, h) + boff + n * 2048 + 1024); } } while (0)
#define PG8_MMA(ai, bj, At, Bt) do { __builtin_amdgcn_s_setprio(1); _Pragma("unroll") for (int m = 0; m < 4; ++m) _Pragma("unroll") for (int n = 0; n < 2; ++n) { \
        if constexpr (F8) { typedef int i32x8 __attribute__((ext_vector_type(8))); \
            asm volatile("v_mfma_scale_f32_16x16x128_f8f6f4 %0, %1, %2, %0, %3, %3 op_sel_hi:[0,0,0]" : "+v"(acc[ai][bj][m][n]) : "v"(__builtin_bit_cast(i32x8, Bt[n])), "v"(__builtin_bit_cast(i32x8, At[m])), "v"(f8scale)); } \
        else { acc[ai][bj][m][n] = __builtin_amdgcn_mfma_f32_16x16x32_bf16(Bt[n].lo, At[m].lo, acc[ai][bj][m][n], 0, 0, 0); \
               acc[ai][bj][m][n] = __builtin_amdgcn_mfma_f32_16x16x32_bf16(Bt[n].hi, At[m].hi, acc[ai][bj][m][n], 0, 0, 0); } } \
        __builtin_amdgcn_s_setprio(0); } while (0)
#define PG8_WAIT_V(n) asm volatile("s_waitcnt vmcnt(" #n ")" ::: "memory")
#define PG8_WAIT_L(n) asm volatile("s_waitcnt lgkmcnt(" #n ")" ::: "memory")
#define PG8_BAR __builtin_amdgcn_s_barrier()
#define PG8_SCHED __builtin_amdgcn_sched_barrier(0)
    Unit cur, nxt; int ui = 0;
    if (!S.next(0, cur)) return;
    f32x4 acc[2][2][4][2];
#pragma unroll
    for (int a = 0; a < 2; ++a)
#pragma unroll
        for (int b = 0; b < 2; ++b)
#pragma unroll
            for (int m = 0; m < 4; ++m)
#pragma unroll
                for (int n = 0; n < 2; ++n) acc[a][b][m][n] = (f32x4){0.f, 0.f, 0.f, 0.f};
    const int f8scale = 0x7f7f7f7f;
    typedef short bf16x16 __attribute__((ext_vector_type(16)));
    bf16x16 At[4], B0[2], B1[2];
    const char* cA = (const char*)g.A + (size_t)cur.pm * tstep; const char* cB = (const char*)g.Bt + (size_t)cur.pn * tstep;
    S.a_ready(cur);
    if constexpr (SP2) {
        PG8_STAGE(PG8_SB(0, 0), cB, voffB); PG8_STAGE(PG8_SB(0, 1), cB + hstep, voffB); PG8_STAGE(PG8_SA(0, 0), cA, voffA); PG8_STAGE(PG8_SA(0, 1), cA + hstep, voffA);
        if (wr == 1) PG8_BAR;
        PG8_WAIT_V(2); PG8_BAR;
        PG8_STAGE(PG8_SB(1, 0), cB + kstep, voffB); PG8_STAGE(PG8_SA(1, 0), cA + kstep, voffA); PG8_STAGE(PG8_SB(1, 1), cB + hstep + kstep, voffB);
        PG8_WAIT_V(6); PG8_BAR;
    } else {
        PG8_STAGE(PG8_SB(0, 0), cB, voffB); PG8_STAGE(PG8_SA(0, 0), cA, voffA); PG8_STAGE(PG8_SB(0, 1), cB + hstep, voffB); PG8_STAGE(PG8_SA(0, 1), cA + hstep, voffA);
        if (wr == 1) PG8_BAR;
        PG8_WAIT_V(4); PG8_BAR;
        PG8_STAGE(PG8_SB(1, 0), cB + kstep, voffB); PG8_STAGE(PG8_SA(1, 0), cA + kstep, voffA); PG8_STAGE(PG8_SB(1, 1), cB + hstep + kstep, voffB);
        PG8_WAIT_V(6); PG8_BAR;
    }
    for (;;) {
        const bool has_next = S.next(ui + 1, nxt);
        const char* nA = has_next ? (const char*)g.A + (size_t)nxt.pm * tstep : cA; const char* nB = has_next ? (const char*)g.Bt + (size_t)nxt.pn * tstep : cB;
#pragma nounroll
        for (int t = 0; t < nt; t += 2) {
            const bool last = (t == nt - 2);
            const char* a1 = cA + (size_t)(t + 1) * kstep;
            const char* a2 = last ? nA : cA + (size_t)(t + 2) * kstep; const char* b2 = last ? nB : cB + (size_t)(t + 2) * kstep;
            const char* a3 = a2 + kstep; const char* b3 = b2 + kstep;
            if (last && has_next) S.a_ready(nxt);
            if constexpr (Epi::MIDK) { if (t == Epi::KT1 || t == Epi::KT2) E.mid(acc, cur, t, wr, wc, fr, fq); }
            if constexpr (SP2) {
            PG8_LDB(B0, 0, 0); PG8_LDB(B1, 0, 1); PG8_SCHED; PG8_LDA(At, 0, 0); PG8_STAGE(PG8_SA(1, 1), a1 + hstep, voffA);
            PG8_WAIT_V(8); PG8_WAIT_L(0); PG8_BAR; PG8_MMA(0, 0, At, B0); PG8_MMA(0, 1, At, B1); PG8_BAR; PG8_SCHED;
            PG8_LDA(At, 0, 1); PG8_STAGE(PG8_SB(0, 0), b2, voffB); PG8_STAGE(PG8_SB(0, 1), b2 + hstep, voffB); PG8_STAGE(PG8_SA(0, 0), a2, voffA);
            PG8_WAIT_V(8); PG8_WAIT_L(0); PG8_BAR; PG8_MMA(1, 0, At, B0); PG8_MMA(1, 1, At, B1); PG8_BAR; PG8_SCHED;
            PG8_LDB(B0, 1, 0); PG8_LDB(B1, 1, 1); PG8_SCHED; PG8_LDA(At, 1, 0); PG8_STAGE(PG8_SA(0, 1), a2 + hstep, voffA);
            PG8_WAIT_V(8); PG8_WAIT_L(0); PG8_BAR; PG8_MMA(0, 0, At, B0); PG8_MMA(0, 1, At, B1); PG8_BAR; PG8_SCHED;
            PG8_LDA(At, 1, 1); PG8_STAGE(PG8_SB(1, 0), b3, voffB); PG8_STAGE(PG8_SB(1, 1), b3 + hstep, voffB); PG8_STAGE(PG8_SA(1, 0), a3, voffA);
            PG8_WAIT_V(8); PG8_WAIT_L(0); PG8_BAR; PG8_MMA(1, 0, At, B0); PG8_MMA(1, 1, At, B1); PG8_BAR; PG8_SCHED;
            } else {
            PG8_LDB(B0, 0, 0); PG8_SCHED; PG8_LDA(At, 0, 0); PG8_STAGE(PG8_SA(1, 1), a1 + hstep, voffA);
            PG8_WAIT_L(8); PG8_BAR; PG8_WAIT_L(0); PG8_MMA(0, 0, At, B0); PG8_BAR; PG8_SCHED;
            PG8_LDB(B1, 0, 1); PG8_STAGE(PG8_SB(0, 0), b2, voffB);
            PG8_BAR; PG8_WAIT_L(0); PG8_MMA(0, 1, At, B1); PG8_BAR;
            PG8_LDA(At, 0, 1); PG8_STAGE(PG8_SA(0, 0), a2, voffA);
            PG8_BAR; PG8_WAIT_L(0); PG8_MMA(1, 0, At, B0); PG8_BAR; PG8_SCHED;
            PG8_STAGE(PG8_SB(0, 1), b2 + hstep, voffB);
            PG8_WAIT_V(6); PG8_BAR; PG8_MMA(1, 1, At, B1); PG8_BAR;
            PG8_LDB(B0, 1, 0); PG8_SCHED; PG8_LDA(At, 1, 0); PG8_STAGE(PG8_SA(0, 1), a2 + hstep, voffA);
            PG8_WAIT_L(8); PG8_BAR; PG8_WAIT_L(0); PG8_MMA(0, 0, At, B0); PG8_BAR; PG8_SCHED;
            PG8_LDB(B1, 1, 1); PG8_STAGE(PG8_SB(1, 0), b3, voffB);
            PG8_BAR; PG8_WAIT_L(0); PG8_MMA(0, 1, At, B1); PG8_BAR;
            PG8_LDA(At, 1, 1); PG8_STAGE(PG8_SA(1, 0), a3, voffA);
            PG8_BAR; PG8_WAIT_L(0); PG8_MMA(1, 0, At, B0); PG8_BAR; PG8_SCHED;
            PG8_STAGE(PG8_SB(1, 1), b3 + hstep, voffB);
            PG8_WAIT_V(6); PG8_BAR; PG8_MMA(1, 1, At, B1); PG8_BAR;
            }
        }
        if constexpr (ALIGN_EPI) { if (wr == 0) PG8_BAR; }
        if constexpr (F8) asm volatile("s_nop 15\n\ts_nop 15\n\ts_nop 15\n\ts_nop 15\n\ts_nop 15" ::: "memory");
        if constexpr (!Epi::AFTER_DRAIN) { E(acc, cur, wr, wc, fr, fq); S.done(cur); }
        if (!has_next) break;
#pragma unroll
        for (int a = 0; a < 2; ++a)
#pragma unroll
            for (int b = 0; b < 2; ++b)
#pragma unroll
                for (int m = 0; m < 4; ++m)
#pragma unroll
                    for (int n = 0; n < 2; ++n) acc[a][b][m][n] = (f32x4){0.f, 0.f, 0.f, 0.f};
        cur = nxt; cA = nA; cB = nB; ++ui;
        if constexpr (ALIGN_EPI) { if (wr == 1) PG8_BAR; }
    }
    PG8_WAIT_V(0);
    if constexpr (!ALIGN_EPI) { if (wr == 0) PG8_BAR; }
    PG8_BAR;
    if constexpr (Epi::AFTER_DRAIN) { E.fused(acc, cur, wr, wc, fr, fq, lds, wid, lane); S.done(cur); }
#undef PG8_SA
#undef PG8_SB
#undef PG8_STAGE
#undef PG8_LDA
#undef PG8_LDB
#undef PG8_MMA
#undef PG8_WAIT_V
#undef PG8_WAIT_L
#undef PG8_BAR
#undef PG8_SCHED
}
}

namespace pg8 {
struct EpiInProj {
    static constexpr bool PERM = true, AFTER_DRAIN = false, MIDK = false;
    bf16_t *Q, *G; const float *gains; float* kmean;
    __device__ __forceinline__ void operator()(const f32x4 (&acc)[2][2][4][2], const Unit& u, int wr, int wc, int, int) const {
        unsigned z_ = 0u; asm volatile("" : "+v"(z_)); const int ln_ = __builtin_amdgcn_mbcnt_hi(~0u, __builtin_amdgcn_mbcnt_lo(~0u, z_)); const int fr = ln_ & 15, fq = ln_ >> 4;
        const int row0 = u.pm * BM + wr * 64 + fr;
        if (u.pn < 18) {
            const int sec = u.pn / 6, head = (u.pn % 6) * 4 + wc;
            const int bb = (u.pm * BM) / SEQ; const int l2k = kv_l2d(head);
            const size_t doff = (size_t)sec * ((size_t)M * QW) + ((sec == 1) ? ((size_t)bb * 23 * SEQ + (size_t)head * SEQ) * 64 : (size_t)(head * 64));
            bf16_t* dst = Q + doff + fq * 8;
            f32x4 gn[2][2];
#pragma unroll
            for (int bj = 0; bj < 2; ++bj)
#pragma unroll
                for (int n = 0; n < 2; ++n) {
                    if (sec < 2) gn[bj][n] = *(const f32x4*)(gains + sec * QW + head * 64 + bj * 32 + fq * 8 + 4 * n);
                    else gn[bj][n] = (f32x4){1.f, 1.f, 1.f, 1.f};
                }
            const bool km_on = (sec == 1 && head >= 6 && head < 12);
            float cs[16];
#pragma unroll
            for (int i = 0; i < 16; ++i) cs[i] = 0.f;
#pragma unroll
            for (int ai = 0; ai < 2; ++ai)
#pragma unroll
                for (int m = 0; m < 4; ++m) {
                    float rs = 1.f;
                    if (sec < 2) {
                        float ss = 0.f;
#pragma unroll
                        for (int bj = 0; bj < 2; ++bj)
#pragma unroll
                            for (int n = 0; n < 2; ++n) { const f32x4 x = acc[ai][bj][m][n]; ss += (x[0] * x[0] + x[1] * x[1]) + (x[2] * x[2] + x[3] * x[3]); }
                        ss += shfl_l(ss, ln_ ^ 16); ss += shfl_l(ss, ln_ ^ 32);
                        rs = __builtin_amdgcn_rsqf(ss * (1.0f / 64.0f) + RMS_EPS);
                    }
                    const int rr_ = row0 + ai * HALF + m * 16;
                    bf16_t* rowp = dst + ((sec == 1) ? (size_t)(bb * SEQ + kv_row(rr_ - bb * SEQ, l2k)) * 64 : (size_t)rr_ * QW);
#pragma unroll
                    for (int bj = 0; bj < 2; ++bj) {
                        const f32x4 v0 = acc[ai][bj][m][0] * rs * gn[bj][0], v1 = acc[ai][bj][m][1] * rs * gn[bj][1];
                        if (km_on) {
#pragma unroll
                            for (int i = 0; i < 4; ++i) { cs[bj * 8 + i] += v0[i]; cs[bj * 8 + 4 + i] += v1[i]; } }
                        u32x4 w; w.x = pk2(v0[0], v0[1]); w.y = pk2(v0[2], v0[3]); w.z = pk2(v1[0], v1[1]); w.w = pk2(v1[2], v1[3]);
                        *(u32x4*)(rowp + bj * 32) = w;
                    }
                    asm volatile("" ::: "memory");
                }
            if (km_on) {
#pragma unroll
                for (int i = 0; i < 16; ++i) { float s = cs[i]; s += shfl_l(s, ln_ ^ 1); s += shfl_l(s, ln_ ^ 2); s += shfl_l(s, ln_ ^ 4); s += shfl_l(s, ln_ ^ 8); cs[i] = s; }
                if (fr == 0) { float* kp = kmean + (((size_t)(u.pm >> 3) * 6 + (head - 6)) * 8 + (u.pm & 7)) * 64 + fq * 8;
#pragma unroll
                    for (int bj = 0; bj < 2; ++bj)
#pragma unroll
                        for (int i = 0; i < 8; ++i) __hip_atomic_fetch_add(kp + bj * 32 + i, cs[bj * 8 + i] * (1.0f / 256.0f), __ATOMIC_RELAXED, __HIP_MEMORY_SCOPE_AGENT); }
            }
        }
    }
};
struct EpiGates8 {
    static constexpr bool PERM = true, AFTER_DRAIN = false, MIDK = false;
    bf16_t* G; bf16_t* V;
    __device__ __forceinline__ void operator()(const f32x4 (&acc)[2][2][4][2], const Unit& u, int wr, int wc, int, int) const {
        unsigned z_ = 0u; asm volatile("" : "+v"(z_)); const int ln_ = __builtin_amdgcn_mbcnt_hi(~0u, __builtin_amdgcn_mbcnt_lo(~0u, z_)); const int fr = ln_ & 15, fq = ln_ >> 4;
        const int row0 = u.pm * BM + wr * 64 + fr, col0 = u.pn * BM + wc * 32 + fq * 8;
        if (u.pn >= 12) {
            const int bb = (u.pm * BM) / SEQ, hv = (u.pn - 12) * 4 + wc, l2v = kv_l2d(hv); bf16_t* dst = V + ((size_t)bb * 24 + hv) * SEQ * 64 + fq * 8;
#pragma unroll
            for (int ai = 0; ai < 2; ++ai)
#pragma unroll
                for (int m = 0; m < 4; ++m) {
                    bf16_t* rowp = dst + (size_t)kv_row(row0 + ai * HALF + m * 16 - bb * SEQ, l2v) * 64;
#pragma unroll
                    for (int bj = 0; bj < 2; ++bj) { const f32x4 v0 = acc[ai][bj][m][0] * (1.0f / F8_WS), v1 = acc[ai][bj][m][1] * (1.0f / F8_WS);
                        u32x4 w; w.x = pk2(v0[0], v0[1]); w.y = pk2(v0[2], v0[3]); w.z = pk2(v1[0], v1[1]); w.w = pk2(v1[2], v1[3]);
                        *(u32x4*)(rowp + bj * 32) = w; }
                    asm volatile("" ::: "memory");
                }
            return;
        }
        unsigned char* gp = (unsigned char*)G + ((size_t)(((u.pn >> 2) * 64 + u.pm) * 4 + (u.pn & 3)) << 16) + (wr * 4 + wc) * 8192 + ln_ * 16;
#pragma unroll
        for (int ai = 0; ai < 2; ++ai)
#pragma unroll
            for (int m = 0; m < 4; ++m) {
                unsigned w4[4] = {0u, 0u, 0u, 0u};
#pragma unroll
                for (int bj = 0; bj < 2; ++bj)
#pragma unroll
                    for (int i = 0; i < 4; ++i) {
                        w4[2 * bj] = __builtin_amdgcn_cvt_pk_u8_f32(fmaxf(255.0f * __builtin_amdgcn_rcpf(1.0f + __builtin_amdgcn_exp2f((-LOG2E / F8_WS) * acc[ai][bj][m][0][i])), 1.0f), i, w4[2 * bj]);
                        w4[2 * bj + 1] = __builtin_amdgcn_cvt_pk_u8_f32(fmaxf(255.0f * __builtin_amdgcn_rcpf(1.0f + __builtin_amdgcn_exp2f((-LOG2E / F8_WS) * acc[ai][bj][m][1][i])), 1.0f), i, w4[2 * bj + 1]); }
                *(u32x4*)(gp + (ai * 4 + m) * 1024) = (u32x4){w4[0], w4[1], w4[2], w4[3]};
                asm volatile("" ::: "memory");
            }
    }
};
struct GateOrder {
    int G, c;
    __device__ __forceinline__ bool next(int i, Unit& u) const {
        int L;
        if (G == 256) { if (c >= 128) { if (i >= 4) return false; L = (c - 128) + 128 * i; } else { if (i >= 2) return false; L = 512 + c + 128 * i; } }
        else { L = i * G + c; if (L >= 768) return false; }
        u.pm = L / 12; u.pn = L % 12; return true;
    }
    __device__ __forceinline__ void a_ready(const Unit&) const {}
    __device__ __forceinline__ void done(const Unit&) const {}
};
struct EpiBranch {
    static constexpr bool PERM = true, AFTER_DRAIN = false, MIDK = true; static constexpr int KT1 = 6, KT2 = 12;
    bf16_t* YB; const bf16_t* G;
    static __device__ __forceinline__ const unsigned char* gblock(const bf16_t* G, int g, int pm, int pn, int wave, int lane) { return (const unsigned char*)G + ((size_t)((g * 64 + pm) * 4 + pn) << 16) + wave * 8192 + lane * 16; }
    __device__ __forceinline__ void mid(f32x4 (&acc)[2][2][4][2], const Unit& u, int t, int wr, int wc, int, int) const {
        unsigned z_ = 0u; asm volatile("" : "+v"(z_)); const int ln_ = __builtin_amdgcn_mbcnt_hi(~0u, __builtin_amdgcn_mbcnt_lo(~0u, z_));
        const int g0 = (t == KT1) ? 0 : 1;
        const unsigned char* pa = gblock(G, g0, u.pm, u.pn, wr * 4 + wc, ln_); const unsigned char* pb = gblock(G, g0 + 1, u.pm, u.pn, wr * 4 + wc, ln_);
#pragma unroll
        for (int ai = 0; ai < 2; ++ai)
#pragma unroll
            for (int m = 0; m < 4; ++m) {
                const u32x4 ga = *(const u32x4*)(pa + (ai * 4 + m) * 1024), gb = *(const u32x4*)(pb + (ai * 4 + m) * 1024);
#pragma unroll
                for (int bj = 0; bj < 2; ++bj) { const unsigned ax = bj ? ga.z : ga.x, ay = bj ? ga.w : ga.y, bx = bj ? gb.z : gb.x, by = bj ? gb.w : gb.y;
                    f32x4 r0 = {ub8(ax, 0) * __builtin_amdgcn_rcpf(ub8(bx, 0)), ub8(ax, 1) * __builtin_amdgcn_rcpf(ub8(bx, 1)), ub8(ax, 2) * __builtin_amdgcn_rcpf(ub8(bx, 2)), ub8(ax, 3) * __builtin_amdgcn_rcpf(ub8(bx, 3))};
                    f32x4 r1 = {ub8(ay, 0) * __builtin_amdgcn_rcpf(ub8(by, 0)), ub8(ay, 1) * __builtin_amdgcn_rcpf(ub8(by, 1)), ub8(ay, 2) * __builtin_amdgcn_rcpf(ub8(by, 2)), ub8(ay, 3) * __builtin_amdgcn_rcpf(ub8(by, 3))};
                    acc[ai][bj][m][0] = acc[ai][bj][m][0] * r0; acc[ai][bj][m][1] = acc[ai][bj][m][1] * r1;
                }
            }
    }
    __device__ __forceinline__ void operator()(const f32x4 (&acc)[2][2][4][2], const Unit& u, int wr, int wc, int, int) const {
        unsigned z_ = 0u; asm volatile("" : "+v"(z_)); const int ln_ = __builtin_amdgcn_mbcnt_hi(~0u, __builtin_amdgcn_mbcnt_lo(~0u, z_)); const int fr = ln_ & 15, fq = ln_ >> 4;
        const int row0 = u.pm * BM + wr * 64 + fr, col0 = u.pn * BM + wc * 32 + fq * 8;
        const unsigned char* pg = gblock(G, 2, u.pm, u.pn, wr * 4 + wc, ln_);
        u32x4 gw[2][4];
#pragma unroll
        for (int ai = 0; ai < 2; ++ai)
#pragma unroll
            for (int m = 0; m < 4; ++m) gw[ai][m] = *(const u32x4*)(pg + (ai * 4 + m) * 1024);
        constexpr float k8 = 1.0f / 255.0f;
#pragma unroll
        for (int ai = 0; ai < 2; ++ai)
#pragma unroll
            for (int m = 0; m < 4; ++m) {
                const size_t row = (size_t)(row0 + ai * HALF + m * 16);
#pragma unroll
                for (int bj = 0; bj < 2; ++bj) {
                    const int col = col0 + bj * HALF; const unsigned gx = bj ? gw[ai][m].z : gw[ai][m].x, gy = bj ? gw[ai][m].w : gw[ai][m].y;
                    const f32x4 g0 = {ub8(gx, 0) * k8, ub8(gx, 1) * k8, ub8(gx, 2) * k8, ub8(gx, 3) * k8}, g1 = {ub8(gy, 0) * k8, ub8(gy, 1) * k8, ub8(gy, 2) * k8, ub8(gy, 3) * k8};
                    const f32x4 v0 = acc[ai][bj][m][0] * g0, v1 = acc[ai][bj][m][1] * g1;
                    u32x4 w; w.x = pk2(v0[0], v0[1]); w.y = pk2(v0[2], v0[3]); w.z = pk2(v1[0], v1[1]); w.w = pk2(v1[2], v1[3]); *(u32x4*)(YB + row * DM + col) = w;
                }
            }
    }
};

template <bool XBF> struct EpiResid {
    static constexpr bool PERM = true, AFTER_DRAIN = false, MIDK = false;
    const void* xin; bf16_t* xb; const float* gate; float rs;
    __device__ __forceinline__ void operator()(const f32x4 (&acc)[2][2][4][2], const Unit& u, int wr, int wc, int, int) const {
        unsigned z_ = 0u; asm volatile("" : "+v"(z_)); const int ln_ = __builtin_amdgcn_mbcnt_hi(~0u, __builtin_amdgcn_mbcnt_lo(~0u, z_)); const int fr = ln_ & 15, fq = ln_ >> 4;
        const int row0 = u.pm * BM + wr * 64 + fr, col0 = u.pn * BM + wc * 32 + fq * 8;
        const float* gp = gate + (size_t)((u.pm * BM) / SEQ) * 6144;
#pragma unroll
        for (int bj = 0; bj < 2; ++bj) {
            const int col = col0 + bj * HALF;
            const f32x4 g0 = *(const f32x4*)(gp + col) * rs, g1 = *(const f32x4*)(gp + col + 4) * rs;
            f32x4 xa[2][4], xc[2][4]; u32x4 xw[2][4];
#pragma unroll
            for (int ai = 0; ai < 2; ++ai)
#pragma unroll
                for (int m = 0; m < 4; ++m) {
                    const size_t off = (size_t)(row0 + ai * HALF + m * 16) * DM + col;
                    if (XBF) xw[ai][m] = *(const u32x4*)((const bf16_t*)xin + off);
                    else { xa[ai][m] = *(const f32x4*)((const float*)xin + off); xc[ai][m] = *(const f32x4*)((const float*)xin + off + 4); }
                }
#pragma unroll
            for (int ai = 0; ai < 2; ++ai)
#pragma unroll
                for (int m = 0; m < 4; ++m) {
                    const size_t off = (size_t)(row0 + ai * HALF + m * 16) * DM + col;
                    f32x4 x0, x1;
                    if (XBF) { const u32x4 q = xw[ai][m]; x0 = (f32x4){bflo(q.x), bfhi(q.x), bflo(q.y), bfhi(q.y)}; x1 = (f32x4){bflo(q.z), bfhi(q.z), bflo(q.w), bfhi(q.w)}; }
                    else { x0 = xa[ai][m]; x1 = xc[ai][m]; }
                    x0 = x0 + g0 * acc[ai][bj][m][0]; x1 = x1 + g1 * acc[ai][bj][m][1];
                    u32x4 w; w.x = pk2(x0[0], x0[1]); w.y = pk2(x0[2], x0[3]); w.z = pk2(x1[0], x1[1]); w.w = pk2(x1[2], x1[3]);
                    *(u32x4*)(xb + off) = w;
                }
            asm volatile("" ::: "memory");
        }
    }
};
struct EpiSwiglu {
    static constexpr bool PERM = true, AFTER_DRAIN = false, MIDK = false;
    bf16_t* ACT; int npn; float qs;
    __device__ __forceinline__ void operator()(const f32x4 (&acc)[2][2][4][2], const Unit& u, int wr, int wc, int, int) const {
        unsigned z_ = 0u; asm volatile("" : "+v"(z_)); const int ln_ = __builtin_amdgcn_mbcnt_hi(~0u, __builtin_amdgcn_mbcnt_lo(~0u, z_)); const int fr = ln_ & 15, fq = ln_ >> 4;
        const int row0 = u.pm * BM + wr * 64 + fr, col0 = (u.pn % npn) * HALF + wc * 32 + fq * 8;
#pragma unroll
        for (int ai = 0; ai < 2; ++ai)
#pragma unroll
            for (int m = 0; m < 4; ++m) {
                float s[8];
#pragma unroll
                for (int n = 0; n < 2; ++n)
#pragma unroll
                    for (int i = 0; i < 4; ++i) { const float g = acc[ai][0][m][n][i], up = acc[ai][1][m][n][i]; s[4 * n + i] = g * __builtin_amdgcn_rcpf(1.0f + __builtin_amdgcn_exp2f(-LOG2E * g)) * up; if (PROBE_FP8 && qs != 0.f) s[4 * n + i] = q8(s[4 * n + i], qs); }
                u32x4 w; w.x = pk2(s[0], s[1]); w.y = pk2(s[2], s[3]); w.z = pk2(s[4], s[5]); w.w = pk2(s[6], s[7]);
                *(u32x4*)(ACT + (size_t)(row0 + ai * HALF + m * 16) * DFF + col0) = w;
                asm volatile("" ::: "memory");
            }
    }
};
struct EpiSwiglu8 {
    static constexpr bool PERM = true, AFTER_DRAIN = false, MIDK = false;
    unsigned char* ACT; int npn; float sg, su;
    __device__ __forceinline__ void operator()(const f32x4 (&acc)[2][2][4][2], const Unit& u, int wr, int wc, int, int) const {
        unsigned z_ = 0u; asm volatile("" : "+v"(z_)); const int ln_ = __builtin_amdgcn_mbcnt_hi(~0u, __builtin_amdgcn_mbcnt_lo(~0u, z_)); const int fr = ln_ & 15, fq = ln_ >> 4;
        const int row0 = u.pm * BM + wr * 64 + fr, col0 = (u.pn % npn) * HALF + wc * 32 + fq * 8;
#pragma unroll
        for (int ai = 0; ai < 2; ++ai)
#pragma unroll
            for (int m = 0; m < 4; ++m) {
                float s[8];
#pragma unroll
                for (int n = 0; n < 2; ++n)
#pragma unroll
                    for (int i = 0; i < 4; ++i) { const float g = acc[ai][0][m][n][i] * sg, up = acc[ai][1][m][n][i] * su; s[4 * n + i] = g * __builtin_amdgcn_rcpf(1.0f + __builtin_amdgcn_exp2f(-LOG2E * g)) * up; }
                unsigned long long w = (unsigned long long)pk4_fp8(s[0], s[1], s[2], s[3]) | ((unsigned long long)pk4_fp8(s[4], s[5], s[6], s[7]) << 32);
                *(unsigned long long*)(ACT + (size_t)(row0 + ai * HALF + m * 16) * DFF + col0) = w;
                asm volatile("" ::: "memory");
            }
    }
};
struct EpiMoeY {
    static constexpr bool PERM = true, AFTER_DRAIN = false, MIDK = false;
    bf16_t* Y; const float* gate; const int* tok; const float* wrow; float sc;
    __device__ __forceinline__ void operator()(const f32x4 (&acc)[2][2][4][2], const Unit& u, int wr, int wc, int, int) const {
        unsigned z_ = 0u; asm volatile("" : "+v"(z_)); const int ln_ = __builtin_amdgcn_mbcnt_hi(~0u, __builtin_amdgcn_mbcnt_lo(~0u, z_)); const int fr = ln_ & 15, fq = ln_ >> 4;
        const int row0 = u.pm * BM + wr * 64 + fr, col0 = (u.pn & 3) * BM + wc * 32 + fq * 8;
        int ids[2][4]; float wsc[2][4];
#pragma unroll
        for (int ai = 0; ai < 2; ++ai)
#pragma unroll
            for (int m = 0; m < 4; ++m) { const int r = row0 + ai * HALF + m * 16; ids[ai][m] = tok[r]; wsc[ai][m] = wrow[r] * sc; }
#pragma unroll
        for (int ai = 0; ai < 2; ++ai) {
            f32x4 gq[4][2][2];
#pragma unroll
            for (int m = 0; m < 4; ++m) { const int id = ids[ai][m]; const float* gp = gate + (size_t)(((id >= 0) ? (id >> 1) : 0) / SEQ) * 6144;
#pragma unroll
                for (int bj = 0; bj < 2; ++bj) { gq[m][bj][0] = *(const f32x4*)(gp + col0 + bj * HALF); gq[m][bj][1] = *(const f32x4*)(gp + col0 + bj * HALF + 4); } }
#pragma unroll
            for (int m = 0; m < 4; ++m) { const int id = ids[ai][m];
                if (id >= 0) { const float w = wsc[ai][m];
#pragma unroll
                    for (int bj = 0; bj < 2; ++bj) {
                        const int col = col0 + bj * HALF; const f32x4 g0 = gq[m][bj][0] * w, g1 = gq[m][bj][1] * w;
                        const f32x4 v0 = acc[ai][bj][m][0] * g0, v1 = acc[ai][bj][m][1] * g1;
                        u32x4 o; o.x = pk2(v0[0], v0[1]); o.y = pk2(v0[2], v0[3]); o.z = pk2(v1[0], v1[1]); o.w = pk2(v1[2], v1[3]);
                        *(u32x4*)(Y + (size_t)id * DM + col) = o;
                    }
                }
            }
            asm volatile("" ::: "memory");
        }
    }
};
struct MoeOrder {
    StaticOrder so; const int* tmap; int npn;
    __device__ __forceinline__ bool next(int i, Unit& u) const { if (!so.next(i, u)) return false; u.pn += tmap[u.pm] * npn; return true; }
    __device__ __forceinline__ void a_ready(const Unit&) const {}
    __device__ __forceinline__ void done(const Unit&) const {}
};
}
#define XB_TMO      128
#define XB_XCNT(j)  (256  + 64 * (j))
#define XB_XSUB(j)  (1280 + 64 * (j))
#define XB_XGEN(j)  (2304 + 64 * (j))
#define XB_TOP      3328
#define XB_TOPGEN   3392
#define XCD_BAR_WORDS 3456
#define XB_SPIN_CAP (1u << 18)

__device__ __forceinline__ unsigned xb_ld(unsigned* p)              { return __hip_atomic_load(p, __ATOMIC_RELAXED, __HIP_MEMORY_SCOPE_AGENT); }
__device__ __forceinline__ unsigned xb_add(unsigned* p, unsigned v) { return __hip_atomic_fetch_add(p, v, __ATOMIC_RELAXED, __HIP_MEMORY_SCOPE_AGENT); }
__device__ __forceinline__ unsigned xb_xcc_id() { return (unsigned)__builtin_amdgcn_s_getreg((3 << 11) | 20) & 0xFu; }
#define XB_SPIN(cond, bar) do { unsigned _sp = 0; while (cond) { __builtin_amdgcn_s_sleep(1); \
    if ((++_sp & 255u) == 0u) { if (xb_ld(&(bar)[XB_TMO])) break; if (_sp > XB_SPIN_CAP) { atomicAdd(&(bar)[XB_TMO], 1u); break; } } } } while (0)

struct XcdBarrier {
    unsigned* bar; unsigned x;
    volatile LAS unsigned* st;
};

__device__ __forceinline__ XcdBarrier xcd_barrier_post(unsigned* bar, volatile LAS unsigned* st, bool t0) {
    XcdBarrier b; b.bar = bar; b.x = xb_xcc_id(); b.st = st;
    if (t0) (void)xb_add(&bar[XB_XCNT(b.x)], 1u);
    return b;
}
__device__ __forceinline__ void xcd_barrier_complete(unsigned* bar, unsigned x, unsigned& nloc, unsigned& nx) {
    const unsigned G = gridDim.x * gridDim.y * gridDim.z;
    unsigned sum, cnt, mine, sp = 0u;
    for (;;) {
        sum = 0u; cnt = 0u; mine = 0u;
#pragma unroll
        for (unsigned j = 0; j < 16; ++j) { const unsigned c = xb_ld(&bar[XB_XCNT(j)]); sum += c; cnt += (c > 0u) ? 1u : 0u; mine = (j == x) ? c : mine; }
        if (sum == G) break;
        __builtin_amdgcn_s_sleep(1);
        if ((++sp & 255u) == 0u) { if (xb_ld(&bar[XB_TMO])) break; if (sp > XB_SPIN_CAP) { atomicAdd(&bar[XB_TMO], 1u); break; } }
    }
    nloc = mine > 0u ? mine : 1u; nx = cnt > 0u ? cnt : 1u;
}

__device__ __forceinline__ void xcd_barrier(const XcdBarrier& b, int wave_k) {
    asm volatile("s_waitcnt vmcnt(0)" ::: "memory");
    __syncthreads();
    if (wave_k == 0 && lane_opq() == 0) {
        unsigned* bar = b.bar;
        __builtin_amdgcn_s_waitcnt(0);
        unsigned nloc = b.st[0], nx = b.st[1];
        if (nloc == 0u) { xcd_barrier_complete(bar, b.x, nloc, nx); b.st[0] = nloc; b.st[1] = nx; }
        const unsigned old = xb_add(&bar[XB_XSUB(b.x)], 1u);
        const unsigned gen = old / nloc;
        if (old + 1u == (gen + 1u) * nloc) {
            __builtin_amdgcn_fence(__ATOMIC_RELEASE, "agent");
            asm volatile("s_waitcnt vmcnt(0)" ::: "memory");
            const unsigned og = xb_add(&bar[XB_TOP], 1u);
            const unsigned tg = og / nx;
            if (og + 1u == (tg + 1u) * nx) xb_add(&bar[XB_TOPGEN], 1u);
            else XB_SPIN(xb_ld(&bar[XB_TOPGEN]) == tg, bar);
            __builtin_amdgcn_fence(__ATOMIC_ACQUIRE, "agent");
            xb_add(&bar[XB_XGEN(b.x)], 1u);
            asm volatile("s_waitcnt vmcnt(0)" ::: "memory");
        } else {
            XB_SPIN(xb_ld(&bar[XB_XGEN(b.x)]) == gen, bar);
            __builtin_amdgcn_fence(__ATOMIC_ACQUIRE, "agent");
            asm volatile("s_waitcnt vmcnt(0)" ::: "memory");
        }
    }
    __syncthreads();
}

struct ConvItem { const float* src; size_t ldw; unsigned char* dst; int ldk; int fp8; };
typedef float f32x4u __attribute__((ext_vector_type(4), aligned(4)));
__device__ __forceinline__ void conv_load(const ConvItem& d, float (&v)[32], int lane) {
#pragma unroll
    for (int j = 0; j < 8; ++j) { const f32x4u x = __builtin_nontemporal_load((const f32x4u*)(d.src + (size_t)((lane >> 3) + 8 * j) * d.ldw + 4 * (lane & 7)));
        v[4 * j] = x.x; v[4 * j + 1] = x.y; v[4 * j + 2] = x.z; v[4 * j + 3] = x.w; }
}
__device__ __forceinline__ void conv_store(const ConvItem& d, const float (&v)[32], LAS float* scr, int lane) {
    const float qs = d.fp8 ? F8_WS : 1.0f;
#pragma unroll
    for (int j = 0; j < 8; ++j)
#pragma unroll
        for (int e = 0; e < 4; ++e) scr[((lane >> 3) + 8 * j) * 33 + 4 * (lane & 7) + e] = v[4 * j + e] * qs;
    LDS_WAIT(); asm volatile("" ::: "memory");
    if (d.fp8) { const int c = lane & 3;
#pragma unroll
        for (int j = 0; j < 2; ++j) { const int n = (lane >> 2) + 16 * j; const LAS float* s = scr + (16 * c) * 33 + n;
            v4u o; o.x = pk4_fp8(s[0 * 33], s[1 * 33], s[2 * 33], s[3 * 33]); o.y = pk4_fp8(s[4 * 33], s[5 * 33], s[6 * 33], s[7 * 33]);
            o.z = pk4_fp8(s[8 * 33], s[9 * 33], s[10 * 33], s[11 * 33]); o.w = pk4_fp8(s[12 * 33], s[13 * 33], s[14 * 33], s[15 * 33]);
            *(GAS v4u*)(d.dst + (size_t)n * d.ldk + 16 * c) = o; } }
    else { const int c = lane & 7;
#pragma unroll
        for (int j = 0; j < 4; ++j) { const int n = (lane >> 3) + 8 * j; const LAS float* s = scr + (8 * c) * 33 + n;
            v4u o; o.x = pk2(s[0 * 33], s[1 * 33]); o.y = pk2(s[2 * 33], s[3 * 33]); o.z = pk2(s[4 * 33], s[5 * 33]); o.w = pk2(s[6 * 33], s[7 * 33]);
            *(GAS v4u*)(d.dst + (size_t)n * d.ldk + 16 * c) = o; } }
    LDS_WAIT(); asm volatile("" ::: "memory");
}
__device__ __forceinline__ int map_qkv(int c0) { const int sec = c0 / QW, cs = c0 % QW, head = cs >> 6, bj = (cs >> 5) & 1; return sec * QW + (head >> 2) * 256 + bj * 128 + (head & 3) * 32; }
__device__ __forceinline__ int map_gu(int c0, int up) { return (c0 >> 7) * 256 + up * 128 + (c0 & 96); }

struct KArgs { const float* in[22]; float* out; unsigned char* ws; int ph_lo, ph_hi; };
__device__ __forceinline__ const float* karg_ptr(int i) { int j = i; asm volatile("" : "+s"(j));
    const __attribute__((address_space(4))) unsigned long long* kp = (const __attribute__((address_space(4))) unsigned long long*)__builtin_amdgcn_kernarg_segment_ptr(); return (const float*)(const GAS float*)kp[j]; }
#define AIN(k) karg_ptr(k)
#define AOUT ((float*)karg_ptr(22))

constexpr int CONV_PER_LAYER = 2304 + 1536 + 192 + 192 + 128 + 512, CONV_NITEMS = 2 * CONV_PER_LAYER + 9 * 4224;
__device__ __forceinline__ void conv_decode(int it, GAS unsigned char* ws, ConvItem& d) {
    d.fp8 = 0;
    if (it < 2 * CONV_PER_LAYER) {
        const int l = it / CONV_PER_LAYER; int r = it % CONV_PER_LAYER;
        const float* win = AIN(6) + (size_t)l * DM * IN_COLS;
        if (r < 2304) { const int kb = r / 144, nb = r % 144; d.src = win + (size_t)(64 * kb) * IN_COLS + 32 * nb; d.ldw = IN_COLS;
            if (V_FP8 && nb >= 96) { d.ldk = DM; d.fp8 = 1;
                d.dst = (unsigned char*)(ws + WS_WIN) + (size_t)l * 15 * MiB + WS_WG8_OFF + (size_t)map_qkv(32 * nb) * DM + 64 * kb; return; }
            d.ldk = DM * 2; d.dst = (unsigned char*)(ws + WS_WIN) + (size_t)l * 15 * MiB + (size_t)map_qkv(32 * nb) * DM * 2 + 64 * kb * 2; return; } r -= 2304;
        if (r < 1536) { const int kb = 2 * (r / 192) + (r & 1), nb = (r >> 1) % 96;
            d.src = win + (size_t)(64 * kb) * IN_COLS + 4614 + 32 * nb; d.ldw = IN_COLS; d.ldk = DM; d.fp8 = 1;
            d.dst = (unsigned char*)(ws + WS_WIN) + (size_t)l * 15 * MiB + WS_WG8_OFF + (size_t)(32 * nb) * DM + 64 * kb; return; } r -= 1536;
        unsigned char* wbr = (unsigned char*)(ws + WS_WBR) + (size_t)l * DM * DM * 2;
        if (r < 192) { const int kb = r / 32, nb = r % 32; d.src = AIN(10) + (size_t)l * FOXW * DM + (size_t)(64 * kb) * DM + 32 * nb; d.ldw = DM; d.ldk = DM * 2; d.dst = wbr + (size_t)(32 * nb) * DM * 2 + (64 * kb) * 2; return; } r -= 192;
        if (r < 192) { const int kb = r / 32, nb = r % 32; d.src = AIN(11) + (size_t)l * MOBW * DM + (size_t)(64 * kb) * DM + 32 * nb; d.ldw = DM; d.ldk = DM * 2; d.dst = wbr + (size_t)(32 * nb) * DM * 2 + (384 + 64 * kb) * 2; return; } r -= 192;
        if (r < 128) { const int kb = r / 32, nb = r % 32; d.src = AIN(12) + (size_t)l * DILW * DM + (size_t)(64 * kb) * DM + 32 * nb; d.ldw = DM; d.ldk = DM * 2; d.dst = wbr + (size_t)(32 * nb) * DM * 2 + (768 + 64 * kb) * 2; return; } r -= 128;
        { const int kb = r / 32, nb = r % 32; d.src = AIN(13) + (size_t)l * DM * DM + (size_t)(64 * kb) * DM + 32 * nb; d.ldw = DM; d.ldk = DM * 2;
          d.dst = (unsigned char*)(ws + WS_WOUT) + (size_t)l * DM * DM * 2 + (size_t)(32 * nb) * DM * 2 + (64 * kb) * 2; return; }
    }
    const int q = it - 2 * CONV_PER_LAYER, ex = q / 4224; int r = q % 4224;
    const int f8 = ((ex > 0 && MOE_FP8) || (ex == 0 && DENSE2_FP8 && r >= 2816)) ? 1 : 0, eb = f8 ? 1 : 2;
    const size_t e = ex > 0 ? ex - 1 : 0;
    const float* wg = ex == 0 ? AIN(14) : AIN(19) + e * DM * DFF; const float* wu = ex == 0 ? AIN(15) : AIN(20) + e * DM * DFF; const float* wd = ex == 0 ? AIN(16) : AIN(21) + e * DFF * DM;
    unsigned char* w1t = ex == 0 ? (unsigned char*)(ws + WS_WF1) : (unsigned char*)(ws + WS_WE1) + e * 5632 * DM * eb;
    unsigned char* w2t = ex == 0 ? (unsigned char*)(ws + WS_WF2) : (unsigned char*)(ws + WS_WE2) + e * DM * DFF * eb;
    d.fp8 = f8;
    if (r < 2816) { const int up = r >= 1408; r -= up * 1408; const int kb = 2 * (r / 176) + (r & 1), nb = (r >> 1) % 88;
        d.src = (up ? wu : wg) + (size_t)(64 * kb) * DFF + 32 * nb; d.ldw = DFF; d.ldk = DM * eb;
        d.dst = w1t + ((size_t)map_gu(32 * nb, up) * DM + 64 * kb) * eb; return; } r -= 2816;
    { const int kb = 2 * (r / 64) + (r & 1), nb = (r >> 1) % 32;
      d.src = wd + (size_t)(64 * kb) * DM + 32 * nb; d.ldw = DM; d.ldk = DFF * eb; d.dst = w2t + ((size_t)(32 * nb) * DFF + 64 * kb) * eb; }
}
__device__ __forceinline__ void phase_mods(GAS unsigned char* ws, LAS unsigned char* lds, int tid, int lane, int wave) {
    __syncthreads();
    {
        LAS float* cond = (LAS float*)lds;
        LAS float* part = (LAS float*)(lds + 32768);
        const float* c = AIN(1);
        { float cv[NB * DM / NTHR];
#pragma unroll
          for (int i = 0; i < NB * DM / NTHR; ++i) cv[i] = c[tid + NTHR * i];
#pragma unroll
          for (int i = 0; i < NB * DM / NTHR; ++i) cond[tid + NTHR * i] = cv[i] / (1.0f + __expf(-cv[i])); }
        __syncthreads();
        float* mods = (float*)(ws + WS_MODS);
        for (int u = blockIdx.x; u < 2 * 96; u += gridDim.x) {
            const int l = u / 96, cg = u % 96, col = tid & 63, ks = tid >> 6;
            const float* w = AIN(2) + (size_t)l * DM * 6144 + cg * 64 + col;
            float acc[8];
#pragma unroll
            for (int b = 0; b < 8; ++b) acc[b] = 0.f;
            for (int k0 = ks * 128; k0 < ks * 128 + 128; k0 += 32) {
                float wv[32];
#pragma unroll
                for (int kk = 0; kk < 32; ++kk) wv[kk] = w[(size_t)(k0 + kk) * 6144];
#pragma unroll
                for (int kk = 0; kk < 32; ++kk) {
#pragma unroll
                    for (int b = 0; b < 8; ++b) acc[b] += cond[b * DM + k0 + kk] * wv[kk]; }
            }
#pragma unroll
            for (int b = 0; b < 8; ++b) part[(ks * 8 + b) * 64 + col] = acc[b];
            __syncthreads();
            { const int b = tid >> 6; float s = 0.f;
#pragma unroll
              for (int k2 = 0; k2 < 8; ++k2) s += part[(k2 * 8 + b) * 64 + col];
              mods[((size_t)l * NB + b) * 6144 + cg * 64 + col] = s + AIN(3)[(size_t)l * 6144 + cg * 64 + col]; }
            __syncthreads();
        }
        __syncthreads();
    }
    if (blockIdx.x == gridDim.x - 1) { float* gains = (float*)(ws + WS_GAINS);
        float t_[2 * 2 * QW / NTHR];
#pragma unroll
        for (int j = 0; j < 2 * 2 * QW / NTHR; ++j) { const int i = tid + NTHR * j, l = i / (2 * QW), r = i % (2 * QW); t_[j] = (r < QW) ? AIN(8)[l * QW + r] * C2 : AIN(9)[l * QW + r - QW]; }
#pragma unroll
        for (int j = 0; j < 2 * 2 * QW / NTHR; ++j) gains[tid + NTHR * j] = t_[j]; }
}
__device__ __forceinline__ void conv_run(GAS unsigned char* ws, LAS unsigned char* lds, int lane, int wave, int first, int stride, int end) {
    LAS float* scr = (LAS float*)(lds + wave * 16384);
    ConvItem cur, nxt; float va[32], vb[32];
    int it = first;
    if (it < end) { conv_decode(it, ws, cur); conv_load(cur, va, lane); }
    for (; it < end; it += 2 * stride) {
        const bool h1 = it + stride < end, h2 = it + 2 * stride < end;
        if (h1) { conv_decode(it + stride, ws, nxt); conv_load(nxt, vb, lane); }
        conv_store(cur, va, scr, lane);
        if (h2) { conv_decode(it + 2 * stride, ws, cur); conv_load(cur, va, lane); }
        if (h1) conv_store(nxt, vb, scr, lane);
    }
}
__device__ __forceinline__ void conv_run4(GAS unsigned char* ws, LAS unsigned char* lds, int lane, int wave, int first, int stride, int end) {
    LAS float* scr = (LAS float*)(lds + wave * 16384);
    ConvItem c0, c1, c2, c3; float v0[32], v1[32], v2[32], v3[32];
    const bool h0 = first < end, h1 = first + stride < end, h2 = first + 2 * stride < end, h3 = first + 3 * stride < end;
    if (h0) { conv_decode(first, ws, c0); conv_load(c0, v0, lane); }
    if (h1) { conv_decode(first + stride, ws, c1); conv_load(c1, v1, lane); }
    if (h2) { conv_decode(first + 2 * stride, ws, c2); conv_load(c2, v2, lane); }
    if (h3) { conv_decode(first + 3 * stride, ws, c3); conv_load(c3, v3, lane); }
    if (h0) conv_store(c0, v0, scr, lane);
    if (h1) conv_store(c1, v1, scr, lane);
    if (h2) conv_store(c2, v2, scr, lane);
    if (h3) conv_store(c3, v3, scr, lane);
}
__device__ __forceinline__ void conv_run8(GAS unsigned char* ws, LAS unsigned char* lds, int lane, int wave, int first, int stride, int end) {
    LAS float* scr = (LAS float*)(lds + wave * 16384);
    ConvItem c0, c1, c2, c3; float v0[32], v1[32], v2[32], v3[32];
#define CR8_H(k) (first + (k) * stride < end)
    if (CR8_H(0)) { conv_decode(first, ws, c0); conv_load(c0, v0, lane); }
    if (CR8_H(1)) { conv_decode(first + stride, ws, c1); conv_load(c1, v1, lane); }
    if (CR8_H(2)) { conv_decode(first + 2 * stride, ws, c2); conv_load(c2, v2, lane); }
    if (CR8_H(3)) { conv_decode(first + 3 * stride, ws, c3); conv_load(c3, v3, lane); }
    if (CR8_H(0)) conv_store(c0, v0, scr, lane);
    if (CR8_H(4)) { conv_decode(first + 4 * stride, ws, c0); conv_load(c0, v0, lane); }
    if (CR8_H(1)) conv_store(c1, v1, scr, lane);
    if (CR8_H(5)) { conv_decode(first + 5 * stride, ws, c1); conv_load(c1, v1, lane); }
    if (CR8_H(2)) conv_store(c2, v2, scr, lane);
    if (CR8_H(6)) { conv_decode(first + 6 * stride, ws, c2); conv_load(c2, v2, lane); }
    if (CR8_H(3)) conv_store(c3, v3, scr, lane);
    if (CR8_H(7)) { conv_decode(first + 7 * stride, ws, c3); conv_load(c3, v3, lane); }
    if (CR8_H(4)) conv_store(c0, v0, scr, lane);
    if (CR8_H(5)) conv_store(c1, v1, scr, lane);
    if (CR8_H(6)) conv_store(c2, v2, scr, lane);
    if (CR8_H(7)) conv_store(c3, v3, scr, lane);
#undef CR8_H
}
constexpr int CONV_FIRST = 2304 + 1536, CONV_SPLIT = 2 * CONV_PER_LAYER + 5 * 4224, CONV_UNIT = 64;
__device__ __forceinline__ void phase_convert(GAS unsigned char* ws, LAS unsigned char* lds, int tid, int lane, int wave) {
    __syncthreads();
    conv_run(ws, lds, lane, wave, blockIdx.x * NWAVES + wave, gridDim.x * NWAVES, CONV_FIRST);
}

template <int MODE, bool XBF>
__device__ __forceinline__ void phase_norm(const void* xs, const float* gain, const float* mods  , int shift_off, int scale_off,
                                           bf16* hout, unsigned char* h8out, const float* win, const float* bfg, float* flog, const float* wr, const float* br, int* sel, float* wt, int* rcnt, int* tok, float* wrow, int* tile_e,
                                           LAS unsigned char* lds, int tid, int lane, int wave) {
    LAS float* wf = (LAS float*)lds;
    if (MODE == 0) { float t_[6 * DM / NTHR];
#pragma unroll
        for (int j = 0; j < 6 * DM / NTHR; ++j) { const int i = tid + NTHR * j, hh = i / DM, k = i % DM; t_[j] = win[(size_t)k * IN_COLS + 4608 + hh]; }
#pragma unroll
        for (int j = 0; j < 6 * DM / NTHR; ++j) wf[tid + NTHR * j] = t_[j];
        __syncthreads(); }
    if (MODE == 2) { float t_[8 * DM / NTHR];
#pragma unroll
        for (int j = 0; j < 8 * DM / NTHR; ++j) { const int i = tid + NTHR * j, e = i / DM, k = i % DM; t_[j] = wr[(size_t)k * NE + e]; }
#pragma unroll
        for (int j = 0; j < 8 * DM / NTHR; ++j) wf[tid + NTHR * j] = t_[j];
        __syncthreads(); }
    const int gw = blockIdx.x * NWAVES + wave, NGW = gridDim.x * NWAVES;
    const int tpw = (M + NGW - 1) / NGW;
    int cntv = 0;
    if (MODE == 3) {
        LAS int* part = (LAS int*)lds;
        LAS int* tab = (LAS int*)(lds + 2048);
        const int cpp = (NGW + 63) / 64, g0 = blockIdx.x * NWAVES;
        { const int e = tid & 7, p = tid >> 3; int s = 0;
          if (cpp <= 32) { int t_[32];
#pragma unroll
              for (int q = 0; q < 32; ++q) { const int gi = p * cpp + q; t_[q] = (q < cpp && gi < NGW) ? rcnt[gi * 8 + e] : 0; }
#pragma unroll
              for (int q = 0; q < 32; ++q) s += t_[q]; }
          else for (int gi = p * cpp; gi < (p + 1) * cpp && gi < NGW; ++gi) s += rcnt[gi * 8 + e];
          part[p * 8 + e] = s; }
        __syncthreads();
        if (tid < 8) { int T = 0, S = 0; const int pf = g0 / cpp; for (int p = 0; p < 64; ++p) { const int x = part[p * 8 + tid]; T += x; if (p < pf) S += x; }
            if (cpp <= 32) { int t_[32];
#pragma unroll
                for (int q = 0; q < 32; ++q) { const int gi = pf * cpp + q; t_[q] = (gi < g0) ? rcnt[gi * 8 + tid] : 0; }
#pragma unroll
                for (int q = 0; q < 32; ++q) S += t_[q]; }
            else for (int gi = pf * cpp; gi < g0; ++gi) S += rcnt[gi * 8 + tid];
            tab[tid] = T; tab[8 + tid] = S; }
        __syncthreads();
        if (tid == 0) { int bse = 0; for (int e = 0; e < 8; ++e) { tab[16 + e] = bse; bse += (tab[e] + 255) & ~255; } tab[24] = bse; }
        __syncthreads();
        if (lane < 8) { int v = tab[16 + lane] + tab[8 + lane]; int t_[NWAVES];
#pragma unroll
            for (int w = 0; w < NWAVES; ++w) t_[w] = (w < wave) ? rcnt[(g0 + w) * 8 + lane] : 0;
#pragma unroll
            for (int w = 0; w < NWAVES; ++w) v += t_[w];
            cntv = v; }
        if (blockIdx.x == 0) {
            for (int e = 0; e < 8; ++e) { const int lo_ = tab[16 + e] + tab[e], hi_ = tab[16 + e + 1]; for (int p = lo_ + tid; p < hi_; p += NTHR) { tok[p] = -1; wrow[p] = 0.f; }
                for (int i = tab[16 + e] / 256 + tid; i < hi_ / 256; i += NTHR) tile_e[i] = e; }
            if (tid == 0) tile_e[255] = tab[24] / 256;
        }
    }
    f32x4 g[4], sc[4], sh[4]; int curb = -1;
    float bfl = 0.f;
    if (MODE == 0) { if ((lane & 7) < 6) bfl = bfg[lane & 7]; }
    if (MODE == 2) bfl = br[lane & 7];
#pragma unroll
    for (int j = 0; j < 4; ++j) g[j] = *(const f32x4*)(gain + 4 * lane + 256 * j);
#define NRM_LOAD(RF, RH, mm) do { _Pragma("unroll") for (int j_ = 0; j_ < 4; ++j_) { \
        if (XBF) RH[j_] = *((const GAS unsigned long long*)((const bf16*)xs + (size_t)(mm) * DM + 256 * j_) + lane); \
        else RF[j_] = *(const f32x4*)((const float*)xs + (size_t)(mm) * DM + 4 * lane + 256 * j_); } } while (0)
    const int m0 = gw * tpw, m1 = ((gw + 1) * tpw < M) ? (gw + 1) * tpw : M;
    int selv = 0; float wtv = 0.f;
    const bool pre3 = (MODE == 3) && tpw <= 32;
    if (pre3) { if (2 * m0 + lane < 2 * m1) { selv = sel[2 * m0 + lane]; wtv = wt[2 * m0 + lane]; } }
    f32x4 curf[4], nxtf[4]; unsigned long long curh[4], nxth[4];
#pragma unroll
    for (int j = 0; j < 4; ++j) { curf[j] = (f32x4){0.f, 0.f, 0.f, 0.f}; nxtf[j] = curf[j]; curh[j] = 0ull; nxth[j] = 0ull; }
    if (m0 < m1) NRM_LOAD(curf, curh, m0);
    for (int m = m0; m < m1; ++m) {
        if (m + 1 < m1) NRM_LOAD(nxtf, nxth, m + 1);
        const int b = m / SEQ;
        if (b != curb) { curb = b;
#pragma unroll
            for (int j = 0; j < 4; ++j) { sc[j] = *(const f32x4*)(mods + (size_t)b * 6144 + scale_off + 4 * lane + 256 * j); sh[j] = *(const f32x4*)(mods + (size_t)b * 6144 + shift_off + 4 * lane + 256 * j); } }
        f32x4 v[4]; float ss = 0.f;
#pragma unroll
        for (int j = 0; j < 4; ++j) {
            if (XBF) { const unsigned lo_ = (unsigned)curh[j], hi_ = (unsigned)(curh[j] >> 32); v[j] = (f32x4){bflo(lo_), bfhi(lo_), bflo(hi_), bfhi(hi_)}; }
            else v[j] = curf[j];
            ss += (v[j].x * v[j].x + v[j].y * v[j].y) + (v[j].z * v[j].z + v[j].w * v[j].w); }
#pragma unroll
        for (int j = 0; j < 4; ++j) { curf[j] = nxtf[j]; curh[j] = nxth[j]; }
        const float rstd = __builtin_amdgcn_rsqf(wave_sum(ss) * (1.0f / DM) + RMS_EPS);
#pragma unroll
        for (int j = 0; j < 4; ++j) v[j] = v[j] * rstd * g[j] * (sc[j] + 1.0f) + sh[j];
        if (MODE == 1 && PROBE_FP8 == 2) {
#pragma unroll
            for (int j = 0; j < 4; ++j) { v[j].x = q8(v[j].x, 1.f); v[j].y = q8(v[j].y, 1.f); v[j].z = q8(v[j].z, 1.f); v[j].w = q8(v[j].w, 1.f); } }
        if (MODE == 0 || MODE == 1) {
            GAS unsigned long long* o8 = (GAS unsigned long long*)(hout + (size_t)m * DM) + lane;
#pragma unroll
            for (int j = 0; j < 4; ++j) o8[64 * j] = (unsigned long long)pk2(v[j].x, v[j].y) | ((unsigned long long)pk2(v[j].z, v[j].w) << 32);
        }
        if (MODE == 0) { GAS unsigned* o4 = (GAS unsigned*)(h8out + (size_t)m * DM) + lane;
#pragma unroll
            for (int j = 0; j < 4; ++j) o4[64 * j] = pk4_fp8(v[j].x, v[j].y, v[j].z, v[j].w); }
        if (MODE == 3) {
            if (PROBE_FP8) {
#pragma unroll
                for (int j = 0; j < 4; ++j) { v[j].x = q8(v[j].x, 1.f); v[j].y = q8(v[j].y, 1.f); v[j].z = q8(v[j].z, 1.f); v[j].w = q8(v[j].w, 1.f); } }
#pragma unroll
            for (int k2 = 0; k2 < 2; ++k2) { const int ex = pre3 ? shfl_li(selv, 2 * (m - m0) + k2) : sel[2 * m + k2]; const float wk = pre3 ? shfl_l(wtv, 2 * (m - m0) + k2) : wt[2 * m + k2]; const int p = shfl_li(cntv, ex); if (lane == ex) ++cntv;
                if (lane == 0) { tok[p] = 2 * m + k2; wrow[p] = wk; }
                if (MOE_FP8) { GAS unsigned* o4 = (GAS unsigned*)((unsigned char*)hout + (size_t)p * DM) + lane;
#pragma unroll
                    for (int j = 0; j < 4; ++j) o4[64 * j] = pk4_fp8(v[j].x, v[j].y, v[j].z, v[j].w); }
                else { GAS unsigned long long* o8 = (GAS unsigned long long*)(hout + (size_t)p * DM) + lane;
#pragma unroll
                    for (int j = 0; j < 4; ++j) o8[64 * j] = (unsigned long long)pk2(v[j].x, v[j].y) | ((unsigned long long)pk2(v[j].z, v[j].w) << 32); } }
        }
        if (MODE == 0) {
            const int t = m % SEQ;
            float dd[8];
#pragma unroll
            for (int hh = 0; hh < 8; ++hh) { float d = 0.f;
                if (hh < 6) {
#pragma unroll
                    for (int j = 0; j < 4; ++j) { const f32x4 w = *(const LAS f32x4*)(wf + hh * DM + 4 * lane + 256 * j); d += (v[j].x * w.x + v[j].y * w.y) + (v[j].z * w.z + v[j].w * w.w); } }
                dd[hh] = d; }
            const float d = wave_reduce8(dd, lane) + bfl;
            if (lane < 6) flog[((size_t)b * 6 + lane) * SEQ + t] = fminf(d, 0.f) * LOG2E - __builtin_amdgcn_logf(1.0f + __builtin_amdgcn_exp2f(-fabsf(d) * LOG2E));
        }
        if (MODE == 2) {
            float lg[8];
#pragma unroll
            for (int e = 0; e < 8; ++e) { float d = 0.f;
#pragma unroll
                for (int j = 0; j < 4; ++j) { const f32x4 w = *(const LAS f32x4*)(wf + e * DM + 4 * lane + 256 * j); d += (v[j].x * w.x + v[j].y * w.y) + (v[j].z * w.z + v[j].w * w.w); }
                lg[e] = d; }
            { const float tot = wave_reduce8(lg, lane) + bfl;
#pragma unroll
              for (int e = 0; e < 8; ++e) lg[e] = shfl_l(tot, e); }
            int i0 = 0; float v0 = lg[0];
#pragma unroll
            for (int e = 1; e < 8; ++e) if (lg[e] > v0) { v0 = lg[e]; i0 = e; }
            int i1 = -1; float v1 = -3.0e38f;
#pragma unroll
            for (int e = 0; e < 8; ++e) if (e != i0 && lg[e] > v1) { v1 = lg[e]; i1 = e; }
            const float e1 = __expf(v1 - v0), w0 = 1.0f / (1.0f + e1), w1 = e1 / (1.0f + e1);
            if (lane == 0) { sel[2 * m] = i0; sel[2 * m + 1] = i1; wt[2 * m] = w0; wt[2 * m + 1] = w1; }
            if (lane == i0 || lane == i1) ++cntv;
        }
    }
    if (MODE == 2) { if (lane < 8) rcnt[gw * 8 + lane] = cntv; }
}

__device__ __forceinline__ void phase_scan(const float* flog, float* fcum, const bf16* K, float* kmean, LAS unsigned char* lds, int tid, int lane, int wave) {
    LAS float* wtot = (LAS float*)lds;
    for (int u = blockIdx.x; u < NB * 6; u += gridDim.x) {
        const f32x4 f = *(const f32x4*)(flog + (size_t)u * SEQ + 4 * tid);
        float a[4];
#pragma unroll
        for (int i = 0; i < 4; ++i) { const float x = f[i]; a[i] = (fminf(x, 0.f) - log1pf(expf(-fabsf(x)))) * LOG2E; }
        a[1] += a[0]; a[2] += a[1]; a[3] += a[2];
        float incl = a[3];
#pragma unroll
        for (int o = 1; o < 64; o <<= 1) { const float t = shfl_l(incl, (lane - o) & 63); if (lane >= o) incl += t; }
        if (lane == 63) wtot[wave] = incl;
        __syncthreads();
        float base = incl - a[3];
        for (int w = 0; w < wave; ++w) base += wtot[w];
        f32x4 o = {a[0] + base, a[1] + base, a[2] + base, a[3] + base};
        *(f32x4*)(fcum + (size_t)u * SEQ + 4 * tid) = o;
        __syncthreads();
    }
    const int gw = blockIdx.x * NWAVES + wave, NGW = gridDim.x * NWAVES;
    for (int it = gw; it < NB * 6 * 8; it += NGW) {
        const int b = it / 48, hm = (it / 8) % 6, blk = it % 8;
        const bf16* kp = K + ((size_t)b * SEQ + blk * 256) * QW + (6 + hm) * 64 + lane;
        float s = 0.f;
        for (int i = 0; i < 256; ++i) s += bflo((unsigned)kp[(size_t)i * QW]);
        kmean[(size_t)it * 64 + lane] = s * (1.0f / 256.0f);
    }
}

__device__ __forceinline__ void phase_moe_combine(float* out, const bf16* XB, const bf16* Y, int tid) {
    const int stride = gridDim.x * NTHR, NIT = M * (DM / 8);
    for (int it0 = blockIdx.x * NTHR + tid; it0 < NIT; it0 += 4 * stride) {
        v4u a[4], bq[4], x[4];
#pragma unroll
        for (int q = 0; q < 4; ++q) { const int it = it0 + q * stride; if (it < NIT) { const int t = it >> 7, ch = it & 127;
            a[q] = *(const v4u*)(Y + (size_t)(2 * t) * DM + ch * 8); bq[q] = *(const v4u*)(Y + (size_t)(2 * t + 1) * DM + ch * 8); x[q] = *(const v4u*)(XB + (size_t)t * DM + ch * 8); } }
#pragma unroll
        for (int q = 0; q < 4; ++q) { const int it = it0 + q * stride; if (it < NIT) { const int t = it >> 7, ch = it & 127;
            float* op = out + (size_t)t * DM + ch * 8;
            f32x4 x0, x1;
            x0.x = bflo(x[q].x) + (bflo(a[q].x) + bflo(bq[q].x)); x0.y = bfhi(x[q].x) + (bfhi(a[q].x) + bfhi(bq[q].x)); x0.z = bflo(x[q].y) + (bflo(a[q].y) + bflo(bq[q].y)); x0.w = bfhi(x[q].y) + (bfhi(a[q].y) + bfhi(bq[q].y));
            x1.x = bflo(x[q].z) + (bflo(a[q].z) + bflo(bq[q].z)); x1.y = bfhi(x[q].z) + (bfhi(a[q].z) + bfhi(bq[q].z)); x1.z = bflo(x[q].w) + (bflo(a[q].w) + bflo(bq[q].w)); x1.w = bfhi(x[q].w) + (bfhi(a[q].w) + bfhi(bq[q].w));
            *(f32x4*)op = x0; *(f32x4*)(op + 4) = x1; } }
    }
}

#define NA_LOADQ(qptr) do { const uint4* q4_ = (const uint4*)(qptr); _Pragma("unroll") for (int c_ = 0; c_ < 8; ++c_) { const uint4 w_ = q4_[c_]; \
    q[8*c_+0] = bflo(w_.x); q[8*c_+1] = bfhi(w_.x); q[8*c_+2] = bflo(w_.y); q[8*c_+3] = bfhi(w_.y); q[8*c_+4] = bflo(w_.z); q[8*c_+5] = bfhi(w_.z); q[8*c_+6] = bflo(w_.w); q[8*c_+7] = bfhi(w_.w); } } while (0)
#define NA_DOT(x, kptr) do { const uint4* k4_ = (const uint4*)(kptr); float s0_ = 0.f, s1_ = 0.f; _Pragma("unroll") for (int c_ = 0; c_ < 8; ++c_) { const uint4 w_ = k4_[c_]; \
    s0_ += q[8*c_+0] * bflo(w_.x) + q[8*c_+2] * bflo(w_.y) + q[8*c_+4] * bflo(w_.z) + q[8*c_+6] * bflo(w_.w); \
    s1_ += q[8*c_+1] * bfhi(w_.x) + q[8*c_+3] * bfhi(w_.y) + q[8*c_+5] * bfhi(w_.z) + q[8*c_+7] * bfhi(w_.w); } x = s0_ + s1_; } while (0)
#define NA_UPD(x, vptr) do { if ((x) > mx) { const float f_ = exp2f(mx - (x)); l *= f_; _Pragma("unroll") for (int d_ = 0; d_ < 64; ++d_) o[d_] *= f_; mx = (x); } \
    const float p_ = exp2f((x) - mx); l += p_; const uint4* v4_ = (const uint4*)(vptr); _Pragma("unroll") for (int c_ = 0; c_ < 8; ++c_) { const uint4 w_ = v4_[c_]; \
    o[8*c_+0] += p_ * bflo(w_.x); o[8*c_+1] += p_ * bfhi(w_.x); o[8*c_+2] += p_ * bflo(w_.y); o[8*c_+3] += p_ * bfhi(w_.y); o[8*c_+4] += p_ * bflo(w_.z); o[8*c_+5] += p_ * bfhi(w_.z); o[8*c_+6] += p_ * bflo(w_.w); o[8*c_+7] += p_ * bfhi(w_.w); } } while (0)
#define NA_STORE(optr) do { const float il_ = 1.0f / l; uint4* o4_ = (uint4*)(optr); _Pragma("unroll") for (int c_ = 0; c_ < 8; ++c_) { uint4 w_; \
    w_.x = pk2(o[8*c_+0] * il_, o[8*c_+1] * il_); w_.y = pk2(o[8*c_+2] * il_, o[8*c_+3] * il_); w_.z = pk2(o[8*c_+4] * il_, o[8*c_+5] * il_); w_.w = pk2(o[8*c_+6] * il_, o[8*c_+7] * il_); o4_[c_] = w_; } } while (0)

__device__ __forceinline__ void phase_attn_naive(const bf16* Q, const bf16* K, const bf16* V, const float* fcum, const float* kmean, bf16* O, int tid, int wave) {
    for (int u = blockIdx.x; u < NB * 12 * 4; u += gridDim.x) {
        const int b = u / 48, h = (u / 4) % 12, ch = u % 4, t = ch * 512 + tid; const size_t m = (size_t)b * SEQ + t;
        float q[64], o[64], mx = -1e30f, l = 0.f;
#pragma unroll
        for (int d = 0; d < 64; ++d) o[d] = 0.f;
        NA_LOADQ(Q + m * QW + h * 64);
        const int smax = ch * 512 + wave * 64 + 63;
        const bf16* kb = K + (size_t)b * SEQ * QW + h * 64; const bf16* vb = V + (size_t)b * SEQ * QW + h * 64;
        if (h < 6) {
            const float* fc = fcum + ((size_t)b * 6 + h) * SEQ; const float fct = fc[t];
            for (int s = 0; s <= smax; ++s) {
                float x; NA_DOT(x, kb + (size_t)s * QW); x += fct - fc[s];
                if (s <= t) NA_UPD(x, vb + (size_t)s * QW);
            }
            NA_STORE(O + m * DM + h * 64);
        } else {
            const int hm = h - 6, qblk = t >> 8; const float slope = alibi_slope(8 + hm) * LOG2E;
            float gt[8];
#pragma unroll
            for (int j = 0; j < 8; ++j) { const float* km = kmean + (((size_t)b * 6 + hm) * 8 + j) * 64; float d = 0.f;
#pragma unroll
                for (int e = 0; e < 64; ++e) d += q[e] * km[e];
                gt[j] = d; }
            unsigned allowed = 1u << qblk;
#pragma unroll
            for (int j = 0; j < 8; ++j) { int rank = 0;
#pragma unroll
                for (int i = 0; i < 8; ++i) if (i < qblk && i != j && (gt[i] > gt[j] || (gt[i] == gt[j] && i < j))) ++rank;
                if (j < qblk && rank < 3) allowed |= 1u << j; }
            for (int s = 0; s <= smax; ++s) {
                float x; NA_DOT(x, kb + (size_t)s * QW); x -= slope * (float)(t - s);
                if (s <= t && ((allowed >> (s >> 8)) & 1u)) NA_UPD(x, vb + (size_t)s * QW);
            }
            NA_STORE(O + m * DM + 384 + hm * 64);
        }
    }
    for (int u = blockIdx.x; u < NB * 4 * 4; u += gridDim.x) {
        const int b = u / 16, slot = (u / 4) % 4, ch = u % 4, t = ch * 512 + tid; const size_t m = (size_t)b * SEQ + t;
        float q[64], o[64], mx = -1e30f, l = 0.f;
#pragma unroll
        for (int d = 0; d < 64; ++d) o[d] = 0.f;
#pragma unroll
        for (int g = 0; g < 3; ++g) {
            const int dil = (g == 0) ? 1 : (g == 1 ? 4 : 16), so = (g == 0) ? 0 : (g == 1 ? 4 : 14), head = 12 + 4 * g + slot;
            const float slope = alibi_slope(so + slot) * LOG2E;
            NA_LOADQ(Q + m * QW + head * 64);
            for (int j = 0; j <= 128; ++j) {
                const int s = t - j * dil;
                if (s >= 0) { const size_t kr = ((size_t)b * SEQ + s) * QW + head * 64; float x; NA_DOT(x, K + kr); x -= slope * (float)(j * dil); NA_UPD(x, V + kr); }
            }
        }
        NA_STORE(O + m * DM + 768 + slot * 64);
    }
}


namespace att {
typedef short bf16x8 __attribute__((ext_vector_type(8)));
typedef short s16x4 __attribute__((ext_vector_type(4)));
typedef float f32x16 __attribute__((ext_vector_type(16)));
typedef unsigned u32x4 __attribute__((ext_vector_type(4)));
typedef float f32x2_t __attribute__((ext_vector_type(2))); typedef __bf16 bf16x2_t __attribute__((ext_vector_type(2)));
constexpr int A_K = 0, A_V = 32768, A_BT = 57344, A_WSF = 65536, A_OST = 67584, A_KB = A_OST, A_Z = 100352, A_BYTES = 100368, SLOT = 8192;
constexpr float THRL = 8.0f;
__device__ __forceinline__ int crow(int r, int hi) { return (r & 3) + 8 * (r >> 2) + 4 * hi; }
__device__ __forceinline__ void glds16(const void* gsrc, unsigned lds_dst) { unsigned keep;
    asm volatile("s_mov_b32 %0, m0\n\ts_mov_b32 m0, %2\n\ts_nop 0\n\tglobal_load_lds_dwordx4 %1, off\n\ts_mov_b32 m0, %0" : "=&s"(keep) : "v"(gsrc), "s"(lds_dst) : "memory"); }
__device__ __forceinline__ void glds16s(const void* sbase, unsigned voff, unsigned lds_dst) { unsigned keep;
    asm volatile("s_mov_b32 %0, m0\n\ts_mov_b32 m0, %3\n\ts_nop 0\n\tglobal_load_lds_dwordx4 %1, %2\n\ts_mov_b32 m0, %0" : "=&s"(keep) : "v"(voff), "s"(sbase), "s"(lds_dst) : "memory"); }
__device__ __forceinline__ unsigned cvtpk(float lo, float hi) { f32x2_t v = {lo, hi}; bf16x2_t b = __builtin_convertvector(v, bf16x2_t); return __builtin_bit_cast(unsigned, b); }
__device__ __forceinline__ int k_rho(int r) { return (r & ~9) | ((r & 1) << 3) | ((r >> 3) & 1); }
__device__ __forceinline__ int kfrag_base(int r32, int hi) { return k_rho(r32) * 128 + ((hi ^ (r32 & 7)) * 16); }
__device__ __forceinline__ void qkt(f32x16& p0, f32x16& p1, const LAS char* Kslot, const bf16x8* qr, const f32x16& negm, int r32, int hi) {
    const int kfb = kfrag_base(r32, hi);
#pragma unroll
    for (int d0 = 0; d0 < 4; ++d0) {
        const bf16x8 b0 = *(const LAS bf16x8*)(Kslot + (kfb ^ (d0 * 32)));
        const bf16x8 b1 = *(const LAS bf16x8*)(Kslot + (kfb ^ (d0 * 32)) + 4096);
        if (d0 == 0) { p0 = __builtin_amdgcn_mfma_f32_32x32x16_bf16(b0, qr[0], negm, 0, 0, 0); p1 = __builtin_amdgcn_mfma_f32_32x32x16_bf16(b1, qr[0], negm, 0, 0, 0); }
        else { p0 = __builtin_amdgcn_mfma_f32_32x32x16_bf16(b0, qr[d0], p0, 0, 0, 0); p1 = __builtin_amdgcn_mfma_f32_32x32x16_bf16(b1, qr[d0], p1, 0, 0, 0); }
    }
}
__device__ __forceinline__ void qkt0(f32x16& p0, f32x16& p1, const LAS char* Kslot, const bf16x8* qr, int r32, int hi) {
    const int kfb = kfrag_base(r32, hi); const f32x16 z = f32x16{};
#pragma unroll
    for (int d0 = 0; d0 < 4; ++d0) {
        const bf16x8 b0 = *(const LAS bf16x8*)(Kslot + (kfb ^ (d0 * 32)));
        const bf16x8 b1 = *(const LAS bf16x8*)(Kslot + (kfb ^ (d0 * 32)) + 4096);
        if (d0 == 0) { p0 = __builtin_amdgcn_mfma_f32_32x32x16_bf16(b0, qr[0], z, 0, 0, 0); p1 = __builtin_amdgcn_mfma_f32_32x32x16_bf16(b1, qr[0], z, 0, 0, 0); }
        else { p0 = __builtin_amdgcn_mfma_f32_32x32x16_bf16(b0, qr[d0], p0, 0, 0, 0); p1 = __builtin_amdgcn_mfma_f32_32x32x16_bf16(b1, qr[d0], p1, 0, 0, 0); }
    }
}
__device__ __forceinline__ void pv(f32x16* o, int vb, bf16x8 pa0, bf16x8 pa1, bf16x8 pa2, bf16x8 pa3) {
#pragma unroll
    for (int d0 = 0; d0 < 2; ++d0) { s16x4 lo[4], hi[4];
#pragma unroll
        for (int ks = 0; ks < 4; ++ks) {
            asm volatile("ds_read_b64_tr_b16 %0,%1 offset:%c2" : "=&v"(lo[ks]) : "v"(vb), "i"(d0 * 4096 + ks * 1024) : "memory");
            asm volatile("ds_read_b64_tr_b16 %0,%1 offset:%c2" : "=&v"(hi[ks]) : "v"(vb), "i"(d0 * 4096 + ks * 1024 + 512) : "memory"); }
        asm volatile("s_waitcnt lgkmcnt(0)" ::: "memory"); __builtin_amdgcn_sched_barrier(0);
#define ATT_PK(k) (bf16x8){lo[k][0], lo[k][1], lo[k][2], lo[k][3], hi[k][0], hi[k][1], hi[k][2], hi[k][3]}
        o[d0] = __builtin_amdgcn_mfma_f32_32x32x16_bf16(pa0, ATT_PK(0), o[d0], 0, 0, 0);
        o[d0] = __builtin_amdgcn_mfma_f32_32x32x16_bf16(pa1, ATT_PK(1), o[d0], 0, 0, 0);
        o[d0] = __builtin_amdgcn_mfma_f32_32x32x16_bf16(pa2, ATT_PK(2), o[d0], 0, 0, 0);
        o[d0] = __builtin_amdgcn_mfma_f32_32x32x16_bf16(pa3, ATT_PK(3), o[d0], 0, 0, 0);
#undef ATT_PK
    }
}
#define ATT_SHFL(v, src) __builtin_bit_cast(float, __builtin_amdgcn_ds_bpermute((src) << 2, __builtin_bit_cast(int, (float)(v))))
#define ATT_BAR() asm volatile("s_waitcnt lgkmcnt(0)\n\ts_barrier" ::: "memory")
#define ATT_WAIT_BAR(N) asm volatile("s_waitcnt vmcnt(" #N ") lgkmcnt(0)\n\ts_barrier" ::: "memory")

template <int MODE, int SKEL = 0>
__device__ __forceinline__ void attn_unit(const bf16* Q, const bf16* K, const bf16* V, int b, int head, int d, int res, int n0, int kt0, int jlo, int jhi,
                                          const float* fc  , float slope2, const float* km  , int qb,
                                          bf16* O, int opitch, int ocol, float* lse_out  , LAS unsigned char* lds, int wid) {
    if (MODE != 2) { d = 1; res = 0; kt0 = 0; jlo = 0; }
    unsigned z_ = 0u; asm volatile("" : "+v"(z_));
    const int lane = __builtin_amdgcn_mbcnt_hi(~0u, __builtin_amdgcn_mbcnt_lo(~0u, z_)), r32 = lane & 31, hi = lane >> 5; const int tid_o = wid * 64 + lane;
    const int L = SEQ / d;
    const size_t tokbase = (size_t)b * SEQ;
    const unsigned lds0 = (unsigned)(size_t)lds;
    LAS float* BT = (LAS float*)(lds + A_BT);
    LAS float* wsf = (LAS float*)(lds + A_WSF) + wid * 64;
#define ATT_UNI64(p) ((const bf16*)(((unsigned long long)(unsigned)__builtin_amdgcn_readfirstlane((int)((unsigned long long)(p) >> 32)) << 32) | (unsigned long long)(unsigned)__builtin_amdgcn_readfirstlane((int)(unsigned)(unsigned long long)(p))))
    const bf16* Kh = ATT_UNI64(K + ((size_t)b * 24 + head) * SEQ * 64); const bf16* Vh = ATT_UNI64(V + ((size_t)b * 24 + head) * SEQ * 64);
#undef ATT_UNI64
    const unsigned kdst = lds0 + A_K + wid * 1024, vdst = lds0 + A_V + wid * 1024;
#define ATT_DMA_K(j, slot) do { int lk_ = lane; asm volatile("" : "+v"(lk_)); const int rk_ = k_rho(8 * wid + (lk_ >> 3));     \
        glds16s(Kh, (unsigned)(rk_ * 128 + (((lk_ & 7) ^ (rk_ & 7)) * 16)) + (unsigned)(kt0 + 64 * (j)) * 128u, (unsigned)__builtin_amdgcn_readfirstlane(kdst + (slot) * SLOT)); } while (0)
#define ATT_DMA_V(j, slot) do { int lq_ = lane; asm volatile("" : "+v"(lq_));     \
        glds16s(Vh, (unsigned)(((16 * (wid & 3) + (lq_ >> 2)) * 64 + (wid >> 2) * 32 + (lq_ & 3) * 8) * 2) + (unsigned)(kt0 + 64 * (j)) * 128u, (unsigned)__builtin_amdgcn_readfirstlane(vdst + (slot) * SLOT)); } while (0)
    ATT_DMA_K(jlo, 0); if (jlo + 1 < jhi) ATT_DMA_K(jlo + 1, 1); ATT_DMA_V(jlo, 0);
    const int nq = n0 + wid * 32 + r32;
    const bool wactive = (n0 + wid * 32) < L;
    bf16x8 qr[4];
    { const bf16* qp = Q + (tokbase + (size_t)(wactive ? nq : n0) * d + res) * QW + head * 64 + hi * 8;
#pragma unroll
      for (int d0 = 0; d0 < 4; ++d0) qr[d0] = *(const bf16x8*)(qp + d0 * 16); }
    f32x4 fca = {0.f, 0.f, 0.f, 0.f}; float kmv = 0.f;
    { const int kmax_ = (n0 + 256 < L) ? n0 + 256 : L;
      if (MODE == 0) { if (4 * tid_o < kmax_) fca = *(const f32x4*)(fc + 4 * tid_o); }
      if (MODE == 1) kmv = km[tid_o]; }
    { const int kmax = (n0 + 256 < L) ? n0 + 256 : L;
      if (MODE == 0) {
          LAS float* wtot = (LAS float*)(lds + A_WSF);
          f32x4 a = fca;
          a.y += a.x; a.z += a.y; a.w += a.z;
          float incl = a.w;
#pragma unroll
          for (int o_ = 1; o_ < 64; o_ <<= 1) { const float t_ = ATT_SHFL(incl, (lane - o_) & 63); if (lane >= o_) incl += t_; }
          if (lane == 63) wtot[wid] = incl;
          ATT_BAR();
          float base = incl - a.w;
          for (int w_ = 0; w_ < wid; ++w_) base += wtot[w_];
          if (4 * tid_o < kmax) *(LAS f32x4*)(BT + 4 * tid_o) = (f32x4){-(a.x + base), -(a.y + base), -(a.z + base), -(a.w + base)};
      } else { for (int k = tid_o; k < kmax; k += NTHR) BT[k] = slope2 * (float)(k * d); } }
    unsigned allowed = 0xffu;
    if (MODE == 1) {
        LAS float* kml = (LAS float*)(lds + A_WSF);
        kml[tid_o] = kmv;
        ATT_BAR();
        float gt[8];
#pragma unroll
        for (int j = 0; j < 8; ++j) { float s = 0.f;
#pragma unroll
            for (int d0 = 0; d0 < 4; ++d0) { const f32x4 k0 = *(const LAS f32x4*)(kml + j * 64 + d0 * 16 + hi * 8), k1 = *(const LAS f32x4*)(kml + j * 64 + d0 * 16 + hi * 8 + 4);
                const u32x4 qw = __builtin_bit_cast(u32x4, qr[d0]);
                s += bflo(qw.x) * k0.x + bfhi(qw.x) * k0.y + bflo(qw.y) * k0.z + bfhi(qw.y) * k0.w + bflo(qw.z) * k1.x + bfhi(qw.z) * k1.y + bflo(qw.w) * k1.z + bfhi(qw.w) * k1.w; }
            s += ATT_SHFL(s, lane ^ 32); gt[j] = s; }
        allowed = 1u << qb;
#pragma unroll
        for (int j = 0; j < 8; ++j) { int rank = 0;
#pragma unroll
            for (int i = 0; i < 8; ++i) if (i < qb && i != j && (gt[i] > gt[j] || (gt[i] == gt[j] && i < j))) ++rank;
            if (j < qb && rank < 3) allowed |= 1u << j; }
    }
    { ATT_BAR();
      const int kmax = (n0 + 256 < L) ? n0 + 256 : L;
      for (int k = tid_o; k < kmax; k += NTHR) { const float bv = BT[k]; const unsigned h16 = f2bf(bv); const unsigned l16 = f2bf(bv - __builtin_bit_cast(float, h16 << 16));
          unsigned one2_ = 0x3F803F80u, z1_ = 0u; asm volatile("" : "+v"(one2_), "+v"(z1_)); *(LAS u32x4*)(lds + A_KB + k * 16) = (u32x4){h16 | (l16 << 16), one2_, z1_, z1_}; }
      if (tid_o == 0) { unsigned z0_ = 0u; asm volatile("" : "+v"(z0_)); *(LAS u32x4*)(lds + A_Z) = (u32x4){z0_, z0_, z0_, z0_}; } }
#define ATT_QX() do { const bool inf_ = !(msub < 3.0e38f); const unsigned mh_ = f2bf(inf_ ? 0.f : msub), ml_ = f2bf(inf_ ? 0.f : msub - __builtin_bit_cast(float, mh_ << 16)); \
        const unsigned w1_ = inf_ ? 0x0000FF80u : (((mh_ ^ 0x8000u) & 0xFFFFu) | ((ml_ ^ 0x8000u) << 16));     \
        unsigned zq_ = 0u; asm volatile("" : "+v"(zq_)); const u32x4 qv_ = {(hi == 0) ? 0x3F803F80u : zq_, (hi == 0) ? w1_ : zq_, zq_, zq_}; qx = __builtin_bit_cast(bf16x8, qv_); } while (0)
    float msub = 0.f, l_reg = 0.f; f32x16 o[2]; o[0] = f32x16{}; o[1] = f32x16{};
    const LAS char* vp0 = (const LAS char*)(lds + A_V) + ((lane >> 4) & 1) * 32 + (lane & 3) * 8 + (4 * hi + ((lane & 15) >> 2)) * 64;
    const int nmin = n0 + wid * 32, nmax = nmin + 31;
    int ja = jlo, jb = jhi - 1;
    { const int jd = (nmax - kt0) >> 6; if (jd < jb) jb = jd;
      if (MODE == 2) { const int jf = (nmin - 128 - kt0) >> 6; if (jf > ja) ja = jf; }
      if (!wactive) { ja = jhi; jb = jlo - 1; } }
#define ATT_BIAS(C0, C1, KB) do { \
        _Pragma("unroll") for (int i_ = 0; i_ < 4; ++i_) { const f32x4 b0_ = *(const LAS f32x4*)(BT + (KB) + 4 * hi + 8 * i_), b1_ = *(const LAS f32x4*)(BT + (KB) + 32 + 4 * hi + 8 * i_); \
            _Pragma("unroll") for (int e_ = 0; e_ < 4; ++e_) { C0[4 * i_ + e_] += b0_[e_] - msub; C1[4 * i_ + e_] += b1_[e_] - msub; } } } while (0)
#define ATT_MASK(C0, C1, KB) do { \
        _Pragma("unroll") for (int r_ = 0; r_ < 16; ++r_) { const int kv_ = (KB) + crow(r_, hi); if (kv_ > nq) C0[r_] = -INFINITY; if (kv_ + 32 > nq) C1[r_] = -INFINITY; } \
        if (MODE == 2) { _Pragma("unroll") for (int r_ = 0; r_ < 16; ++r_) { const int kv_ = (KB) + crow(r_, hi); if (nq - kv_ > 128) C0[r_] = -INFINITY; if (nq - kv_ - 32 > 128) C1[r_] = -INFINITY; } } } while (0)
#define ATT_ROWMAX(RM, C0, C1) do { float a_ = fmaxf(fmaxf(C0[0], C0[1]), C1[0]), b_ = fmaxf(fmaxf(C0[2], C0[3]), C1[1]); a_ = fmaxf(fmaxf(a_, C1[2]), C1[3]); \
        _Pragma("unroll") for (int r_ = 4; r_ < 16; r_ += 4) { a_ = fmaxf(fmaxf(a_, C0[r_]), C0[r_ + 1]); b_ = fmaxf(fmaxf(b_, C0[r_ + 2]), C0[r_ + 3]); a_ = fmaxf(fmaxf(a_, C1[r_]), C1[r_ + 1]); b_ = fmaxf(fmaxf(b_, C1[r_ + 2]), C1[r_ + 3]); } \
        RM = fmaxf(a_, b_); { auto rr_ = __builtin_amdgcn_permlane32_swap(__float_as_uint(RM), __float_as_uint(RM), false, false); RM = fmaxf(__uint_as_float(rr_[0]), __uint_as_float(rr_[1])); } } while (0)
#define ATT_RESC(RM, C0, C1) do { if (__any((RM) > THRL)) { const float dl_ = fmaxf((RM), 0.f); msub += dl_; \
        _Pragma("unroll") for (int r_ = 0; r_ < 16; ++r_) { C0[r_] -= dl_; C1[r_] -= dl_; } \
        const float f_ = __builtin_amdgcn_exp2f(-dl_); l_reg *= f_; if (hi == 0) wsf[r32] = f_; \
        asm volatile("s_waitcnt lgkmcnt(0)" ::: "memory"); \
        _Pragma("unroll") for (int r_ = 0; r_ < 16; ++r_) { const float fr_ = wsf[crow(r_, hi)]; o[0][r_] *= fr_; o[1][r_] *= fr_; } } } while (0)
#define ATT_VTR(p) __builtin_bit_cast(s16x4, __builtin_amdgcn_ds_read_tr16_b64_v4i16((LAS v4i16_t*)(p)))
    typedef short v4i16_t __attribute__((ext_vector_type(4)));
    f32x16 c0 = f32x16{}, c1 = f32x16{};
    bool blk_ok = true;
#define ATT_EXP_PACK() \
            float sacc = 0.f; \
            _Pragma("unroll") for (int r = 0; r < 16; ++r) { c0[r] = __builtin_amdgcn_exp2f(c0[r]); c1[r] = __builtin_amdgcn_exp2f(c1[r]); sacc += c0[r] + c1[r]; } \
            l_reg += sacc; \
            const u32x4 pw0 = {cvtpk(c0[0], c0[1]), cvtpk(c0[2], c0[3]), cvtpk(c0[4], c0[5]), cvtpk(c0[6], c0[7])}; \
            const u32x4 pw1 = {cvtpk(c0[8], c0[9]), cvtpk(c0[10], c0[11]), cvtpk(c0[12], c0[13]), cvtpk(c0[14], c0[15])}; \
            const u32x4 pw2 = {cvtpk(c1[0], c1[1]), cvtpk(c1[2], c1[3]), cvtpk(c1[4], c1[5]), cvtpk(c1[6], c1[7])}; \
            const u32x4 pw3 = {cvtpk(c1[8], c1[9]), cvtpk(c1[10], c1[11]), cvtpk(c1[12], c1[13]), cvtpk(c1[14], c1[15])};
#define ATT_KFP(KN_, g) (*(const LAS bf16x8*)((KN_) + (kfrag_base(r32, hi) ^ (((g) >> 1) * 32)) + ((g) & 1) * 4096))
#define ATT_CEP(A0, A1, idx) (((idx) < 16) ? A0[(idx) & 15] : A1[(idx) & 15])
#define ATT_FUSED_P(MASKED, C0, C1, N0, N1, KN_, VP_, KBN_) do { \
            u32x4 pw[4]; \
            bf16x8 kf[8]; kf[0] = ATT_KFP(KN_, 0); kf[1] = ATT_KFP(KN_, 1); \
            _Pragma("unroll") for (int g = 0; g < 8; ++g) { \
                if (g + 2 < 8) kf[g + 2] = ATT_KFP(KN_, g + 2); \
                float e0_ = ATT_CEP(C0, C1, 4 * g), e1_ = ATT_CEP(C0, C1, 4 * g + 1), e2_ = ATT_CEP(C0, C1, 4 * g + 2), e3_ = ATT_CEP(C0, C1, 4 * g + 3); \
                if (SKEL != 2) { e0_ = __builtin_amdgcn_exp2f(e0_); e1_ = __builtin_amdgcn_exp2f(e1_); e2_ = __builtin_amdgcn_exp2f(e2_); e3_ = __builtin_amdgcn_exp2f(e3_); }     \
                if (SKEL == 4) { if (g == 0) N0 = C0; if (g == 1) N1 = C1; } else \
                if (g == 0) N0 = __builtin_amdgcn_mfma_f32_32x32x16_bf16(kf[g], qr[0], f32x16{}, 0, 0, 0); else if (g == 1) N1 = __builtin_amdgcn_mfma_f32_32x32x16_bf16(kf[g], qr[0], f32x16{}, 0, 0, 0); \
                else if (g & 1) N1 = __builtin_amdgcn_mfma_f32_32x32x16_bf16(kf[g], qr[g >> 1], N1, 0, 0, 0); else N0 = __builtin_amdgcn_mfma_f32_32x32x16_bf16(kf[g], qr[g >> 1], N0, 0, 0, 0); \
                asm volatile("" : "+v"(e0_), "+v"(e1_), "+v"(e2_), "+v"(e3_));     \
                l_reg += (e0_ + e1_) + (e2_ + e3_);     \
                pw[g >> 1][2 * (g & 1)] = cvtpk(e0_, e1_); pw[g >> 1][2 * (g & 1) + 1] = cvtpk(e2_, e3_); \
                asm volatile("" : "+v"(l_reg)); \
                __builtin_amdgcn_sched_barrier(0); } \
            { bf16x8 qx; ATT_QX(); const LAS char* kx_ = hi ? (const LAS char*)(lds + A_Z) : (const LAS char*)(lds + A_KB) + ((KBN_) + r32) * 16; const bf16x8 kx0_ = *(const LAS bf16x8*)kx_, kx1_ = *(const LAS bf16x8*)(kx_ + (hi ? 0 : 512)); \
              N0 = __builtin_amdgcn_mfma_f32_32x32x16_bf16(kx0_, qx, N0, 0, 0, 0); N1 = __builtin_amdgcn_mfma_f32_32x32x16_bf16(kx1_, qx, N1, 0, 0, 0); }     \
            s16x4 vl[8], vh[8]; vl[0] = ATT_VTR(VP_); vh[0] = ATT_VTR(VP_ + 512); vl[1] = ATT_VTR(VP_ + 4096); vh[1] = ATT_VTR(VP_ + 4096 + 512); \
            _Pragma("unroll") for (int g = 0; g < 8; ++g) { \
                if (g + 2 < 8) { vl[g + 2] = ATT_VTR(VP_ + ((g + 2) & 1) * 4096 + ((g + 2) >> 1) * 1024); vh[g + 2] = ATT_VTR(VP_ + ((g + 2) & 1) * 4096 + ((g + 2) >> 1) * 1024 + 512); } \
                if (SKEL != 3) o[g & 1] = __builtin_amdgcn_mfma_f32_32x32x16_bf16(__builtin_bit_cast(bf16x8, pw[g >> 1]), (bf16x8){vl[g][0], vl[g][1], vl[g][2], vl[g][3], vh[g][0], vh[g][1], vh[g][2], vh[g][3]}, o[g & 1], 0, 0, 0);     \
                if (MASKED) _Pragma("unroll") for (int e = 0; e < 4; ++e) { const int ix = 4 * g + e; float x = (ix < 16) ? N0[ix & 15] : N1[ix & 15]; \
                    { const int kv_ = KBN_ + ((g >= 4) ? 32 : 0) + crow(ix & 15, hi); if (kv_ > nq) x = -INFINITY; if (MODE == 2) { if (nq - kv_ > 128) x = -INFINITY; } } \
                    if (ix < 16) N0[ix & 15] = x; else N1[ix & 15] = x; \
                    } \
                if (MASKED) { if (g < 3) asm volatile("" : "+v"(o[g & 1]), "+v"(N0[(4 * g + 4) & 15]), "+v"(N0[(4 * g + 5) & 15]), "+v"(N0[(4 * g + 6) & 15]), "+v"(N0[(4 * g + 7) & 15])); \
                              else if (g < 7) asm volatile("" : "+v"(o[g & 1]), "+v"(N1[(4 * g + 4) & 15]), "+v"(N1[(4 * g + 5) & 15]), "+v"(N1[(4 * g + 6) & 15]), "+v"(N1[(4 * g + 7) & 15])); }     \
                __builtin_amdgcn_sched_barrier(0); } \
            float rm = -1.0f; asm volatile("" : "+v"(rm));     \
            ATT_RESC(rm, N0, N1); \
            } while (0)
    bool ref_set = false;
    f32x16 d0_ = f32x16{}, d1_ = f32x16{};
#define ATT_SYNC(j) do { const int fly_ = ((j) >= jlo) ? (((j) + 2 < jhi) ? 1 : 0) + (((j) + 1 < jhi) ? 1 : 0) : ((jlo + 1 < jhi) ? 2 : 1); \
        if (fly_ == 2) { ATT_WAIT_BAR(2); } else if (fly_ == 1) { ATT_WAIT_BAR(1); } else { ATT_WAIT_BAR(0); } \
        if ((j) + 3 < jhi) ATT_DMA_K((j) + 3, ((j) + 3 - jlo) & 3); \
        if ((j) + 2 < jhi) ATT_DMA_V((j) + 2, ((j) + 2 - jlo) % 3); \
        if (!ref_set) { ref_set = true; if (wactive) msub = BT[nq]; } \
        if (MODE == 1) { const int kb_ = kt0 + 64 * ((j) + 1); if (((j) + 1 >= ja) && ((j) + 1 <= jb) && (kb_ & 255) == 0) { blk_ok = (allowed >> (kb_ >> 8)) & 1u; msub = blk_ok ? BT[nq] : INFINITY; } } } while (0)
#define ATT_KN(j) ((const LAS char*)(lds + A_K + (((j) + 1 - jlo) & 3) * SLOT))
#define ATT_VP(j) (vp0 + (((j) - jlo + 3) % 3) * SLOT)
#define ATT_MASKED(j) (((kt0 + 64 * ((j) + 1) + 63) > nmin) || (MODE == 2 && (kt0 + 64 * ((j) + 1)) < nmax - 128))
#define ATT_DOA(j) (((j) + 1 >= ja) && ((j) + 1 <= jb))
#define ATT_DOP(j) (((j) >= ja) && ((j) <= jb))
    asm volatile("" : "+v"(qr[0]), "+v"(qr[1]), "+v"(qr[2]), "+v"(qr[3]));
    int j = jlo - 1;
#pragma nounroll
    while (j < jhi) {
        ATT_SYNC(j);
        const bool doA = ATT_DOA(j), doP = ATT_DOP(j), masked = ATT_MASKED(j);
        const int kbn = kt0 + 64 * (j + 1);
        const LAS char* Kn = ATT_KN(j);
        const LAS char* vp = ATT_VP(j);
        if (SKEL == 1) { ++j; }
        else if (doP && doA && !masked && (j + 1 < jhi) && ATT_DOA(j + 1) && !ATT_MASKED(j + 1)) {
            ATT_FUSED_P(false, c0, c1, d0_, d1_, Kn, vp, kbn);
            ATT_SYNC(j + 1);
            ATT_FUSED_P(false, d0_, d1_, c0, c1, ATT_KN(j + 1), ATT_VP(j + 1), (kbn + 64));
            j += 2;
        } else {
            if (doP && doA) { if (masked) { ATT_FUSED_P(true, c0, c1, d0_, d1_, Kn, vp, kbn); } else { ATT_FUSED_P(false, c0, c1, d0_, d1_, Kn, vp, kbn); } c0 = d0_; c1 = d1_; }
            else if (doA) {
                f32x16 n0_, n1_; qkt0(n0_, n1_, Kn, qr, r32, hi);
                ATT_BIAS(n0_, n1_, kbn); if (masked) ATT_MASK(n0_, n1_, kbn);
                c0 = n0_; c1 = n1_;
            } else if (doP) {
                ATT_EXP_PACK()
                pv(o, (int)(lds0 + A_V) + ((lane >> 4) & 1) * 32 + (lane & 3) * 8 + (4 * hi + ((lane & 15) >> 2)) * 64 + ((j - jlo + 3) % 3) * SLOT,
                   __builtin_bit_cast(bf16x8, pw0), __builtin_bit_cast(bf16x8, pw1), __builtin_bit_cast(bf16x8, pw2), __builtin_bit_cast(bf16x8, pw3));
            }
            ++j;
        }
    }
#undef ATT_SYNC
#undef ATT_QX
#undef ATT_KN
#undef ATT_VP
#undef ATT_MASKED
#undef ATT_DOA
#undef ATT_DOP
#undef ATT_FUSED_P
#undef ATT_KFP
#undef ATT_CEP
#undef ATT_EXP_PACK
#undef ATT_BIAS
#undef ATT_MASK
    ATT_BAR();
#undef ATT_ROWMAX
#undef ATT_RESC
#undef ATT_VTR
    if (wactive && SKEL == 0) {
        unsigned z2_ = 0u; asm volatile("" : "+v"(z2_));
        const int lane2 = __builtin_amdgcn_mbcnt_hi(~0u, __builtin_amdgcn_mbcnt_lo(~0u, z2_)), r2 = lane2 & 31, h2 = lane2 >> 5;
        l_reg += ATT_SHFL(l_reg, lane2 ^ 32);
        LAS float* wsf2 = (LAS float*)(lds + A_WSF) + wid * 64;
        int b2_ = b; asm volatile("" : "+s"(b2_)); const size_t tb2_ = (size_t)b2_ * SEQ;
        if (h2 == 0) wsf2[32 + r2] = l_reg;
        if (MODE == 2) { if (h2 == 0) lse_out[(tokbase + (size_t)nq * d + res) * 4] = __builtin_amdgcn_logf(l_reg); }
        asm volatile("s_waitcnt lgkmcnt(0)" ::: "memory");
        LAS unsigned short* stl = (LAS unsigned short*)(lds + A_OST) + wid * 2048;
#pragma unroll
        for (int r = 0; r < 16; ++r) { const int orow = crow(r, h2); const float rl = __builtin_amdgcn_rcpf(wsf2[32 + orow]);
#pragma unroll
            for (int d0 = 0; d0 < 2; ++d0) stl[orow * 64 + d0 * 32 + r2] = (unsigned short)f2bf(o[d0][r] * rl); }
        asm volatile("s_waitcnt lgkmcnt(0)" ::: "memory");
#pragma unroll
        for (int i = 0; i < 4; ++i) { const int row = i * 8 + (lane2 >> 3), ch = lane2 & 7; const u32x4 v = *(const LAS u32x4*)(stl + row * 64 + ch * 8);
            *(u32x4*)(O + (tb2_ + (size_t)(n0 + wid * 32 + row) * d + res) * opitch + ocol + ch * 8) = v; }
    }
#undef ATT_DMA_K
#undef ATT_DMA_V
}

__device__ __forceinline__ void dil_merge_tokens(bf16* O, const bf16* OG1, const bf16* OG2, const float* lse, int tid, int m_lo) {
#pragma unroll
    for (int trip = 0; trip < 2; ++trip) {
        v4u a[2], bq[2], c[2]; float l0[2], l1[2], l2[2];
#pragma unroll
        for (int q = 0; q < 2; ++q) { const int it = tid + NTHR * (2 * trip + q); const int m = m_lo + (it >> 5), ch = it & 31, slot = ch >> 3;
            l0[q] = lse[(size_t)m * 4 + slot]; l1[q] = lse[(size_t)(M + m) * 4 + slot]; l2[q] = lse[(size_t)(2 * M + m) * 4 + slot];
            a[q] = *(const v4u*)(O + (size_t)m * DM + 768 + ch * 8); bq[q] = *(const v4u*)(OG1 + (size_t)m * DILW + ch * 8); c[q] = *(const v4u*)(OG2 + (size_t)m * DILW + ch * 8); }
#pragma unroll
        for (int q = 0; q < 2; ++q) { const int it = tid + NTHR * (2 * trip + q); const int m = m_lo + (it >> 5), ch = it & 31;
            const float mx = fmaxf(l0[q], fmaxf(l1[q], l2[q])); float w0 = __builtin_amdgcn_exp2f(l0[q] - mx), w1 = __builtin_amdgcn_exp2f(l1[q] - mx), w2 = __builtin_amdgcn_exp2f(l2[q] - mx); const float inv = __builtin_amdgcn_rcpf(w0 + w1 + w2); w0 *= inv; w1 *= inv; w2 *= inv;
            v4u o;
            o.x = pk2(w0 * bflo(a[q].x) + w1 * bflo(bq[q].x) + w2 * bflo(c[q].x), w0 * bfhi(a[q].x) + w1 * bfhi(bq[q].x) + w2 * bfhi(c[q].x));
            o.y = pk2(w0 * bflo(a[q].y) + w1 * bflo(bq[q].y) + w2 * bflo(c[q].y), w0 * bfhi(a[q].y) + w1 * bfhi(bq[q].y) + w2 * bfhi(c[q].y));
            o.z = pk2(w0 * bflo(a[q].z) + w1 * bflo(bq[q].z) + w2 * bflo(c[q].z), w0 * bfhi(a[q].z) + w1 * bfhi(bq[q].z) + w2 * bfhi(c[q].z));
            o.w = pk2(w0 * bflo(a[q].w) + w1 * bflo(bq[q].w) + w2 * bflo(c[q].w), w0 * bfhi(a[q].w) + w1 * bfhi(bq[q].w) + w2 * bfhi(c[q].w));
            *(v4u*)(O + (size_t)m * DM + 768 + ch * 8) = o; }
    }
}
__device__ __forceinline__ void wdil_unit(GAS unsigned char* ws, LAS unsigned char* lds, int wid, int w) {
    unsigned z_ = 0u; asm volatile("" : "+v"(z_));
    const int lane = __builtin_amdgcn_mbcnt_hi(~0u, __builtin_amdgcn_mbcnt_lo(~0u, z_)), r32 = lane & 31, hi = lane >> 5;
    const int g = w >> 11, v = w & 2047;
    int b, slot, res, rb, d, head, si, opitch, ocol; bf16* O; float* lse_out;
    if (g == 0) { b = v >> 8; slot = (v >> 6) & 3; res = 0; rb = v & 63; d = 1; head = 12 + slot; si = slot; O = (bf16*)(ws + WS_O); opitch = DM; ocol = 768 + slot * 64; lse_out = (float*)(ws + WS_LSE) + slot; }
    else if (g == 1) { b = v >> 8; slot = (v >> 6) & 3; res = (v >> 4) & 3; rb = v & 15; d = 4; head = 16 + slot; si = 4 + slot; O = (bf16*)(ws + WS_OG1); opitch = DILW; ocol = slot * 64; lse_out = (float*)(ws + WS_LSE) + (size_t)M * 4 + slot; }
    else { b = v >> 8; slot = (v >> 6) & 3; res = (v >> 2) & 15; rb = v & 3; d = 16; head = 20 + slot; si = 14 + slot; O = (bf16*)(ws + WS_OG2); opitch = DILW; ocol = slot * 64; lse_out = (float*)(ws + WS_LSE) + (size_t)2 * M * 4 + slot; }
    const float slope2 = alibi_slope(si) * LOG2E * (float)d;
    const size_t tokbase = (size_t)b * SEQ;
    const bf16* Q = (const bf16*)(ws + WS_Q);
    const char* Kb = (const char*)((const bf16*)(ws + WS_K) + (((size_t)b * 24 + head) * SEQ + (size_t)res * (SEQ / d)) * 64);
    const char* Vb = (const char*)((const bf16*)(ws + WS_V) + (((size_t)b * 24 + head) * SEQ + (size_t)res * (SEQ / d)) * 64);
    const unsigned rstride = 64 * 2;
    const int nq = 32 * rb + r32;
    const int k0 = (32 * rb - 128 > 0) ? 32 * rb - 128 : 0, nt = (32 * rb + 32 - k0 + 63) >> 6;
    LAS unsigned char* mine = lds + wid * 16384;
    const unsigned vdst = (unsigned)(size_t)mine;
    bf16x8 qr[4];
    { const bf16* qp = Q + (tokbase + (size_t)nq * d + res) * QW + head * 64 + hi * 8;
#pragma unroll
      for (int d0 = 0; d0 < 4; ++d0) qr[d0] = *(const bf16x8*)(qp + d0 * 16); }
    const unsigned koff0 = (unsigned)(k0 + r32) * rstride + hi * 16;
    const unsigned voff0 = (unsigned)(k0 + (lane >> 2)) * rstride + (lane & 3) * 16;
#define WD_H2(kb) ((kb) + 32 <= 32 * rb + 31)
#define WD_LDK(t_, h2_) do { const unsigned ko_ = koff0 + (unsigned)(t_) * 64u * rstride; \
        _Pragma("unroll") for (int g_ = 0; g_ < 8; g_ += 2) kf[g_] = *(const bf16x8*)(Kb + (size_t)(ko_ + (g_ >> 1) * 32)); \
        if (h2_) { const unsigned k2_ = ko_ + 32u * rstride; _Pragma("unroll") for (int g_ = 1; g_ < 8; g_ += 2) kf[g_] = *(const bf16x8*)(Kb + (size_t)(k2_ + (g_ >> 1) * 32)); } } while (0)
#define WD_DMAV(t_, sl, h2_) do { const unsigned vo_ = voff0 + (unsigned)(t_) * 64u * rstride; \
        _Pragma("unroll") for (int p_ = 0; p_ < 8; ++p_) if ((p_ & 2) == 0 || (h2_)) \
            glds16s(Vb, vo_ + (unsigned)(16 * (p_ & 3)) * rstride + (p_ >> 2) * 64, (unsigned)__builtin_amdgcn_readfirstlane(vdst + (sl) * 8192 + p_ * 1024)); } while (0)
    bf16x8 kf[8];
#pragma unroll
    for (int g_ = 0; g_ < 8; ++g_) kf[g_] = qr[0];
    { const bool h2 = WD_H2(k0); WD_DMAV(0, 0, h2); WD_LDK(0, h2); }
    float l_reg = 0.f; f32x16 o[2]; o[0] = f32x16{}; o[1] = f32x16{};
    const int vlane = ((lane >> 4) & 1) * 32 + (lane & 3) * 8 + (4 * hi + ((lane & 15) >> 2)) * 64;
    const float s32 = slope2 * 32.0f;
#pragma nounroll
    for (int t = 0; t < nt; ++t) {
        const int kb = k0 + 64 * t; const bool h2 = WD_H2(kb);
        f32x16 c0, c1 = f32x16{};
        c0 = __builtin_amdgcn_mfma_f32_32x32x16_bf16(kf[0], qr[0], f32x16{}, 0, 0, 0);
#pragma unroll
        for (int d0 = 1; d0 < 4; ++d0) c0 = __builtin_amdgcn_mfma_f32_32x32x16_bf16(kf[2 * d0], qr[d0], c0, 0, 0, 0);
        if (h2) {
#pragma unroll
            for (int d0 = 0; d0 < 4; ++d0) c1 = __builtin_amdgcn_mfma_f32_32x32x16_bf16(kf[2 * d0 + 1], qr[d0], c1, 0, 0, 0); }
        if (t + 1 < nt) { asm volatile("" : "+v"(c0), "+v"(c1)); const bool n2 = WD_H2(kb + 64); WD_DMAV(t + 1, (t + 1) & 1, n2); WD_LDK(t + 1, n2); }
        const int dk = kb - nq + 4 * hi; const float fdk = slope2 * (float)dk;
        const bool mcaus = (kb + (h2 ? 63 : 31)) > 32 * rb, mwin = kb < 32 * rb + 31 - 128;
        if (mcaus || mwin) {
#pragma unroll
            for (int r = 0; r < 16; ++r) { const int cr = (r & 3) + 8 * (r >> 2); const float tb = fdk + slope2 * (float)cr;
                float x0 = c0[r] + tb, x1 = c1[r] + (tb + s32);
                const int q0 = dk + cr, q1 = q0 + 32;
                if (q0 > 0 || q0 < -128) x0 = -INFINITY; if (q1 > 0 || q1 < -128) x1 = -INFINITY;
                c0[r] = x0; c1[r] = x1; }
        } else {
#pragma unroll
            for (int r = 0; r < 16; ++r) { const int cr = (r & 3) + 8 * (r >> 2); const float tb = fdk + slope2 * (float)cr; c0[r] += tb; c1[r] += tb + s32; }
        }
        const int vb = (int)vdst + (t & 1) * 8192 + vlane;
        if (h2) {
            float sacc = 0.f;
#pragma unroll
            for (int r = 0; r < 16; ++r) { c0[r] = __builtin_amdgcn_exp2f(c0[r]); c1[r] = __builtin_amdgcn_exp2f(c1[r]); sacc += c0[r] + c1[r]; }
            l_reg += sacc;
            const u32x4 pw0 = {cvtpk(c0[0], c0[1]), cvtpk(c0[2], c0[3]), cvtpk(c0[4], c0[5]), cvtpk(c0[6], c0[7])};
            const u32x4 pw1 = {cvtpk(c0[8], c0[9]), cvtpk(c0[10], c0[11]), cvtpk(c0[12], c0[13]), cvtpk(c0[14], c0[15])};
            const u32x4 pw2 = {cvtpk(c1[0], c1[1]), cvtpk(c1[2], c1[3]), cvtpk(c1[4], c1[5]), cvtpk(c1[6], c1[7])};
            const u32x4 pw3 = {cvtpk(c1[8], c1[9]), cvtpk(c1[10], c1[11]), cvtpk(c1[12], c1[13]), cvtpk(c1[14], c1[15])};
            pv(o, vb, __builtin_bit_cast(bf16x8, pw0), __builtin_bit_cast(bf16x8, pw1), __builtin_bit_cast(bf16x8, pw2), __builtin_bit_cast(bf16x8, pw3));
        } else {
            float sacc = 0.f;
#pragma unroll
            for (int r = 0; r < 16; ++r) { c0[r] = __builtin_amdgcn_exp2f(c0[r]); sacc += c0[r]; }
            l_reg += sacc;
            const u32x4 pw0 = {cvtpk(c0[0], c0[1]), cvtpk(c0[2], c0[3]), cvtpk(c0[4], c0[5]), cvtpk(c0[6], c0[7])};
            const u32x4 pw1 = {cvtpk(c0[8], c0[9]), cvtpk(c0[10], c0[11]), cvtpk(c0[12], c0[13]), cvtpk(c0[14], c0[15])};
#pragma unroll
            for (int d0 = 0; d0 < 2; ++d0) { s16x4 lo[2], hh[2];
#pragma unroll
                for (int ks = 0; ks < 2; ++ks) {
                    asm volatile("ds_read_b64_tr_b16 %0,%1 offset:%c2" : "=&v"(lo[ks]) : "v"(vb), "i"(d0 * 4096 + ks * 1024) : "memory");
                    asm volatile("ds_read_b64_tr_b16 %0,%1 offset:%c2" : "=&v"(hh[ks]) : "v"(vb), "i"(d0 * 4096 + ks * 1024 + 512) : "memory"); }
                asm volatile("s_waitcnt lgkmcnt(0)" ::: "memory"); __builtin_amdgcn_sched_barrier(0);
                o[d0] = __builtin_amdgcn_mfma_f32_32x32x16_bf16(__builtin_bit_cast(bf16x8, pw0), (bf16x8){lo[0][0], lo[0][1], lo[0][2], lo[0][3], hh[0][0], hh[0][1], hh[0][2], hh[0][3]}, o[d0], 0, 0, 0);
                o[d0] = __builtin_amdgcn_mfma_f32_32x32x16_bf16(__builtin_bit_cast(bf16x8, pw1), (bf16x8){lo[1][0], lo[1][1], lo[1][2], lo[1][3], hh[1][0], hh[1][1], hh[1][2], hh[1][3]}, o[d0], 0, 0, 0);
            }
        }
    }
#undef WD_H2
#undef WD_LDK
#undef WD_DMAV
    asm volatile("s_waitcnt vmcnt(0) lgkmcnt(0)" ::: "memory");
    l_reg += ATT_SHFL(l_reg, lane ^ 32);
    LAS float* wsf2 = (LAS float*)(mine + 8192);
    if (hi == 0) { wsf2[r32] = l_reg; const float lg_ = __builtin_amdgcn_logf(l_reg); asm volatile("global_store_dword %0, %1, off sc1" :: "v"(lse_out + (tokbase + (size_t)nq * d + res) * 4), "v"(lg_) : "memory"); }
    asm volatile("s_waitcnt lgkmcnt(0)" ::: "memory");
    LAS unsigned short* stl = (LAS unsigned short*)mine;
#pragma unroll
    for (int r = 0; r < 16; ++r) { const int orow = crow(r, hi); const float rl = __builtin_amdgcn_rcpf(wsf2[orow]);
#pragma unroll
        for (int d0 = 0; d0 < 2; ++d0) stl[orow * 64 + d0 * 32 + r32] = (unsigned short)f2bf(o[d0][r] * rl); }
    asm volatile("s_waitcnt lgkmcnt(0)" ::: "memory");
#pragma unroll
    for (int i = 0; i < 4; ++i) { const int row = i * 8 + (lane >> 3), ch = lane & 7; const u32x4 vv = *(const LAS u32x4*)(stl + row * 64 + ch * 8);
        asm volatile("global_store_dwordx4 %0, %1, off sc1\n\ts_nop 1" :: "v"(O + (tokbase + (size_t)(32 * rb + row) * d + res) * opitch + ocol + ch * 8), "v"(vv) : "memory"); }
    asm volatile("s_waitcnt lgkmcnt(0)" ::: "memory");
}

template <int SKEL = 0>
__device__ __forceinline__ void attn_phase(GAS unsigned char* ws0, int l, volatile LAS unsigned*  , LAS unsigned char* lds0, int tid, int ulo = 0, int uhi = 768, int qoff = 0) {
    const int wv0 = __builtin_amdgcn_readfirstlane(tid >> 6);
    if (SKEL == 0 && (qoff == 0 || !MERGE_IN_QUEUE)) {
        for (int rp_ = 0; rp_ < 1 + ((qoff == 0) ? PROBE_WDIL2 : 0); ++rp_)
        for (int w = blockIdx.x * NWAVES + wv0; w < 3 * 2048; w += gridDim.x * NWAVES) {
            GAS unsigned char* ws = ws0; asm volatile("" : "+s"(ws));
            LAS unsigned char* lds = lds0; asm volatile("" : "+s"(lds));
            int wv = wv0; asm volatile("" : "+s"(wv));
            wdil_unit(ws, lds, wv, w);
        }
        asm volatile("s_waitcnt vmcnt(0)" ::: "memory");
        if (MERGE_IN_QUEUE && qoff == 0 && lane_opq() == 0) (void)xb_add((unsigned*)(ws0 + WS_CTL) + CW_Q + 64 * l + 32, 1u);
        __syncthreads();
    }
    const int c_lo = (l == 0) ? CONV_FIRST : CONV_SPLIT, c_hi = (l == 0) ? CONV_SPLIT : CONV_NITEMS;
    const int NC = (qoff == 0 || PROBE_CONVQ) ? (c_hi - c_lo + CONV_UNIT - 1) / CONV_UNIT : 0;
    const int NA = uhi - ulo, NP = (NA < NC) ? NA : NC;
    const int NM = (MERGE_IN_QUEUE && qoff == 0) ? M / 64 : 0;
    const int NU = NA + NC + NM;
    for (;;) {
        GAS unsigned char* ws = ws0; asm volatile("" : "+s"(ws));
        LAS unsigned char* lds = lds0; asm volatile("" : "+s"(lds));
        int wv = wv0; asm volatile("" : "+s"(wv));
        volatile LAS unsigned* misc = (volatile LAS unsigned*)(lds + MISC_OFF);
        { GAS unsigned* qctr = (GAS unsigned*)(ws + WS_CTL) + CW_Q + 64 * l + qoff;
          const bool t1 = (wv == 0) && (lane_opq() == 0);
          if (t1) misc[0] = __hip_atomic_fetch_add(qctr, 1u, __ATOMIC_RELAXED, __HIP_MEMORY_SCOPE_AGENT); }
        __syncthreads();
        const int uq = __builtin_amdgcn_readfirstlane((int)misc[0]);
        __syncthreads();
        if (uq >= NU) break;
        if (uq >= NA + NC) {
            if (misc[2] != (unsigned)(l + 1)) {
                if (wv == 0 && lane_opq() == 0) { unsigned* dctr = (unsigned*)(ws + WS_CTL) + CW_Q + 64 * l + 32; unsigned sp_ = 0u;
                    while (xb_ld(dctr) < gridDim.x * NWAVES) { __builtin_amdgcn_s_sleep(2); if (++sp_ > (1u << 24)) break; }
                    __builtin_amdgcn_fence(__ATOMIC_ACQUIRE, "agent"); asm volatile("s_waitcnt vmcnt(0)" ::: "memory"); }
                __syncthreads();
                if (wv == 0 && lane_opq() == 0) misc[2] = (unsigned)(l + 1);
                __syncthreads();
            }
            dil_merge_tokens((bf16*)(ws + WS_O), (const bf16*)(ws + WS_OG1), (const bf16*)(ws + WS_OG2), (const float*)(ws + WS_LSE), wv * 64 + lane_opq(), 64 * (uq - NA - NC));
            continue;
        }
        const bool isc = (uq < 2 * NP) ? ((uq & 1) != 0) : (NC > NA);
        if (isc) {
            const int cu = (uq < 2 * NP) ? (uq >> 1) : uq - NA;
            const int base = c_lo + CONV_UNIT * cu, end = (base + CONV_UNIT < c_hi) ? base + CONV_UNIT : c_hi;
            conv_run8(ws, lds, lane_opq(), wv, base + wv, NWAVES, end);
            VM_WAIT();
            continue;
        }
        const int ua = (uq < 2 * NP) ? (uq >> 1) : uq - NC;
        const bf16* Q = (const bf16*)(ws + WS_Q); const bf16* K = (const bf16*)(ws + WS_K); const bf16* V = (const bf16*)(ws + WS_V);
        bf16* O = (bf16*)(ws + WS_O);
        const float* fcum = (const float*)(ws + WS_FLOG); const float* kmean = (const float*)(ws + WS_KM) + (size_t)l * 8 * 6 * 8 * 64;
        const int u = ua + ulo;
        const int qb = 7 - u / 96, r = u % 96, type = r / 48, bh = r % 48, b = bh / 6, h = bh % 6;
        if (type == 0) attn_unit<0, SKEL>(Q, K, V, b, h, 1, 0, 256 * qb, 0, 0, 4 * (qb + 1), fcum + (size_t)bh * SEQ, 0.f, nullptr, qb, O, DM, h * 64, nullptr, lds, wv);
        else attn_unit<1, SKEL>(Q, K, V, b, 6 + h, 1, 0, 256 * qb, 0, 0, 4 * (qb + 1), nullptr, alibi_slope(8 + h) * LOG2E, kmean + (size_t)bh * 512, qb, O, DM, 384 + h * 64, nullptr, lds, wv);
    }
}
__device__ __forceinline__ void phase_dil_merge(bf16* O, const bf16* OG1, const bf16* OG2, const float* lse, int tid) {
    const int stride = gridDim.x * NTHR;
    for (int it0 = blockIdx.x * NTHR + tid; it0 < M * 32; it0 += 2 * stride) {
        v4u a[2], bq[2], c[2]; float l0[2], l1[2], l2[2];
#pragma unroll
        for (int q = 0; q < 2; ++q) { const int it = it0 + q * stride; if (it < M * 32) { const int m = it >> 5, ch = it & 31, slot = ch >> 3;
            l0[q] = lse[(size_t)m * 4 + slot]; l1[q] = lse[(size_t)(M + m) * 4 + slot]; l2[q] = lse[(size_t)(2 * M + m) * 4 + slot];
            a[q] = *(const v4u*)(O + (size_t)m * DM + 768 + ch * 8); bq[q] = *(const v4u*)(OG1 + (size_t)m * DILW + ch * 8); c[q] = *(const v4u*)(OG2 + (size_t)m * DILW + ch * 8); } }
#pragma unroll
        for (int q = 0; q < 2; ++q) { const int it = it0 + q * stride; if (it < M * 32) { const int m = it >> 5, ch = it & 31;
            const float mx = fmaxf(l0[q], fmaxf(l1[q], l2[q])); float w0 = __builtin_amdgcn_exp2f(l0[q] - mx), w1 = __builtin_amdgcn_exp2f(l1[q] - mx), w2 = __builtin_amdgcn_exp2f(l2[q] - mx); const float inv = __builtin_amdgcn_rcpf(w0 + w1 + w2); w0 *= inv; w1 *= inv; w2 *= inv;
            v4u o;
            o.x = pk2(w0 * bflo(a[q].x) + w1 * bflo(bq[q].x) + w2 * bflo(c[q].x), w0 * bfhi(a[q].x) + w1 * bfhi(bq[q].x) + w2 * bfhi(c[q].x));
            o.y = pk2(w0 * bflo(a[q].y) + w1 * bflo(bq[q].y) + w2 * bflo(c[q].y), w0 * bfhi(a[q].y) + w1 * bfhi(bq[q].y) + w2 * bfhi(c[q].y));
            o.z = pk2(w0 * bflo(a[q].z) + w1 * bflo(bq[q].z) + w2 * bflo(c[q].z), w0 * bfhi(a[q].z) + w1 * bfhi(bq[q].z) + w2 * bfhi(c[q].z));
            o.w = pk2(w0 * bflo(a[q].w) + w1 * bflo(bq[q].w) + w2 * bflo(c[q].w), w0 * bfhi(a[q].w) + w1 * bfhi(bq[q].w) + w2 * bfhi(c[q].w));
            *(v4u*)(O + (size_t)m * DM + 768 + ch * 8) = o; } }
    }
}
#undef ATT_BAR
#undef ATT_WAIT_BAR
#undef ATT_SHFL
}

#ifndef ONE_LAUNCH
#define ONE_LAUNCH 1
#endif
#ifndef REP_PHASE
#define REP_PHASE -1
#endif
#ifndef REP_N
#define REP_N 2
#endif
#define REPN(pid) ((REP_PHASE == (pid)) ? REP_N : 1)
#ifndef PROBE_ATTN2
#define PROBE_ATTN2 0
#endif
#ifndef PROBE_BAR2
#define PROBE_BAR2 0
#endif
#ifndef PROBE_DUP
#define PROBE_DUP 0
#endif
#ifndef PROBE_CONV2
#define PROBE_CONV2 0
#endif
#ifndef PROBE_ATTN2_L
#define PROBE_ATTN2_L 0
#endif
#ifndef PROBE_SKEL
#define PROBE_SKEL 0
#endif
#ifndef PROBE_ULO
#define PROBE_ULO 0
#define PROBE_UHI 768
#endif
#ifndef NAIVE_ATTN
#define NAIVE_ATTN 0
#endif
static_assert(WS_K - WS_Q == (size_t)M * QW * 2 && WS_V - WS_K == (size_t)M * QW * 2, "q|k|v stride");
constexpr int NPL = 12, NPH = 1 + 2 * NPL + 1;
#if NAIVE_ATTN
__global__ void __launch_bounds__(NTHR, 2) k_attn_naive(KArgs a) {
    unsigned char* ws = a.ws; const int tid = threadIdx.x, wave = tid >> 6;
    phase_attn_naive((const bf16*)(ws + WS_Q), (const bf16*)(ws + WS_K), (const bf16*)(ws + WS_V), (const float*)(ws + WS_FCUM), (const float*)(ws + WS_KMEAN), (bf16*)(ws + WS_O), tid, wave);
}
#endif
__device__ __forceinline__ bool opq(GAS unsigned char*& w, GAS unsigned char* w0, int& tid, int& lane, int& wave, int wave_k) { w = w0; asm volatile("" : "+s"(w)); unsigned z = 0u; asm volatile("" : "+v"(z)); asm volatile("" : "+s"(wave_k)); lane = (int)__builtin_amdgcn_mbcnt_hi(~0u, __builtin_amdgcn_mbcnt_lo(~0u, z)); wave = wave_k; tid = wave_k * 64 + lane; return true; }
#define PH(k) (lo <= (k) && (k) < hi && opq(ws, ws0, tid, lane, wave, wave_k))
#define SEAM(k) do { if (PH(k) && PH((k) + 1)) { XcdBarrier b_ = bar; asm volatile("" : "+s"(b_.bar)); xcd_barrier(b_, wave_k); if (PROBE_BAR2) { XcdBarrier c_ = bar; asm volatile("" : "+s"(c_.bar)); xcd_barrier(c_, wave_k); } } } while (0)
#define mods ((float*)(ws + WS_MODS))
#define flog ((float*)(ws + WS_FLOG))
#define fcum ((float*)(ws + WS_FCUM))
#define kmean ((float*)(ws + WS_KM) + (size_t)l * 8 * 6 * 8 * 64)
#define sel ((int*)(ws + WS_SEL))
#define wt ((float*)(ws + WS_WT))
#define rcnt ((int*)(ws + WS_CNT))
#define tok ((int*)(ws + WS_TOK))
#define wrow ((float*)(ws + WS_WROW))
#define tile_e ((int*)(ws + WS_TILEE))
#define Hb ((bf16*)(ws + WS_H))
#define Qb ((bf16*)(ws + WS_Q))
#define Kb ((bf16*)(ws + WS_K))
#define Vb ((bf16*)(ws + WS_V))
#define Gb ((bf16*)(ws + WS_G))
#define Ob ((bf16*)(ws + WS_O))
#define YB ((bf16*)(ws + WS_YB))
template <int L> __device__ __forceinline__ void layer_body(GAS unsigned char* const ws0, const int lo, const int hi, const XcdBarrier bar, LAS unsigned char* lds, const int wave_k) {
    constexpr int l = L; GAS unsigned char* ws = ws0; int tid = 0, lane = 0, wave = wave_k;
    const int G = (int)gridDim.x, bx = (int)blockIdx.x;
        const int p0 = 1 + NPL * l;
#define XBp ((bf16*)(ws + WS_XB))
#define mods_l (mods + (size_t)l * NB * 6144)
#define win_l (AIN(6) + (size_t)l * DM * IN_COLS)
#define wint_l ((const bf16*)(ws + WS_WIN) + (size_t)l * NIN * DM)
        if constexpr (l == 0) { if (PH(p0 + 0)) { for (int rc_ = 0; rc_ < 1 + PROBE_CONV2; ++rc_) phase_convert(ws, lds, tid, lane, wave); __syncthreads(); } }
        if (PH(p0 + 0)) for (int rep_ = 0; rep_ < REPN(p0 + 0); ++rep_) phase_norm<0, (l != 0)>((l == 0) ? (const void*)AIN(0) : (const void*)XBp, AIN(4) + l * DM, mods_l, 0, 1024, Hb, (unsigned char*)(ws + WS_H8), win_l, AIN(7) + 6 * l, flog, nullptr, nullptr, nullptr, nullptr, nullptr, nullptr, nullptr, nullptr, lds, tid, lane, wave);
        SEAM(p0 + 0);
        if (PH(p0 + 1)) for (int rep_ = 0; rep_ < REPN(p0 + 1); ++rep_) {
#if V_FP8
            { pg8::Gemm g{Hb, wint_l, M, 2 * QW, DM}; pg8::StaticOrder S; S.init(M, 2 * QW, G, bx);
              pg8::EpiInProj E{Qb, Gb, (const float*)(ws + WS_GAINS) + l * 2 * QW, kmean};
              pg8::gemm_phase<pg8::EpiInProj, pg8::StaticOrder, true, true>(lds, g, S, E, wave); }
            { pg8::Gemm g{(const bf16*)(ws + WS_H8), (const bf16*)(ws + WS_WIN + (size_t)l * 15 * MiB + WS_WG8_OFF), M, 3072 + QW, DM / 2};
              pg8::StaticOrder S; S.init(M, 3072 + QW, G, bx); pg8::EpiGates8 E{Gb, Vb};
              pg8::gemm_phase<pg8::EpiGates8, pg8::StaticOrder, true, true, true>(lds, g, S, E, wave); }
#else
            { pg8::Gemm g{Hb, wint_l, M, 3 * QW, DM}; pg8::StaticOrder S; S.init(M, 3 * QW, G, bx);
              pg8::EpiInProj E{Qb, Gb, (const float*)(ws + WS_GAINS) + l * 2 * QW, kmean};
              pg8::gemm_phase<pg8::EpiInProj, pg8::StaticOrder, true, true>(lds, g, S, E, wave); }
            { pg8::Gemm g{(const bf16*)(ws + WS_H8), (const bf16*)(ws + WS_WIN + (size_t)l * 15 * MiB + WS_WG8_OFF), M, 3072, DM / 2};
              pg8::GateOrder S{G, bx}; pg8::EpiGates8 E{Gb, Vb};
              pg8::gemm_phase<pg8::EpiGates8, pg8::GateOrder, true, true, true>(lds, g, S, E, wave); }
#endif
        }
        SEAM(p0 + 1);
#if PROBE_ATTN2
        if (l == PROBE_ATTN2_L && PH(p0 + 3)) att::attn_phase<PROBE_SKEL>(ws, l, (volatile LAS unsigned*)(lds + MISC_OFF), lds, tid, PROBE_ULO, PROBE_UHI, 16);
#endif
        if (PH(p0 + 3)) att::attn_phase(ws, l, (volatile LAS unsigned*)(lds + MISC_OFF), lds, tid);
        SEAM(p0 + 3);
        if (!MERGE_IN_QUEUE) { if (PH(p0 + 4)) att::phase_dil_merge(Ob, (const bf16*)(ws + WS_OG1), (const bf16*)(ws + WS_OG2), (const float*)(ws + WS_LSE), tid);
                               SEAM(p0 + 4); }
        if (PH(p0 + 5)) for (int rep_ = 0; rep_ < REPN(p0 + 5); ++rep_) {
            pg8::Gemm g{Ob, (const bf16*)(ws + WS_WBR) + (size_t)l * DM * DM, M, DM, DM}; pg8::StaticOrder S; S.init(M, DM, G, bx);
            pg8::EpiBranch E{YB, Gb}; pg8::gemm_phase<pg8::EpiBranch, pg8::StaticOrder, false, true>(lds, g, S, E, wave);
        }
        SEAM(p0 + 5);
        if (PH(p0 + 6)) for (int rep_ = 0; rep_ < REPN(p0 + 6); ++rep_) {
            pg8::Gemm g{YB, (const bf16*)(ws + WS_WOUT) + (size_t)l * DM * DM, M, DM, DM}; pg8::StaticOrder S; S.init(M, DM, G, bx);
            if constexpr (l == 0) { pg8::EpiResid<false> E{(const void*)AIN(0), XBp, mods_l + 2048, 1.f}; pg8::gemm_phase<pg8::EpiResid<false>, pg8::StaticOrder, false, true>(lds, g, S, E, wave); }
            else { pg8::EpiResid<true> E{(const void*)XBp, XBp, mods_l + 2048, (rep_ == 0) ? 1.f : 0.f}; pg8::gemm_phase<pg8::EpiResid<true>, pg8::StaticOrder, false, true>(lds, g, S, E, wave); }
        }
        SEAM(p0 + 6);
        if constexpr (l == 0) {
            if (PH(p0 + 7)) for (int rep_ = 0; rep_ < REPN(p0 + 7); ++rep_) phase_norm<1, true>((const void*)XBp, AIN(5) + l * DM, mods_l, 3072, 4096, Hb, nullptr, nullptr, nullptr, nullptr, nullptr, nullptr, nullptr, nullptr, nullptr, nullptr, nullptr, nullptr, lds, tid, lane, wave);
            SEAM(p0 + 7);
            if (PH(p0 + 10)) for (int rep_ = 0; rep_ < REPN(p0 + 10); ++rep_) {
                pg8::Gemm g{Hb, (const bf16*)(ws + WS_WF1), M, 2 * DFF, DM}; pg8::StaticOrder S; S.init(M, 2 * DFF, G, bx);
#if DENSE2_FP8
                pg8::EpiSwiglu8 E{(unsigned char*)(ws + WS_ACT), 22, 1.0f, F8_AS}; pg8::gemm_phase<pg8::EpiSwiglu8, pg8::StaticOrder, true, true>(lds, g, S, E, wave);
#else
                pg8::EpiSwiglu E{(bf16*)(ws + WS_ACT), 22, (PROBE_FP8 == 2) ? 8.f : 0.f}; pg8::gemm_phase<pg8::EpiSwiglu, pg8::StaticOrder, true, true>(lds, g, S, E, wave);
#endif
            }
            SEAM(p0 + 10);
            if (PH(p0 + 11)) for (int rep_ = 0; rep_ < REPN(p0 + 11); ++rep_) {
#if DENSE2_FP8
                pg8::Gemm g{(const bf16*)(ws + WS_ACT), (const bf16*)(ws + WS_WF2), M, DM, DFF / 2}; pg8::StaticOrder S; S.init(M, DM, G, bx);
                pg8::EpiResid<true> E{(const void*)XBp, XBp, mods_l + 5120, (rep_ == 0) ? 1.0f / (F8_WS * F8_AS) : 0.f}; pg8::gemm_phase<pg8::EpiResid<true>, pg8::StaticOrder, false, true, true>(lds, g, S, E, wave);
#else
                pg8::Gemm g{(const bf16*)(ws + WS_ACT), (const bf16*)(ws + WS_WF2), M, DM, DFF}; pg8::StaticOrder S; S.init(M, DM, G, bx);
                pg8::EpiResid<true> E{(const void*)XBp, XBp, mods_l + 5120, (rep_ == 0) ? 1.f : 0.f}; pg8::gemm_phase<pg8::EpiResid<true>, pg8::StaticOrder, false, true>(lds, g, S, E, wave);
#endif
            }
            SEAM(p0 + 11);
        } else {
            if (PH(p0 + 7)) for (int rep_ = 0; rep_ < REPN(p0 + 7); ++rep_) phase_norm<2, true>((const void*)XBp, AIN(5) + l * DM, mods_l, 3072, 4096, nullptr, nullptr, nullptr, nullptr, nullptr, AIN(17), AIN(18), sel, wt, rcnt, nullptr, nullptr, nullptr, lds, tid, lane, wave);
            SEAM(p0 + 7);
            if (PH(p0 + 9)) for (int rep_ = 0; rep_ < REPN(p0 + 9); ++rep_) phase_norm<3, true>((const void*)XBp, AIN(5) + l * DM, mods_l, 3072, 4096, (bf16*)(ws + WS_HP), nullptr, nullptr, nullptr, nullptr, nullptr, nullptr, sel, wt, rcnt, tok, wrow, tile_e, lds, tid, lane, wave);
            SEAM(p0 + 9);
            if (PH(p0 + 10)) for (int rep_ = 0; rep_ < REPN(p0 + 10); ++rep_) {
                const int nt = __builtin_amdgcn_readfirstlane(tile_e[255]);
                pg8::MoeOrder S; S.so.init(nt * 256, 2 * DFF, G, bx); S.tmap = tile_e; S.npn = 22;
#if MOE_FP8
                pg8::Gemm g{(const bf16*)(ws + WS_HP), (const bf16*)(ws + WS_WE1), nt * 256, 2 * DFF, DM / 2};
                pg8::EpiSwiglu8 E{(unsigned char*)(ws + WS_ACTE), 22, 1.0f / F8_WS, F8_AS / F8_WS}; pg8::gemm_phase<pg8::EpiSwiglu8, pg8::MoeOrder, true, true, true>(lds, g, S, E, wave);
#if PROBE_DUP == 3
                pg8::gemm_phase<pg8::EpiSwiglu8, pg8::MoeOrder, true, true, true>(lds, g, S, E, wave);
#endif
#else
                pg8::Gemm g{(const bf16*)(ws + WS_HP), (const bf16*)(ws + WS_WE1), nt * 256, 2 * DFF, DM};
                pg8::EpiSwiglu E{(bf16*)(ws + WS_ACTE), 22, 8.f}; pg8::gemm_phase<pg8::EpiSwiglu, pg8::MoeOrder, true, true>(lds, g, S, E, wave);
#endif
            }
            SEAM(p0 + 10);
            if (PH(p0 + 11)) for (int rep_ = 0; rep_ < REPN(p0 + 11); ++rep_) {
                const int nt = __builtin_amdgcn_readfirstlane(tile_e[255]);
                pg8::MoeOrder S; S.so.init(nt * 256, DM, G, bx); S.tmap = tile_e; S.npn = 4;
#if MOE_FP8
                pg8::Gemm g{(const bf16*)(ws + WS_ACTE), (const bf16*)(ws + WS_WE2), nt * 256, DM, DFF / 2};
                pg8::EpiMoeY E{(bf16*)(ws + WS_YE), mods_l + 5120, tok, wrow, 1.0f / (F8_WS * F8_AS)}; pg8::gemm_phase<pg8::EpiMoeY, pg8::MoeOrder, true, true, true>(lds, g, S, E, wave);
#if PROBE_DUP == 4
                pg8::gemm_phase<pg8::EpiMoeY, pg8::MoeOrder, true, true, true>(lds, g, S, E, wave);
#endif
#else
                pg8::Gemm g{(const bf16*)(ws + WS_ACTE), (const bf16*)(ws + WS_WE2), nt * 256, DM, DFF};
                pg8::EpiMoeY E{(bf16*)(ws + WS_YE), mods_l + 5120, tok, wrow, 1.0f}; pg8::gemm_phase<pg8::EpiMoeY, pg8::MoeOrder, false, true>(lds, g, S, E, wave);
#endif
            }
            SEAM(p0 + 11);
            if (PH(p0 + 12)) phase_moe_combine(AOUT, XBp, (const bf16*)(ws + WS_YE), tid);
        }
}
__global__ void __launch_bounds__(NTHR, 2) mk_fwd(KArgs a) {
    extern __shared__ __attribute__((aligned(16))) unsigned char lds_raw[];
    LAS unsigned char* lds = (LAS unsigned char*)lds_raw;
    const int wave_k = __builtin_amdgcn_readfirstlane((int)threadIdx.x >> 6);
    int lane = lane_opq(), tid = wave_k * 64 + lane, wave = wave_k;
    volatile LAS unsigned* MISC = (volatile LAS unsigned*)(lds + MISC_OFF);
    for (int u = tid; u < (LDS_BYTES - RING_BYTES) / 4; u += NTHR) ((LAS unsigned*)(lds + RING_BYTES))[u] = 0u;
    __syncthreads();
    GAS unsigned char* const ws0 = (GAS unsigned char*)a.ws;
    GAS unsigned char* ws = ws0;
    unsigned* ctl = (unsigned*)(ws + WS_CTL);
    const int lo = a.ph_lo, hi = a.ph_hi;
    XcdBarrier bar; bar.bar = ctl + CW_BAR; bar.x = 0; bar.st = nullptr;
    if (hi - lo > 1) bar = xcd_barrier_post(ctl + CW_BAR, MISC + 8, tid == 0);
    const int G = (int)gridDim.x, bx = (int)blockIdx.x;

    if (PH(0)) { for (int rep_ = 0; rep_ < REPN(0); ++rep_) phase_mods(ws, lds, tid, lane, wave);
                 }
    SEAM(0);
    layer_body<0>(ws0, lo, hi, bar, lds, wave_k);
    layer_body<1>(ws0, lo, hi, bar, lds, wave_k);
#undef PH
#undef SEAM
}

extern "C" void kernel_launch(void* const* d_in, const int* in_sizes, int n_in, void* d_out, int out_size, void* d_ws, size_t ws_size, hipStream_t stream) {
    static int grid = 0;
    if (grid == 0) {
        if (n_in != 22 || out_size != M * DM || ws_size < WS_END) { fprintf(stderr, "kernel_launch: unexpected sizes n_in %d out %d ws %zu (need %zu)\n", n_in, out_size, ws_size, (size_t)WS_END); grid = -1; return; }
        int dev = 0, cus = 0, per_cu = 0;
        if (hipGetDevice(&dev) != hipSuccess || hipDeviceGetAttribute(&cus, hipDeviceAttributeMultiprocessorCount, dev) != hipSuccess) { grid = -1; return; }
        if (hipFuncSetAttribute((const void*)mk_fwd, hipFuncAttributeMaxDynamicSharedMemorySize, LDS_BYTES) != hipSuccess) { fprintf(stderr, "kernel_launch: hipFuncSetAttribute failed\n"); grid = -1; return; }
        if (hipOccupancyMaxActiveBlocksPerMultiprocessor(&per_cu, (const void*)mk_fwd, NTHR, LDS_BYTES) != hipSuccess || per_cu < 1) fprintf(stderr, "kernel_launch: occupancy query says %d\n", per_cu);
        (void)hipGetLastError();
        grid = cus;
    }
    if (grid < 0) return;
    (void)hipMemsetAsync((char*)d_ws + WS_CTL, 0, CTL_ZERO_BYTES, stream);
    KArgs a{};
    for (int i = 0; i < 22; ++i) a.in[i] = (const float*)d_in[i];
    a.out = (float*)d_out; a.ws = (unsigned char*)d_ws;
#if ONE_LAUNCH
    a.ph_lo = 0; a.ph_hi = NPH;
    hipLaunchKernelGGL(mk_fwd, dim3(grid), dim3(NTHR), LDS_BYTES, stream, a);
#else
    for (int p = 0; p < NPH; ++p) {
        if (p == 1 + 8 || p == 1 + 9) continue;
        if (NAIVE_ATTN && (p == 1 + 4 || p == 1 + NPL + 4)) continue;
        a.ph_lo = p; a.ph_hi = p + 1;
#if NAIVE_ATTN
        if (p == 1 + 3 || p == 1 + NPL + 3) { hipLaunchKernelGGL(k_attn_naive, dim3(grid), dim3(NTHR), 0, stream, a); continue; }
#endif
        hipLaunchKernelGGL(mk_fwd, dim3(grid), dim3(NTHR), LDS_BYTES, stream, a);
    }
#endif
}
```
